# Optimizing an MI355X kernel written in HIP

```python
import jax, jax.numpy as jnp
from jax import lax
import numpy as np

D_MODEL = 1024
BATCH = 16
SEQ = 2048
DEPTH = 2

CHUNK = 128
E_A = 2 * D_MODEL
N_GROUPS_A = 16
GROUP_A = E_A // N_GROUPS_A
E_B = D_MODEL
CONV_W = 3
D_FF = ((8 * D_MODEL // 3 + 255) // 256) * 256
N_A = (DEPTH + 1) // 2
N_B = DEPTH // 2
EPS = 1e-6

kernel_name = "hybrid_sgu_shortconv_swiglu"


def rms_norm(x, g):
    xf = x.astype(jnp.float32)
    y = xf * lax.rsqrt(jnp.mean(xf * xf, axis=-1, keepdims=True) + EPS)
    return (y * g.astype(jnp.float32)).astype(x.dtype)


def layer_norm(x, g, b):
    xf = x.astype(jnp.float32)
    mu = jnp.mean(xf, axis=-1, keepdims=True)
    xc = xf - mu
    y = xc * lax.rsqrt(jnp.mean(xc * xc, axis=-1, keepdims=True) + EPS)
    return (y * g.astype(jnp.float32) + b.astype(jnp.float32)).astype(x.dtype)


def spatial_gating_mixer(h, w_in, v_gain, v_bias, w_s, b_s, w_out):
    bsz, seq, _ = h.shape
    z = jax.nn.gelu(jnp.einsum('bsd,de->bse', h, w_in))
    u, v = jnp.split(z, 2, axis=-1)
    v = layer_norm(v, v_gain, v_bias)
    v = v.reshape(bsz, seq // CHUNK, CHUNK, N_GROUPS_A, GROUP_A)
    causal = jnp.tril(jnp.ones((CHUNK, CHUNK), dtype=bool))
    w = jnp.where(causal[None], w_s, jnp.zeros((), w_s.dtype))
    sv = jnp.einsum('hts,bnshc->bnthc', w, v) + b_s.T[None, None, :, :, None]
    y = u * sv.reshape(bsz, seq, E_A)
    return jnp.einsum('bse,ed->bsd', y, w_out)


def short_conv_mixer(h, w_in, conv_w, w_out):
    seq = h.shape[1]
    p = jnp.einsum('bsd,de->bse', h, w_in)
    b_gate, c_gate, hx = jnp.split(p, 3, axis=-1)
    z = c_gate * hx
    zp = jnp.pad(z, ((0, 0), (CONV_W - 1, 0), (0, 0)))
    conv = zp[:, 0:seq] * conv_w[0]
    for k in range(1, CONV_W):
        conv = conv + zp[:, k:k + seq] * conv_w[k]
    y = b_gate * conv
    return jnp.einsum('bse,ed->bsd', y, w_out)


def swiglu(h, w_gate, w_up, w_down):
    g = jnp.einsum('bsd,df->bsf', h, w_gate)
    u = jnp.einsum('bsd,df->bsf', h, w_up)
    return jnp.einsum('bsf,fd->bsd', jax.nn.silu(g) * u, w_down)


def setup_inputs(seed: int = 0) -> dict:
    key = jax.random.key(seed)
    ks = jax.random.split(key, 20)
    f32 = jnp.float32

    def nrm(k, shape, fan_in):
        return jax.random.normal(k, shape, f32) * (fan_in ** -0.5)

    def gain(k, shape):
        return 1.0 + 0.02 * jax.random.normal(k, shape, f32)

    return {
        "x": jax.random.normal(ks[0], (BATCH, SEQ, D_MODEL), f32),
        "mix_norm": gain(ks[1], (DEPTH, D_MODEL)),
        "ffn_norm": gain(ks[2], (DEPTH, D_MODEL)),
        "a_w_in": nrm(ks[3], (N_A, D_MODEL, 2 * E_A), D_MODEL),
        "a_v_gain": gain(ks[4], (N_A, E_A)),
        "a_v_bias": 0.02 * jax.random.normal(ks[5], (N_A, E_A), f32),
        "a_w_s": nrm(ks[6], (N_A, N_GROUPS_A, CHUNK, CHUNK), CHUNK),
        "a_b_s": gain(ks[7], (N_A, N_GROUPS_A, CHUNK)),
        "a_w_out": nrm(ks[8], (N_A, E_A, D_MODEL), E_A),
        "b_w_in": nrm(ks[9], (N_B, D_MODEL, 3 * E_B), D_MODEL),
        "b_conv_w": nrm(ks[10], (N_B, CONV_W, E_B), CONV_W),
        "b_w_out": nrm(ks[11], (N_B, E_B, D_MODEL), E_B),
        "ffn_w_gate": nrm(ks[12], (DEPTH, D_MODEL, D_FF), D_MODEL),
        "ffn_w_up": nrm(ks[13], (DEPTH, D_MODEL, D_FF), D_MODEL),
        "ffn_w_down": nrm(ks[14], (DEPTH, D_FF, D_MODEL), D_FF),
        "final_norm": gain(ks[15], (D_MODEL,)),
    }


def reference(x, mix_norm, ffn_norm, a_w_in, a_v_gain, a_v_bias, a_w_s, a_b_s, a_w_out,
              b_w_in, b_conv_w, b_w_out, ffn_w_gate, ffn_w_up, ffn_w_down, final_norm):
    for i in range(DEPTH):
        h = rms_norm(x, mix_norm[i])
        j = i // 2
        if i % 2 == 0:
            mix = spatial_gating_mixer(h, a_w_in[j], a_v_gain[j], a_v_bias[j],
                                       a_w_s[j], a_b_s[j], a_w_out[j])
        else:
            mix = short_conv_mixer(h, b_w_in[j], b_conv_w[j], b_w_out[j])
        x = x + mix
        x = x + swiglu(rms_norm(x, ffn_norm[i]), ffn_w_gate[i], ffn_w_up[i], ffn_w_down[i])
    return rms_norm(x, final_norm)
```

```cpp
#include <hip/hip_runtime.h>
#include <hip/hip_cooperative_groups.h>
#include <cstdio>
#include <cstdint>
namespace cg = cooperative_groups;
namespace pg8 {
#define PG8_LAS __attribute__((address_space(3)))
typedef unsigned short bf16_t;
typedef short bf16x8 __attribute__((ext_vector_type(8)));
typedef float f32x4 __attribute__((ext_vector_type(4)));
typedef unsigned u32x4 __attribute__((ext_vector_type(4)));
constexpr int BM = 256, BK = 64, HALF = 128, HTB = HALF * BK * 2  , STAGE_BYTES = 8 * HTB, NXCD = 8, WGM = 8;

__host__ __device__ __forceinline__ int lds_byte(int r, int c) { const int st = (r >> 4) * 2 + (c >> 5), rr = r & 15, cc = c & 31, ob = rr * 64 + cc * 2; return st * 1024 + (ob ^ (((ob >> 9) & 1) << 5)); }
__host__ __device__ __forceinline__ void stage_rc(int b, int& R, int& C) { const int st = b / 1024, sb = b % 1024, swz = sb ^ (((sb >> 9) & 1) << 5); R = (st >> 1) * 16 + swz / 64; C = (st & 1) * 32 + (swz % 64) / 2; }
__host__ __device__ __forceinline__ int perm32(int rho) { const int n = rho >> 4, i = rho & 15; return 8 * (i >> 2) + 4 * n + (i & 3); }

struct Unit { int pm, pn; };
struct Gemm { const bf16_t* A; const bf16_t* Bt; int M, N, K; };

struct StaticOrder {
    int nM, nN, nwg, G, c;
    __host__ __device__ void init(int M, int N, int G_, int c_) { nM = M / BM; nN = N / BM; nwg = nM * nN; G = G_; c = c_; }
    __host__ __device__ bool next(int i, Unit& u) const {
        const long L = (long)i * G + c; if (L >= nwg) return false;
        int wgid = (int)L; { const int q = nwg / NXCD, r = nwg % NXCD, xcd = wgid % NXCD, off = wgid / NXCD; wgid = (xcd < r ? xcd * (q + 1) : r * (q + 1) + (xcd - r) * q) + off; }
        const int nig = WGM * nN, gid = wgid / nig, fm = gid * WGM, gsz = (nM - fm) < WGM ? (nM - fm) : WGM;
        u.pm = fm + ((wgid % nig) % gsz); u.pn = (wgid % nig) / gsz; return true;
    }
    __device__ __forceinline__ void a_ready(const Unit&) const {}
    __device__ __forceinline__ void done(const Unit&) const {}
};

__device__ __forceinline__ unsigned cvt_pk_bf16(float lo, float hi) { unsigned r; asm volatile("v_cvt_pk_bf16_f32 %0, %1, %2" : "=v"(r) : "v"(lo), "v"(hi)); return r; }
typedef float f32x2 __attribute__((ext_vector_type(2)));
typedef unsigned u32x2 __attribute__((ext_vector_type(2)));
constexpr float RMS_EPS = 1e-6f;
__device__ __forceinline__ float gelu_tanh(float v) {
    const float w = v * (1.0f + 0.044715f * v * v);
    const float e = __builtin_amdgcn_exp2f(w * (-2.0f * 0.7978845608028654f * 1.4426950408889634f));
    return v * __builtin_amdgcn_rcpf(1.0f + e);
}
__device__ __forceinline__ float silu_f(float v) {
    const float e = __builtin_amdgcn_exp2f(v * (-1.4426950408889634f));
    return v * __builtin_amdgcn_rcpf(1.0f + e);
}
__device__ __forceinline__ u32x4 pack8(const f32x4 a, const f32x4 b) {
    u32x4 w; w.x = cvt_pk_bf16(a[0], a[1]); w.y = cvt_pk_bf16(a[2], a[3]); w.z = cvt_pk_bf16(b[0], b[1]); w.w = cvt_pk_bf16(b[2], b[3]); return w;
}
__device__ __forceinline__ float row_rstd(const float* ss, int row, int fq) {
    const f32x4 p = *(const f32x4*)(ss + (size_t)row * 16 + fq * 4);
    float s = (p[0] + p[1]) + (p[2] + p[3]);
    s += __shfl_xor(s, 16); s += __shfl_xor(s, 32);
    return 1.0f / sqrtf(s * (1.0f / 1024.0f) + RMS_EPS);
}

struct EpiGelu {
    static constexpr bool PERM = true, AFTER_DRAIN = false;
    bf16_t* O; int ldc;
    __device__ __forceinline__ void operator()(const f32x4 (&acc)[2][2][4][2], const Unit& u, int wr, int wc, int fr, int fq) const {
        const int row0 = u.pm * BM + wr * 64 + fr, col0 = u.pn * BM + wc * 32 + 8 * fq;
#pragma unroll
        for (int ai = 0; ai < 2; ++ai)
#pragma unroll
            for (int m = 0; m < 4; ++m) { bf16_t* rowp = O + (size_t)(row0 + ai * HALF + m * 16) * ldc + col0;
#pragma unroll
                for (int bj = 0; bj < 2; ++bj) { f32x4 v0 = acc[ai][bj][m][0], v1 = acc[ai][bj][m][1];
#pragma unroll
                    for (int e = 0; e < 4; ++e) { v0[e] = gelu_tanh(v0[e]); v1[e] = gelu_tanh(v1[e]); }
                    *(u32x4*)(rowp + bj * HALF) = pack8(v0, v1); } }
    }
};
struct EpiGeluT {
    static constexpr bool PERM = true, AFTER_DRAIN = false;
    bf16_t* O; int ldc; f32x2* vst;
    __device__ __forceinline__ void operator()(const f32x4 (&acc)[2][2][4][2], const Unit& u, int wr, int wc, int fr, int fq) const {
        const int row0 = u.pm * BM + wr * 64 + fr, col0 = u.pn * BM + wc * 32 + 8 * fq;
        float v[32];
#pragma unroll
        for (int i = 0; i < 32; ++i) v[i] = 0.f;
#pragma unroll
        for (int ai = 0; ai < 2; ++ai)
#pragma unroll
            for (int m = 0; m < 4; ++m) { bf16_t* rowp = O + (size_t)(row0 + ai * HALF + m * 16) * ldc + col0;
#pragma unroll
                for (int bj = 0; bj < 2; ++bj) { f32x4 v0 = acc[ai][bj][m][0], v1 = acc[ai][bj][m][1];
#pragma unroll
                    for (int e = 0; e < 4; ++e) { v0[e] = gelu_tanh(v0[e]); v1[e] = gelu_tanh(v1[e]);
                        v[2 * (8 * bj + e)] += v0[e]; v[2 * (8 * bj + e) + 1] += v0[e] * v0[e];
                        v[2 * (8 * bj + 4 + e)] += v1[e]; v[2 * (8 * bj + 4 + e) + 1] += v1[e] * v1[e]; }
                    *(u32x4*)(rowp + bj * HALF) = pack8(v0, v1); } }
#define PG8_XSTEP(H, MASK) { const bool bit = (fr & (MASK)) != 0; _Pragma("unroll") for (int i = 0; i < (H); ++i) { const float send = bit ? v[i] : v[i + (H)]; const float keep = bit ? v[i + (H)] : v[i]; v[i] = keep + __shfl_xor(send, (MASK)); } }
        PG8_XSTEP(16, 8) PG8_XSTEP(8, 4) PG8_XSTEP(4, 2) PG8_XSTEP(2, 1)
#undef PG8_XSTEP
        const int token = u.pn * BM + (fr >> 3) * HALF + wc * 32 + 8 * fq + (fr & 7);
        vst[(size_t)token * 16 + u.pm * 2 + wr] = (f32x2){v[0], v[1]};
    }
};
struct EpiRes {
    static constexpr bool PERM = true, AFTER_DRAIN = false;
    const float* base; float* out; bf16_t* xb; float* ss;
    __device__ __forceinline__ void operator()(const f32x4 (&acc)[2][2][4][2], const Unit& u, int wr, int wc, int fr, int fq) const {
        const int row0 = u.pm * BM + wr * 64 + fr, col0 = u.pn * BM + wc * 32 + 8 * fq;
#pragma unroll
        for (int ai = 0; ai < 2; ++ai)
#pragma unroll
            for (int m = 0; m < 4; ++m) { const int row = row0 + ai * HALF + m * 16; const size_t off = (size_t)row * 1024 + col0; float q = 0.f;
#pragma unroll
                for (int bj = 0; bj < 2; ++bj) {
                    const f32x4 b0 = *(const f32x4*)(base + off + bj * HALF), b1 = *(const f32x4*)(base + off + bj * HALF + 4);
                    const f32x4 o0 = b0 + acc[ai][bj][m][0], o1 = b1 + acc[ai][bj][m][1];
                    *(f32x4*)(out + off + bj * HALF) = o0; *(f32x4*)(out + off + bj * HALF + 4) = o1;
                    q += (o0[0] * o0[0] + o0[1] * o0[1]) + (o0[2] * o0[2] + o0[3] * o0[3]) + (o1[0] * o1[0] + o1[1] * o1[1]) + (o1[2] * o1[2] + o1[3] * o1[3]);
                    *(u32x4*)(xb + off + bj * HALF) = pack8(o0, o1); }
                q += __shfl_xor(q, 16); q += __shfl_xor(q, 32);
                if (fq == 0) ss[(size_t)row * 16 + u.pn * 4 + wc] = q; }
    }
};
struct EpiSwiglu {
    static constexpr bool PERM = true, AFTER_DRAIN = false;
    bf16_t* O; int ldc; const float* ss;
    __device__ __forceinline__ void operator()(const f32x4 (&acc)[2][2][4][2], const Unit& u, int wr, int wc, int fr, int fq) const {
        const int row0 = u.pm * BM + wr * 64 + fr, col0 = u.pn * HALF + wc * 32 + 8 * fq;
#pragma unroll
        for (int ai = 0; ai < 2; ++ai)
#pragma unroll
            for (int m = 0; m < 4; ++m) { const int row = row0 + ai * HALF + m * 16; const float rs = row_rstd(ss, row, fq);
                f32x4 a0, a1;
#pragma unroll
                for (int e = 0; e < 4; ++e) { a0[e] = silu_f(acc[ai][0][m][0][e] * rs) * (acc[ai][1][m][0][e] * rs); a1[e] = silu_f(acc[ai][0][m][1][e] * rs) * (acc[ai][1][m][1][e] * rs); }
                *(u32x4*)(O + (size_t)row * ldc + col0) = pack8(a0, a1); }
    }
};
struct EpiConvIn {
    static constexpr bool PERM = true, AFTER_DRAIN = false;
    bf16_t* Z; bf16_t* BG; const float* ss;
    __device__ __forceinline__ void operator()(const f32x4 (&acc)[2][2][4][2], const Unit& u, int wr, int wc, int fr, int fq) const {
        const int row0 = u.pm * BM + wr * 64 + fr;
        if (u.pn < 8) {
            const int col0 = u.pn * HALF + wc * 32 + 8 * fq;
#pragma unroll
            for (int ai = 0; ai < 2; ++ai)
#pragma unroll
                for (int m = 0; m < 4; ++m) { const int row = row0 + ai * HALF + m * 16; float rs = row_rstd(ss, row, fq); rs = rs * rs;
                    const f32x4 a0 = acc[ai][0][m][0] * acc[ai][1][m][0] * rs, a1 = acc[ai][0][m][1] * acc[ai][1][m][1] * rs;
                    *(u32x4*)(Z + (size_t)row * 1024 + col0) = pack8(a0, a1); }
        } else {
            const int col0 = (u.pn - 8) * BM + wc * 32 + 8 * fq;
#pragma unroll
            for (int ai = 0; ai < 2; ++ai)
#pragma unroll
                for (int m = 0; m < 4; ++m) { const int row = row0 + ai * HALF + m * 16; const float rs = row_rstd(ss, row, fq);
#pragma unroll
                    for (int bj = 0; bj < 2; ++bj) *(u32x4*)(BG + (size_t)row * 1024 + col0 + bj * HALF) = pack8(acc[ai][bj][m][0] * rs, acc[ai][bj][m][1] * rs); }
        }
    }
};

template <class Epi, class Sched, bool ALIGN_EPI = false, bool SP2 = false>
__device__ __forceinline__ void gemm_phase(PG8_LAS unsigned char* lds, const Gemm g, const Sched& S, const Epi& E) {
    const int tid = threadIdx.x, wid = __builtin_amdgcn_readfirstlane(tid >> 6), lane = tid & 63, wr = wid >> 2, wc = wid & 3, fr = lane & 15, fq = lane >> 4;
    const int K = g.K, nt = K / BK;
    unsigned voffA[2], voffB[2];
#pragma unroll
    for (int i = 0; i < 2; ++i) { int R, C; stage_rc(tid * 16 + i * 8192, R, C); const int Rb = Epi::PERM ? ((R & ~31) + perm32(R & 31)) : R;
        voffA[i] = (unsigned)(R * K + C) * 2u; voffB[i] = (unsigned)(Rb * K + C) * 2u; }
    const size_t kstep = (size_t)(BK * 2);
    const size_t hstep = (size_t)HALF * K * 2;
    const size_t tstep = 2 * hstep;
    const unsigned ldsw = (unsigned)wid * 1024u;
    const int aoff = lds_byte(wr * 64 + fr, fq * 8), boff = lds_byte(wc * 32 + fr, fq * 8);
#define PG8_SA(b, h) (((b) * 2 + (h)) * HTB)
#define PG8_SB(b, h) ((4 + (b) * 2 + (h)) * HTB)
#define PG8_STAGE(bufoff, gbase, voff) do { _Pragma("unroll") for (int _i = 0; _i < 2; ++_i) \
        __builtin_amdgcn_global_load_lds((const unsigned*)((const char*)(gbase) + (voff)[_i]), (PG8_LAS unsigned*)(lds + (bufoff) + ldsw + _i * 8192), 16, 0, 0); } while (0)
#define PG8_LDA(dst, b, h) do { _Pragma("unroll") for (int m = 0; m < 4; ++m) _Pragma("unroll") for (int k = 0; k < 2; ++k) dst[m][k] = *(const PG8_LAS bf16x8*)(lds + PG8_SA(b, h) + aoff + m * 2048 + k * 1024); } while (0)
#define PG8_LDB(dst, b, h) do { _Pragma("unroll") for (int n = 0; n < 2; ++n) _Pragma("unroll") for (int k = 0; k < 2; ++k) dst[n][k] = *(const PG8_LAS bf16x8*)(lds + PG8_SB(b, h) + boff + n * 2048 + k * 1024); } while (0)
#define PG8_MMA(ai, bj, At, Bt) do { __builtin_amdgcn_s_setprio(1); _Pragma("unroll") for (int m = 0; m < 4; ++m) _Pragma("unroll") for (int n = 0; n < 2; ++n) _Pragma("unroll") for (int k = 0; k < 2; ++k) \
        acc[ai][bj][m][n] = __builtin_amdgcn_mfma_f32_16x16x32_bf16(Bt[n][k], At[m][k], acc[ai][bj][m][n], 0, 0, 0); __builtin_amdgcn_s_setprio(0); } while (0)
#define PG8_WAIT_V(n) asm volatile("s_waitcnt vmcnt(" #n ")" ::: "memory")
#define PG8_WAIT_L(n) asm volatile("s_waitcnt lgkmcnt(" #n ")" ::: "memory")
#define PG8_BAR __builtin_amdgcn_s_barrier()
#define PG8_SCHED __builtin_amdgcn_sched_barrier(0)
    Unit cur, nxt; int ui = 0;
    if (!S.next(0, cur)) return;
    f32x4 acc[2][2][4][2];
#pragma unroll
    for (int a = 0; a < 2; ++a)
#pragma unroll
        for (int b = 0; b < 2; ++b)
#pragma unroll
            for (int m = 0; m < 4; ++m)
#pragma unroll
                for (int n = 0; n < 2; ++n) acc[a][b][m][n] = (f32x4){0.f, 0.f, 0.f, 0.f};
    bf16x8 At[4][2], B0[2][2], B1[2][2];
    const char* cA = (const char*)g.A + (size_t)cur.pm * tstep; const char* cB = (const char*)g.Bt + (size_t)cur.pn * tstep;
    S.a_ready(cur);
    if constexpr (SP2) {
        PG8_STAGE(PG8_SB(0, 0), cB, voffB); PG8_STAGE(PG8_SB(0, 1), cB + hstep, voffB); PG8_STAGE(PG8_SA(0, 0), cA, voffA); PG8_STAGE(PG8_SA(0, 1), cA + hstep, voffA);
        if (wr == 1) PG8_BAR;
        PG8_WAIT_V(2); PG8_BAR;
        PG8_STAGE(PG8_SB(1, 0), cB + kstep, voffB); PG8_STAGE(PG8_SA(1, 0), cA + kstep, voffA); PG8_STAGE(PG8_SB(1, 1), cB + hstep + kstep, voffB);
        PG8_WAIT_V(6); PG8_BAR;
    } else {
        PG8_STAGE(PG8_SB(0, 0), cB, voffB); PG8_STAGE(PG8_SA(0, 0), cA, voffA); PG8_STAGE(PG8_SB(0, 1), cB + hstep, voffB); PG8_STAGE(PG8_SA(0, 1), cA + hstep, voffA);
        if (wr == 1) PG8_BAR;
        PG8_WAIT_V(4); PG8_BAR;
        PG8_STAGE(PG8_SB(1, 0), cB + kstep, voffB); PG8_STAGE(PG8_SA(1, 0), cA + kstep, voffA); PG8_STAGE(PG8_SB(1, 1), cB + hstep + kstep, voffB);
        PG8_WAIT_V(6); PG8_BAR;
    }
    for (;;) {
        const bool has_next = S.next(ui + 1, nxt);
        const char* nA = has_next ? (const char*)g.A + (size_t)nxt.pm * tstep : cA; const char* nB = has_next ? (const char*)g.Bt + (size_t)nxt.pn * tstep : cB;
        for (int t = 0; t < nt; t += 2) {
            const bool last = (t == nt - 2);
            const char* a1 = cA + (size_t)(t + 1) * kstep;
            const char* a2 = last ? nA : cA + (size_t)(t + 2) * kstep; const char* b2 = last ? nB : cB + (size_t)(t + 2) * kstep;
            const char* a3 = a2 + kstep; const char* b3 = b2 + kstep;
            if (last && has_next) S.a_ready(nxt);
            if constexpr (SP2) {
            PG8_LDB(B0, 0, 0); PG8_LDB(B1, 0, 1); PG8_SCHED; PG8_LDA(At, 0, 0); PG8_STAGE(PG8_SA(1, 1), a1 + hstep, voffA);
            PG8_WAIT_V(8); PG8_WAIT_L(0); PG8_BAR; PG8_MMA(0, 0, At, B0); PG8_MMA(0, 1, At, B1); PG8_BAR; PG8_SCHED;
            PG8_LDA(At, 0, 1); PG8_STAGE(PG8_SB(0, 0), b2, voffB); PG8_STAGE(PG8_SB(0, 1), b2 + hstep, voffB); PG8_STAGE(PG8_SA(0, 0), a2, voffA);
            PG8_WAIT_V(8); PG8_WAIT_L(0); PG8_BAR; PG8_MMA(1, 0, At, B0); PG8_MMA(1, 1, At, B1); PG8_BAR; PG8_SCHED;
            PG8_LDB(B0, 1, 0); PG8_LDB(B1, 1, 1); PG8_SCHED; PG8_LDA(At, 1, 0); PG8_STAGE(PG8_SA(0, 1), a2 + hstep, voffA);
            PG8_WAIT_V(8); PG8_WAIT_L(0); PG8_BAR; PG8_MMA(0, 0, At, B0); PG8_MMA(0, 1, At, B1); PG8_BAR; PG8_SCHED;
            PG8_LDA(At, 1, 1); PG8_STAGE(PG8_SB(1, 0), b3, voffB); PG8_STAGE(PG8_SB(1, 1), b3 + hstep, voffB); PG8_STAGE(PG8_SA(1, 0), a3, voffA);
            PG8_WAIT_V(8); PG8_WAIT_L(0); PG8_BAR; PG8_MMA(1, 0, At, B0); PG8_MMA(1, 1, At, B1); PG8_BAR; PG8_SCHED;
            } else {
            PG8_LDB(B0, 0, 0); PG8_SCHED; PG8_LDA(At, 0, 0); PG8_STAGE(PG8_SA(1, 1), a1 + hstep, voffA);
            PG8_WAIT_L(8); PG8_BAR; PG8_WAIT_L(0); PG8_MMA(0, 0, At, B0); PG8_BAR; PG8_SCHED;
            PG8_LDB(B1, 0, 1); PG8_STAGE(PG8_SB(0, 0), b2, voffB);
            PG8_BAR; PG8_WAIT_L(0); PG8_MMA(0, 1, At, B1); PG8_BAR;
            PG8_LDA(At, 0, 1); PG8_STAGE(PG8_SA(0, 0), a2, voffA);
            PG8_BAR; PG8_WAIT_L(0); PG8_MMA(1, 0, At, B0); PG8_BAR; PG8_SCHED;
            PG8_STAGE(PG8_SB(0, 1), b2 + hstep, voffB);
            PG8_WAIT_V(6); PG8_BAR; PG8_MMA(1, 1, At, B1); PG8_BAR;
            PG8_LDB(B0, 1, 0); PG8_SCHED; PG8_LDA(At, 1, 0); PG8_STAGE(PG8_SA(0, 1), a2 + hstep, voffA);
            PG8_WAIT_L(8); PG8_BAR; PG8_WAIT_L(0); PG8_MMA(0, 0, At, B0); PG8_BAR; PG8_SCHED;
            PG8_LDB(B1, 1, 1); PG8_STAGE(PG8_SB(1, 0), b3, voffB);
            PG8_BAR; PG8_WAIT_L(0); PG8_MMA(0, 1, At, B1); PG8_BAR;
            PG8_LDA(At, 1, 1); PG8_STAGE(PG8_SA(1, 0), a3, voffA);
            PG8_BAR; PG8_WAIT_L(0); PG8_MMA(1, 0, At, B0); PG8_BAR; PG8_SCHED;
            PG8_STAGE(PG8_SB(1, 1), b3 + hstep, voffB);
            PG8_WAIT_V(6); PG8_BAR; PG8_MMA(1, 1, At, B1); PG8_BAR;
            }
        }
        if constexpr (ALIGN_EPI) { if (wr == 0) PG8_BAR; }
        if constexpr (!Epi::AFTER_DRAIN) { E(acc, cur, wr, wc, fr, fq); S.done(cur); }
        if (!has_next) break;
#pragma unroll
        for (int a = 0; a < 2; ++a)
#pragma unroll
            for (int b = 0; b < 2; ++b)
#pragma unroll
                for (int m = 0; m < 4; ++m)
#pragma unroll
                    for (int n = 0; n < 2; ++n) acc[a][b][m][n] = (f32x4){0.f, 0.f, 0.f, 0.f};
        cur = nxt; cA = nA; cB = nB; ++ui;
        if constexpr (ALIGN_EPI) { if (wr == 1) PG8_BAR; }
    }
    PG8_WAIT_V(0);
    if constexpr (!ALIGN_EPI) { if (wr == 0) PG8_BAR; }
    PG8_BAR;
    if constexpr (Epi::AFTER_DRAIN) { E.fused(acc, cur, wr, wc, fr, fq, lds, wid, lane); S.done(cur); }
#undef PG8_SA
#undef PG8_SB
#undef PG8_STAGE
#undef PG8_LDA
#undef PG8_LDB
#undef PG8_MMA
#undef PG8_WAIT_V
#undef PG8_WAIT_L
#undef PG8_BAR
#undef PG8_SCHED
}
}

constexpr int NWAVES = 8;
constexpr int SEQ = 2048, D = 1024, M = 16 * SEQ;
constexpr int EA = 2048, NH = 16, CH = 128;
constexpr int FF = 2816;
constexpr float LN_EPS = 1e-6f;
#ifndef MK_ONE_LAUNCH
#define MK_ONE_LAUNCH 1
#endif
constexpr int N_PHASES = 12;

constexpr size_t MiB = 1u << 20;
constexpr size_t WS_AIN = 2 * MiB, WS_AOUT = 10 * MiB, WS_WS = 14 * MiB, WS_GU0 = 15 * MiB, WS_D0 = 26 * MiB, WS_GU1 = 32 * MiB, WS_D1 = 43 * MiB, WS_BIN = 49 * MiB, WS_BOUT = 55 * MiB;
constexpr size_t WS_SS = 58 * MiB, WS_VST = 60 * MiB;
constexpr size_t WS_XB = 64 * MiB;
constexpr size_t WS_U = 128 * MiB, WS_VT = 256 * MiB;
constexpr size_t WS_A = 128 * MiB;
constexpr size_t WS_YC = 304 * MiB, WS_Z = 384 * MiB, WS_BG = 448 * MiB, WS_END = 512 * MiB;
static_assert(WS_A + (size_t)M * FF * 2 <= WS_YC && WS_YC + (size_t)M * D * 2 <= WS_Z && WS_BG + (size_t)M * D * 2 <= WS_END, "d_ws map");
static_assert(WS_GU0 + (size_t)2 * FF * D * 2 <= WS_D0 && WS_D0 + (size_t)FF * D * 2 <= WS_GU1 && WS_D1 + (size_t)FF * D * 2 <= WS_BIN, "weight map");

constexpr int RING_BYTES = 131072, LDS_BYTES = 147456;

#define GAS __attribute__((address_space(1)))
#define LAS __attribute__((address_space(3)))
typedef unsigned short bf16;
typedef unsigned v4u __attribute__((ext_vector_type(4)));
typedef unsigned v2u __attribute__((ext_vector_type(2)));
typedef float f32x4 __attribute__((ext_vector_type(4)));
typedef float f32x2 __attribute__((ext_vector_type(2)));
typedef short bf16x8 __attribute__((ext_vector_type(8)));
#define LDS_WAIT() asm volatile("s_waitcnt lgkmcnt(0)" ::: "memory")
__device__ __forceinline__ unsigned f2bf(float f) { unsigned u = __builtin_bit_cast(unsigned, f); return (u + 0x7fffu + ((u >> 16) & 1u)) >> 16; }
__device__ __forceinline__ unsigned pk2(float lo, float hi) { return f2bf(lo) | (f2bf(hi) << 16); }
__device__ __forceinline__ float bflo(unsigned w) { return __builtin_bit_cast(float, w << 16); }
__device__ __forceinline__ float bfhi(unsigned w) { return __builtin_bit_cast(float, w & 0xffff0000u); }

struct Frame {
    LAS unsigned char* lds;
    int tid, lane, wave, vcu, G;
    const float *x, *mix_norm, *ffn_norm, *a_w_in, *a_v_gain, *a_v_bias, *a_w_s, *a_b_s, *a_w_out, *b_w_in, *b_conv_w, *b_w_out, *w_gate, *w_up, *w_down, *final_norm;
    float* out; unsigned char* ws;
};

__device__ __forceinline__ float wave_sum(float v) {
#pragma unroll
    for (int o = 1; o < 64; o <<= 1) v += __shfl_xor(v, o);
    return v;
}
template <int MODE> __device__ __forceinline__ void p0_transpose_item(const float* W, int K, int N, bf16* WT, int row_off, const float* gain, LAS float* scr, int item, int lane) {
    const int nblk = N / 32, kb = item / nblk, nb = item % nblk, k0 = 64 * kb, n0 = 32 * nb;
#pragma unroll 8
    for (int i = 0; i < 32; ++i) { const int kk = 2 * i + (lane >> 5); float w = W[(size_t)(k0 + kk) * N + n0 + (lane & 31)]; if (gain) w *= gain[k0 + kk]; scr[kk * 33 + (lane & 31)] = w; }
    LDS_WAIT(); asm volatile("" ::: "memory");
    const int c = lane & 7;
    const int rbase = (MODE == 0) ? (row_off + n0) : (row_off + 256 * (n0 / 128) + (n0 % 128));
#pragma unroll
    for (int j = 0; j < 4; ++j) { const int n = (lane >> 3) + 8 * j; const LAS float* s = scr + (8 * c) * 33 + n;
        v4u o; o.x = pk2(s[0 * 33], s[1 * 33]); o.y = pk2(s[2 * 33], s[3 * 33]); o.z = pk2(s[4 * 33], s[5 * 33]); o.w = pk2(s[6 * 33], s[7 * 33]);
        *(GAS v4u*)(WT + (size_t)(rbase + n) * K + k0 + 8 * c) = o; }
    LDS_WAIT(); asm volatile("" ::: "memory");
}
__device__ __forceinline__ void p0_prologue(Frame& F) {
    LAS float* scr = (LAS float*)(F.lds + F.wave * 16384);
    const int gw = F.vcu * NWAVES + F.wave, NGW = F.G * NWAVES;
    unsigned char* ws = F.ws;
    constexpr int I_AIN = (D / 64) * (2 * EA / 32), I_AOUT = (EA / 64) * (D / 32), I_G = (D / 64) * (FF / 32), I_DN = (FF / 64) * (D / 32), I_BIN = (D / 64) * (D / 32), I_BOUT = (D / 64) * (D / 32);
    constexpr int NITEMS = I_AIN + I_AOUT + 4 * I_G + 2 * I_DN + 3 * I_BIN + I_BOUT;
    for (int it = gw; it < NITEMS; it += NGW) {
        int r = it;
        if (r < I_AIN) { p0_transpose_item<0>(F.a_w_in, D, 2 * EA, (bf16*)(ws + WS_AIN), 0, F.mix_norm, scr, r, F.lane); continue; } r -= I_AIN;
        if (r < I_AOUT) { p0_transpose_item<0>(F.a_w_out, EA, D, (bf16*)(ws + WS_AOUT), 0, nullptr, scr, r, F.lane); continue; } r -= I_AOUT;
        if (r < I_G) { p0_transpose_item<1>(F.w_gate, D, FF, (bf16*)(ws + WS_GU0), 0, F.ffn_norm, scr, r, F.lane); continue; } r -= I_G;
        if (r < I_G) { p0_transpose_item<1>(F.w_up, D, FF, (bf16*)(ws + WS_GU0), 128, F.ffn_norm, scr, r, F.lane); continue; } r -= I_G;
        if (r < I_G) { p0_transpose_item<1>(F.w_gate + (size_t)D * FF, D, FF, (bf16*)(ws + WS_GU1), 0, F.ffn_norm + D, scr, r, F.lane); continue; } r -= I_G;
        if (r < I_G) { p0_transpose_item<1>(F.w_up + (size_t)D * FF, D, FF, (bf16*)(ws + WS_GU1), 128, F.ffn_norm + D, scr, r, F.lane); continue; } r -= I_G;
        if (r < I_DN) { p0_transpose_item<0>(F.w_down, FF, D, (bf16*)(ws + WS_D0), 0, nullptr, scr, r, F.lane); continue; } r -= I_DN;
        if (r < I_DN) { p0_transpose_item<0>(F.w_down + (size_t)FF * D, FF, D, (bf16*)(ws + WS_D1), 0, nullptr, scr, r, F.lane); continue; } r -= I_DN;
        if (r < 3 * I_BIN) {
            const int nblk = 3 * D / 32, nb = r % nblk, n0 = 32 * nb, part = n0 / D;
            const int kb = r / nblk, k0 = 64 * kb; const float* W = F.b_w_in; bf16* WT = (bf16*)(ws + WS_BIN); const float* gain = F.mix_norm + D;
#pragma unroll 8
            for (int i = 0; i < 32; ++i) { const int kk = 2 * i + (F.lane >> 5); scr[kk * 33 + (F.lane & 31)] = W[(size_t)(k0 + kk) * (3 * D) + n0 + (F.lane & 31)] * gain[k0 + kk]; }
            LDS_WAIT(); asm volatile("" ::: "memory");
            const int e0 = n0 - part * D;
            const int rbase = (part == 0) ? (2048 + e0) : (256 * (e0 / 128) + (e0 % 128) + (part == 2 ? 128 : 0));
            const int c = F.lane & 7;
#pragma unroll
            for (int j = 0; j < 4; ++j) { const int n = (F.lane >> 3) + 8 * j; const LAS float* s = scr + (8 * c) * 33 + n;
                v4u o; o.x = pk2(s[0 * 33], s[1 * 33]); o.y = pk2(s[2 * 33], s[3 * 33]); o.z = pk2(s[4 * 33], s[5 * 33]); o.w = pk2(s[6 * 33], s[7 * 33]);
                *(GAS v4u*)(WT + (size_t)(rbase + n) * D + k0 + 8 * c) = o; }
            LDS_WAIT(); asm volatile("" ::: "memory");
            continue; } r -= 3 * I_BIN;
        p0_transpose_item<0>(F.b_w_out, D, D, (bf16*)(ws + WS_BOUT), 0, nullptr, scr, r, F.lane);
    }
    { const int gt = (F.vcu * NWAVES + F.wave) * 64 + F.lane, NGT = NGW * 64; bf16* o = (bf16*)(ws + WS_WS);
      for (int i = gt; i < NH * CH * CH / 2; i += NGT) { const int e = 2 * i, t = (e / CH) % CH, s = e % CH; const float a = F.a_w_s[e], b = F.a_w_s[e + 1];
          ((GAS unsigned*)o)[i] = pk2(s <= t ? a : 0.f, (s + 1) <= t ? b : 0.f); } }
    for (int m = gw; m < M; m += NGW) {
        const GAS f32x4* xr = (const GAS f32x4*)(F.x + (size_t)m * D) + F.lane;
        f32x4 v[4]; float s = 0.f;
#pragma unroll
        for (int j = 0; j < 4; ++j) { v[j] = xr[64 * j]; s += (v[j].x * v[j].x + v[j].y * v[j].y) + (v[j].z * v[j].z + v[j].w * v[j].w); }
        const float rstd = 1.f / sqrtf(wave_sum(s) * (1.f / D) + pg8::RMS_EPS);
        GAS unsigned long long* o8 = (GAS unsigned long long*)((bf16*)(ws + WS_XB) + (size_t)m * D) + F.lane;
#pragma unroll
        for (int j = 0; j < 4; ++j) o8[64 * j] = (unsigned long long)pk2(v[j].x * rstd, v[j].y * rstd) | ((unsigned long long)pk2(v[j].z * rstd, v[j].w * rstd) << 32);
    }
}

constexpr int SG_PITCH = 272;
constexpr int SG_W = 0, SG_V = 128 * SG_PITCH, SG_ST = 2 * 128 * SG_PITCH;
__device__ __forceinline__ void sgu_phase(Frame& F) {
    LAS unsigned char* lds = F.lds;
    const int tid = F.tid, lane = F.lane, w = F.wave, fr = lane & 15, fq = lane >> 4;
    bf16* U = (bf16*)(F.ws + WS_U); const bf16* VT = (const bf16*)(F.ws + WS_VT); const bf16* WSB = (const bf16*)(F.ws + WS_WS);
    const f32x2* vst = (const f32x2*)(F.ws + WS_VST);
    for (int chunk = F.vcu; chunk < M / CH; chunk += F.G) {
        const int t0 = chunk * CH;
        if (tid < CH) { const f32x4* p = (const f32x4*)(vst + (size_t)(t0 + tid) * 16); float s = 0.f, q = 0.f;
#pragma unroll
            for (int i = 0; i < 8; ++i) { const f32x4 a = p[i]; s += a[0] + a[2]; q += a[1] + a[3]; }
            const float mean = s * (1.f / EA); const float var = q * (1.f / EA) - mean * mean;
            ((LAS f32x2*)(lds + SG_ST))[tid] = (f32x2){mean, 1.f / sqrtf(var + LN_EPS)}; }
        __syncthreads();
        for (int h = 0; h < NH; ++h) {
#pragma unroll
            for (int i = 0; i < 4; ++i) { const int p = tid + 512 * i, r = p >> 4, cs = p & 15;
                const v4u wv = *(const GAS v4u*)(WSB + (size_t)h * CH * CH + r * CH + cs * 8);
                *(LAS v4u*)(lds + SG_W + r * SG_PITCH + cs * 16) = wv; }
#pragma unroll
            for (int i = 0; i < 4; ++i) { const int p = tid + 512 * i, r = p >> 4, cs = p & 15; const int c = h * CH + r;
                const v4u vv = *(const GAS v4u*)(VT + (size_t)c * M + t0 + cs * 8);
                const float g = F.a_v_gain[c], b = F.a_v_bias[c];
                const LAS f32x2* st = (const LAS f32x2*)(lds + SG_ST) + cs * 8;
                float o[8]; const unsigned wd[4] = {vv.x, vv.y, vv.z, vv.w};
#pragma unroll
                for (int k = 0; k < 4; ++k) { const f32x2 s0 = st[2 * k], s1 = st[2 * k + 1];
                    o[2 * k] = (bflo(wd[k]) - s0.x) * s0.y * g + b; o[2 * k + 1] = (bfhi(wd[k]) - s1.x) * s1.y * g + b; }
                v4u ov; ov.x = pk2(o[0], o[1]); ov.y = pk2(o[2], o[3]); ov.z = pk2(o[4], o[5]); ov.w = pk2(o[6], o[7]);
                *(LAS v4u*)(lds + SG_V + r * SG_PITCH + cs * 16) = ov; }
            __syncthreads();
            f32x4 acc[4][2];
#pragma unroll
            for (int g = 0; g < 4; ++g) { acc[g][0] = (f32x4){0.f, 0.f, 0.f, 0.f}; acc[g][1] = (f32x4){0.f, 0.f, 0.f, 0.f}; }
            const int kmax = (16 * w + 15) / 32;
            for (int kk = 0; kk <= kmax; ++kk) {
                const bf16x8 a = *(const LAS bf16x8*)(lds + SG_W + (16 * w + fr) * SG_PITCH + kk * 64 + fq * 16);
#pragma unroll
                for (int g = 0; g < 4; ++g)
#pragma unroll
                    for (int n = 0; n < 2; ++n) { const int crow = 32 * g + 8 * (fr >> 2) + 4 * n + (fr & 3);
                        const bf16x8 b = *(const LAS bf16x8*)(lds + SG_V + crow * SG_PITCH + kk * 64 + fq * 16);
                        acc[g][n] = __builtin_amdgcn_mfma_f32_16x16x32_bf16(b, a, acc[g][n], 0, 0, 0); }
            }
            const int t = 16 * w + fr; const float bs = F.a_b_s[h * CH + t];
            bf16* up = U + (size_t)(t0 + t) * EA + h * CH + 8 * fq;
#pragma unroll
            for (int g = 0; g < 4; ++g) { const v4u uv = *(const GAS v4u*)(up + 32 * g);
                v4u ov; ov.x = pk2(bflo(uv.x) * (acc[g][0][0] + bs), bfhi(uv.x) * (acc[g][0][1] + bs)); ov.y = pk2(bflo(uv.y) * (acc[g][0][2] + bs), bfhi(uv.y) * (acc[g][0][3] + bs));
                ov.z = pk2(bflo(uv.z) * (acc[g][1][0] + bs), bfhi(uv.z) * (acc[g][1][1] + bs)); ov.w = pk2(bflo(uv.w) * (acc[g][1][2] + bs), bfhi(uv.w) * (acc[g][1][3] + bs));
                *(GAS v4u*)(up + 32 * g) = ov; }
            __syncthreads();
        }
    }
}

__device__ __forceinline__ void conv_phase(Frame& F) {
    const bf16* Z = (const bf16*)(F.ws + WS_Z); const bf16* BG = (const bf16*)(F.ws + WS_BG); bf16* YC = (bf16*)(F.ws + WS_YC);
    const int gt = F.vcu * 512 + F.tid, NGT = F.G * 512;
    for (int i = gt; i < M * (D / 8); i += NGT) {
        const int row = i >> 7, c8 = (i & 127) * 8, tpos = row & (SEQ - 1);
        const size_t off = (size_t)row * D + c8;
        const v4u z2 = *(const GAS v4u*)(Z + off), bg = *(const GAS v4u*)(BG + off);
        v4u z1 = (v4u){0u, 0u, 0u, 0u}, z0 = (v4u){0u, 0u, 0u, 0u};
        if (tpos >= 1) z1 = *(const GAS v4u*)(Z + off - D);
        if (tpos >= 2) z0 = *(const GAS v4u*)(Z + off - 2 * D);
        const f32x4 w0a = *(const GAS f32x4*)(F.b_conv_w + c8), w0b = *(const GAS f32x4*)(F.b_conv_w + c8 + 4);
        const f32x4 w1a = *(const GAS f32x4*)(F.b_conv_w + D + c8), w1b = *(const GAS f32x4*)(F.b_conv_w + D + c8 + 4);
        const f32x4 w2a = *(const GAS f32x4*)(F.b_conv_w + 2 * D + c8), w2b = *(const GAS f32x4*)(F.b_conv_w + 2 * D + c8 + 4);
        const unsigned a0[4] = {z0.x, z0.y, z0.z, z0.w}, a1[4] = {z1.x, z1.y, z1.z, z1.w}, a2[4] = {z2.x, z2.y, z2.z, z2.w}, ab[4] = {bg.x, bg.y, bg.z, bg.w};
        const float w0[8] = {w0a[0], w0a[1], w0a[2], w0a[3], w0b[0], w0b[1], w0b[2], w0b[3]}, w1[8] = {w1a[0], w1a[1], w1a[2], w1a[3], w1b[0], w1b[1], w1b[2], w1b[3]}, w2[8] = {w2a[0], w2a[1], w2a[2], w2a[3], w2b[0], w2b[1], w2b[2], w2b[3]};
        unsigned o[4];
#pragma unroll
        for (int k = 0; k < 4; ++k) {
            const float lo = bflo(ab[k]) * (bflo(a0[k]) * w0[2 * k] + bflo(a1[k]) * w1[2 * k] + bflo(a2[k]) * w2[2 * k]);
            const float hi = bfhi(ab[k]) * (bfhi(a0[k]) * w0[2 * k + 1] + bfhi(a1[k]) * w1[2 * k + 1] + bfhi(a2[k]) * w2[2 * k + 1]);
            o[k] = pk2(lo, hi); }
        *(GAS v4u*)(YC + off) = (v4u){o[0], o[1], o[2], o[3]};
    }
}
__device__ __forceinline__ void final_norm_phase(Frame& F) {
    const int gw = F.vcu * NWAVES + F.wave, NGW = F.G * NWAVES; const float* ss = (const float*)(F.ws + WS_SS);
    for (int m = gw; m < M; m += NGW) {
        float s = (F.lane < 16) ? ss[(size_t)m * 16 + F.lane] : 0.f;
        s = wave_sum(s);
        const float rstd = 1.f / sqrtf(s * (1.f / D) + pg8::RMS_EPS);
        GAS f32x4* xr = (GAS f32x4*)(F.out + (size_t)m * D) + F.lane; const GAS f32x4* gr = (const GAS f32x4*)F.final_norm + F.lane;
#pragma unroll
        for (int j = 0; j < 4; ++j) { const f32x4 v = xr[64 * j], g = gr[64 * j]; xr[64 * j] = v * rstd * g; }
    }
}

struct Args { const float* in[16]; float* out; unsigned char* ws; int ph_lo, ph_hi; };
__global__ void __launch_bounds__(NWAVES * 64, 2) hybrid_fwd(Args args) {
    extern __shared__ __attribute__((aligned(16))) unsigned char lds[];
    cg::grid_group grid = cg::this_grid();
    Frame F;
    F.lds = (LAS unsigned char*)lds;
    F.tid = threadIdx.x; F.lane = F.tid & 63; F.wave = __builtin_amdgcn_readfirstlane(F.tid >> 6);
    F.G = gridDim.x; { const int bx = blockIdx.x; F.vcu = (F.G % 8 == 0) ? (bx % 8) * (F.G / 8) + bx / 8 : bx; }
    F.x = args.in[0]; F.mix_norm = args.in[1]; F.ffn_norm = args.in[2]; F.a_w_in = args.in[3]; F.a_v_gain = args.in[4]; F.a_v_bias = args.in[5]; F.a_w_s = args.in[6]; F.a_b_s = args.in[7];
    F.a_w_out = args.in[8]; F.b_w_in = args.in[9]; F.b_conv_w = args.in[10]; F.b_w_out = args.in[11]; F.w_gate = args.in[12]; F.w_up = args.in[13]; F.w_down = args.in[14]; F.final_norm = args.in[15];
    F.out = args.out; F.ws = args.ws;
    unsigned char* ws = args.ws;
    const int lo = args.ph_lo, hi = args.ph_hi;
#define IN(k) (lo <= (k) && (k) < hi)
#define SEAM(k) do { if (IN(k) && IN((k) + 1)) grid.sync(); } while (0)
    pg8::bf16_t* XB = (pg8::bf16_t*)(ws + WS_XB); float* SS = (float*)(ws + WS_SS);
    const int c = (int)blockIdx.x;

    if (IN(0)) { p0_prologue(F); __syncthreads(); } SEAM(0);

    if (IN(1)) {
        { pg8::Gemm g{XB, (const pg8::bf16_t*)(ws + WS_AIN), M, EA, D}; pg8::StaticOrder S; S.init(M, EA, F.G, c);
          pg8::EpiGelu E{(pg8::bf16_t*)(ws + WS_U), EA};
          pg8::gemm_phase<pg8::EpiGelu, pg8::StaticOrder, true, true>(F.lds, g, S, E); }
        { pg8::Gemm g{(const pg8::bf16_t*)(ws + WS_AIN) + (size_t)EA * D, XB, EA, M, D}; pg8::StaticOrder S; S.init(EA, M, F.G, c);
          pg8::EpiGeluT E{(pg8::bf16_t*)(ws + WS_VT), M, (pg8::f32x2*)(ws + WS_VST)};
          pg8::gemm_phase<pg8::EpiGeluT, pg8::StaticOrder, true, true>(F.lds, g, S, E); }
    } SEAM(1);

    if (IN(2)) { sgu_phase(F); } SEAM(2);

    if (IN(3)) {
        pg8::Gemm g{(const pg8::bf16_t*)(ws + WS_U), (const pg8::bf16_t*)(ws + WS_AOUT), M, D, EA}; pg8::StaticOrder S; S.init(M, D, F.G, c);
        pg8::EpiRes E{F.x, F.out, XB, SS};
        pg8::gemm_phase<pg8::EpiRes, pg8::StaticOrder, true, true>(F.lds, g, S, E);
    } SEAM(3);

    if (IN(4)) {
        pg8::Gemm g{XB, (const pg8::bf16_t*)(ws + WS_GU0), M, 2 * FF, D}; pg8::StaticOrder S; S.init(M, 2 * FF, F.G, c);
        pg8::EpiSwiglu E{(pg8::bf16_t*)(ws + WS_A), FF, SS};
        pg8::gemm_phase<pg8::EpiSwiglu, pg8::StaticOrder, true, true>(F.lds, g, S, E);
    } SEAM(4);

    if (IN(5)) {
        pg8::Gemm g{(const pg8::bf16_t*)(ws + WS_A), (const pg8::bf16_t*)(ws + WS_D0), M, D, FF}; pg8::StaticOrder S; S.init(M, D, F.G, c);
        pg8::EpiRes E{F.out, F.out, XB, SS};
        pg8::gemm_phase<pg8::EpiRes, pg8::StaticOrder, true, true>(F.lds, g, S, E);
    } SEAM(5);

    if (IN(6)) {
        pg8::Gemm g{XB, (const pg8::bf16_t*)(ws + WS_BIN), M, 3 * D, D}; pg8::StaticOrder S; S.init(M, 3 * D, F.G, c);
        pg8::EpiConvIn E{(pg8::bf16_t*)(ws + WS_Z), (pg8::bf16_t*)(ws + WS_BG), SS};
        pg8::gemm_phase<pg8::EpiConvIn, pg8::StaticOrder, true, true>(F.lds, g, S, E);
    } SEAM(6);

    if (IN(7)) { conv_phase(F); } SEAM(7);

    if (IN(8)) {
        pg8::Gemm g{(const pg8::bf16_t*)(ws + WS_YC), (const pg8::bf16_t*)(ws + WS_BOUT), M, D, D}; pg8::StaticOrder S; S.init(M, D, F.G, c);
        pg8::EpiRes E{F.out, F.out, XB, SS};
        pg8::gemm_phase<pg8::EpiRes, pg8::StaticOrder, true, true>(F.lds, g, S, E);
    } SEAM(8);

    if (IN(9)) {
        pg8::Gemm g{XB, (const pg8::bf16_t*)(ws + WS_GU1), M, 2 * FF, D}; pg8::StaticOrder S; S.init(M, 2 * FF, F.G, c);
        pg8::EpiSwiglu E{(pg8::bf16_t*)(ws + WS_A), FF, SS};
        pg8::gemm_phase<pg8::EpiSwiglu, pg8::StaticOrder, true, true>(F.lds, g, S, E);
    } SEAM(9);

    if (IN(10)) {
        pg8::Gemm g{(const pg8::bf16_t*)(ws + WS_A), (const pg8::bf16_t*)(ws + WS_D1), M, D, FF}; pg8::StaticOrder S; S.init(M, D, F.G, c);
        pg8::EpiRes E{F.out, F.out, XB, SS};
        pg8::gemm_phase<pg8::EpiRes, pg8::StaticOrder, true, true>(F.lds, g, S, E);
    } SEAM(10);

    if (IN(11)) { final_norm_phase(F); }
#undef IN
#undef SEAM
}

extern "C" void kernel_launch(void* const* d_in, const int* in_sizes, int n_in, void* d_out, int out_size, void* d_ws, size_t ws_size, hipStream_t stream) {
    static int grid = 0;
    if (grid == 0) {
        if (n_in != 16 || in_sizes[0] != M * D || out_size != M * D || ws_size < WS_END) { fprintf(stderr, "kernel_launch: unexpected shapes (n_in %d, in0 %d, out %d, ws %zu); nothing launched\n", n_in, n_in > 0 ? in_sizes[0] : -1, out_size, ws_size); grid = -1; return; }
        int dev = 0, cus = 0, per_cu = 0;
        if (hipGetDevice(&dev) != hipSuccess || hipDeviceGetAttribute(&cus, hipDeviceAttributeMultiprocessorCount, dev) != hipSuccess) { grid = -1; return; }
        if (hipFuncSetAttribute((const void*)hybrid_fwd, hipFuncAttributeMaxDynamicSharedMemorySize, LDS_BYTES) != hipSuccess) { fprintf(stderr, "kernel_launch: hipFuncSetAttribute failed\n"); grid = -1; return; }
        if (hipOccupancyMaxActiveBlocksPerMultiprocessor(&per_cu, (const void*)hybrid_fwd, NWAVES * 64, LDS_BYTES) != hipSuccess || per_cu < 1) { fprintf(stderr, "kernel_launch: occupancy query says %d blocks per CU\n", per_cu); per_cu = 1; }
        (void)hipGetLastError();
        grid = cus;
    }
    if (grid < 0) return;
    Args a{};
    for (int i = 0; i < 16; ++i) a.in[i] = (const float*)d_in[i];
    a.out = (float*)d_out; a.ws = (unsigned char*)d_ws;
#if MK_ONE_LAUNCH
    a.ph_lo = 0; a.ph_hi = N_PHASES;
    void* kargs[] = {&a};
    const hipError_t e = hipLaunchCooperativeKernel((const void*)hybrid_fwd, dim3(grid), dim3(NWAVES * 64), kargs, LDS_BYTES, stream);
    if (e != hipSuccess) fprintf(stderr, "kernel_launch: cooperative launch failed: %s (grid %d)\n", hipGetErrorString(e), grid);
#else
    for (int p = 0; p < N_PHASES; ++p) { a.ph_lo = p; a.ph_hi = p + 1; hipLaunchKernelGGL(hybrid_fwd, dim3(grid), dim3(NWAVES * 64), LDS_BYTES, stream, a); }
#endif
}
```

```cpp
#include <hip/hip_runtime.h>
#include <hip/hip_cooperative_groups.h>
#include <cstdio>
#include <cstdint>
namespace cg = cooperative_groups;

namespace pg8 {
#define PG8_LAS __attribute__((address_space(3)))
typedef unsigned short bf16_t;
typedef short bf16x8 __attribute__((ext_vector_type(8)));
typedef float f32x4 __attribute__((ext_vector_type(4)));
typedef unsigned u32x4 __attribute__((ext_vector_type(4)));
constexpr int BM = 256, BK = 64, HALF = 128, HTB = HALF * BK * 2  , STAGE_BYTES = 8 * HTB, NXCD = 8, WGM = 8;

__host__ __device__ __forceinline__ int lds_byte(int r, int c) { const int st = (r >> 4) * 2 + (c >> 5), rr = r & 15, cc = c & 31, ob = rr * 64 + cc * 2; return st * 1024 + (ob ^ (((ob >> 9) & 1) << 5)); }
__host__ __device__ __forceinline__ void stage_rc(int b, int& R, int& C) { const int st = b / 1024, sb = b % 1024, swz = sb ^ (((sb >> 9) & 1) << 5); R = (st >> 1) * 16 + swz / 64; C = (st & 1) * 32 + (swz % 64) / 2; }
__host__ __device__ __forceinline__ int perm32(int rho) { const int n = rho >> 4, i = rho & 15; return 8 * (i >> 2) + 4 * n + (i & 3); }

struct Unit { int pm, pn; };
struct Gemm { const bf16_t* A; const bf16_t* Bt; int M, N, K; };

struct StaticOrder {
    int nM, nN, nwg, G, c;
    __host__ __device__ void init(int M, int N, int G_, int c_) { nM = M / BM; nN = N / BM; nwg = nM * nN; G = G_; c = c_; }
    __host__ __device__ bool next(int i, Unit& u) const {
        const long L = (long)i * G + c; if (L >= nwg) return false;
        int wgid = (int)L; { const int q = nwg / NXCD, r = nwg % NXCD, xcd = wgid % NXCD, off = wgid / NXCD; wgid = (xcd < r ? xcd * (q + 1) : r * (q + 1) + (xcd - r) * q) + off; }
        const int nig = WGM * nN, gid = wgid / nig, fm = gid * WGM, gsz = (nM - fm) < WGM ? (nM - fm) : WGM;
        u.pm = fm + ((wgid % nig) % gsz); u.pn = (wgid % nig) / gsz; return true;
    }
    __device__ __forceinline__ void a_ready(const Unit&) const {}
    __device__ __forceinline__ void done(const Unit&) const {}
};

__device__ __forceinline__ unsigned cvt_pk_bf16(float lo, float hi) { unsigned r; asm volatile("v_cvt_pk_bf16_f32 %0, %1, %2" : "=v"(r) : "v"(lo), "v"(hi)); return r; }
typedef float f32x2 __attribute__((ext_vector_type(2)));
typedef unsigned u32x2 __attribute__((ext_vector_type(2)));
constexpr float RMS_EPS = 1e-6f;
__device__ __forceinline__ float gelu_tanh(float v) {
    const float w = v * (1.0f + 0.044715f * v * v);
    const float e = __builtin_amdgcn_exp2f(w * (-2.0f * 0.7978845608028654f * 1.4426950408889634f));
    return v * __builtin_amdgcn_rcpf(1.0f + e);
}
__device__ __forceinline__ float silu_f(float v) {
    const float e = __builtin_amdgcn_exp2f(v * (-1.4426950408889634f));
    return v * __builtin_amdgcn_rcpf(1.0f + e);
}
__device__ __forceinline__ u32x4 pack8(const f32x4 a, const f32x4 b) {
    u32x4 w; w.x = cvt_pk_bf16(a[0], a[1]); w.y = cvt_pk_bf16(a[2], a[3]); w.z = cvt_pk_bf16(b[0], b[1]); w.w = cvt_pk_bf16(b[2], b[3]); return w;
}
__device__ __forceinline__ float row_rstd(const float* ss, int row, int fq) {
    const f32x4 p = *(const f32x4*)(ss + (size_t)row * 16 + fq * 4);
    float s = (p[0] + p[1]) + (p[2] + p[3]);
    s += __shfl_xor(s, 16); s += __shfl_xor(s, 32);
    return 1.0f / sqrtf(s * (1.0f / 1024.0f) + RMS_EPS);
}

struct EpiGelu {
    static constexpr bool PERM = true, AFTER_DRAIN = false;
    bf16_t* O; int ldc;
    __device__ __forceinline__ void operator()(const f32x4 (&acc)[2][2][4][2], const Unit& u, int wr, int wc, int fr, int fq) const {
        const int row0 = u.pm * BM + wr * 64 + fr, col0 = u.pn * BM + wc * 32 + 8 * fq;
#pragma unroll
        for (int ai = 0; ai < 2; ++ai)
#pragma unroll
            for (int m = 0; m < 4; ++m) { bf16_t* rowp = O + (size_t)(row0 + ai * HALF + m * 16) * ldc + col0;
#pragma unroll
                for (int bj = 0; bj < 2; ++bj) { f32x4 v0 = acc[ai][bj][m][0], v1 = acc[ai][bj][m][1];
#pragma unroll
                    for (int e = 0; e < 4; ++e) { v0[e] = gelu_tanh(v0[e]); v1[e] = gelu_tanh(v1[e]); }
                    *(u32x4*)(rowp + bj * HALF) = pack8(v0, v1); } }
    }
};
struct EpiGeluT {
    static constexpr bool PERM = true, AFTER_DRAIN = false;
    bf16_t* O; int ldc; f32x2* vst;
    __device__ __forceinline__ void operator()(const f32x4 (&acc)[2][2][4][2], const Unit& u, int wr, int wc, int fr, int fq) const {
        const int row0 = u.pm * BM + wr * 64 + fr, col0 = u.pn * BM + wc * 32 + 8 * fq;
        float v[32];
#pragma unroll
        for (int i = 0; i < 32; ++i) v[i] = 0.f;
#pragma unroll
        for (int ai = 0; ai < 2; ++ai)
#pragma unroll
            for (int m = 0; m < 4; ++m) { bf16_t* rowp = O + (size_t)(row0 + ai * HALF + m * 16) * ldc + col0;
#pragma unroll
                for (int bj = 0; bj < 2; ++bj) { f32x4 v0 = acc[ai][bj][m][0], v1 = acc[ai][bj][m][1];
#pragma unroll
                    for (int e = 0; e < 4; ++e) { v0[e] = gelu_tanh(v0[e]); v1[e] = gelu_tanh(v1[e]);
                        v[2 * (8 * bj + e)] += v0[e]; v[2 * (8 * bj + e) + 1] += v0[e] * v0[e];
                        v[2 * (8 * bj + 4 + e)] += v1[e]; v[2 * (8 * bj + 4 + e) + 1] += v1[e] * v1[e]; }
                    *(u32x4*)(rowp + bj * HALF) = pack8(v0, v1); } }
#define PG8_XSTEP(H, MASK) { const bool bit = (fr & (MASK)) != 0; _Pragma("unroll") for (int i = 0; i < (H); ++i) { const float send = bit ? v[i] : v[i + (H)]; const float keep = bit ? v[i + (H)] : v[i]; v[i] = keep + __shfl_xor(send, (MASK)); } }
        PG8_XSTEP(16, 8) PG8_XSTEP(8, 4) PG8_XSTEP(4, 2) PG8_XSTEP(2, 1)
#undef PG8_XSTEP
        const int token = u.pn * BM + (fr >> 3) * HALF + wc * 32 + 8 * fq + (fr & 7);
        vst[(size_t)token * 16 + u.pm * 2 + wr] = (f32x2){v[0], v[1]};
    }
};
struct EpiRes {
    static constexpr bool PERM = true, AFTER_DRAIN = false;
    const float* base; float* out; bf16_t* xb; float* ss;
    __device__ __forceinline__ void operator()(const f32x4 (&acc)[2][2][4][2], const Unit& u, int wr, int wc, int fr, int fq) const {
        const int row0 = u.pm * BM + wr * 64 + fr, col0 = u.pn * BM + wc * 32 + 8 * fq;
#pragma unroll
        for (int ai = 0; ai < 2; ++ai)
#pragma unroll
            for (int m = 0; m < 4; ++m) { const int row = row0 + ai * HALF + m * 16; const size_t off = (size_t)row * 1024 + col0; float q = 0.f;
#pragma unroll
                for (int bj = 0; bj < 2; ++bj) {
                    const f32x4 b0 = *(const f32x4*)(base + off + bj * HALF), b1 = *(const f32x4*)(base + off + bj * HALF + 4);
                    const f32x4 o0 = b0 + acc[ai][bj][m][0], o1 = b1 + acc[ai][bj][m][1];
                    *(f32x4*)(out + off + bj * HALF) = o0; *(f32x4*)(out + off + bj * HALF + 4) = o1;
                    q += (o0[0] * o0[0] + o0[1] * o0[1]) + (o0[2] * o0[2] + o0[3] * o0[3]) + (o1[0] * o1[0] + o1[1] * o1[1]) + (o1[2] * o1[2] + o1[3] * o1[3]);
                    *(u32x4*)(xb + off + bj * HALF) = pack8(o0, o1); }
                q += __shfl_xor(q, 16); q += __shfl_xor(q, 32);
                if (fq == 0) ss[(size_t)row * 16 + u.pn * 4 + wc] = q; }
    }
};
struct EpiSwiglu {
    static constexpr bool PERM = true, AFTER_DRAIN = false;
    bf16_t* O; int ldc; const float* ss;
    __device__ __forceinline__ void operator()(const f32x4 (&acc)[2][2][4][2], const Unit& u, int wr, int wc, int fr, int fq) const {
        const int row0 = u.pm * BM + wr * 64 + fr, col0 = u.pn * HALF + wc * 32 + 8 * fq;
#pragma unroll
        for (int ai = 0; ai < 2; ++ai)
#pragma unroll
            for (int m = 0; m < 4; ++m) { const int row = row0 + ai * HALF + m * 16; const float rs = row_rstd(ss, row, fq);
                f32x4 a0, a1;
#pragma unroll
                for (int e = 0; e < 4; ++e) { a0[e] = silu_f(acc[ai][0][m][0][e] * rs) * (acc[ai][1][m][0][e] * rs); a1[e] = silu_f(acc[ai][0][m][1][e] * rs) * (acc[ai][1][m][1][e] * rs); }
                *(u32x4*)(O + (size_t)row * ldc + col0) = pack8(a0, a1); }
    }
};
struct EpiConvIn {
    static constexpr bool PERM = true, AFTER_DRAIN = false;
    bf16_t* Z; bf16_t* BG; const float* ss;
    __device__ __forceinline__ void operator()(const f32x4 (&acc)[2][2][4][2], const Unit& u, int wr, int wc, int fr, int fq) const {
        const int row0 = u.pm * BM + wr * 64 + fr;
        if (u.pn < 8) {
            const int col0 = u.pn * HALF + wc * 32 + 8 * fq;
#pragma unroll
            for (int ai = 0; ai < 2; ++ai)
#pragma unroll
                for (int m = 0; m < 4; ++m) { const int row = row0 + ai * HALF + m * 16; float rs = row_rstd(ss, row, fq); rs = rs * rs;
                    const f32x4 a0 = acc[ai][0][m][0] * acc[ai][1][m][0] * rs, a1 = acc[ai][0][m][1] * acc[ai][1][m][1] * rs;
                    *(u32x4*)(Z + (size_t)row * 1024 + col0) = pack8(a0, a1); }
        } else {
            const int col0 = (u.pn - 8) * BM + wc * 32 + 8 * fq;
#pragma unroll
            for (int ai = 0; ai < 2; ++ai)
#pragma unroll
                for (int m = 0; m < 4; ++m) { const int row = row0 + ai * HALF + m * 16; const float rs = row_rstd(ss, row, fq);
#pragma unroll
                    for (int bj = 0; bj < 2; ++bj) *(u32x4*)(BG + (size_t)row * 1024 + col0 + bj * HALF) = pack8(acc[ai][bj][m][0] * rs, acc[ai][bj][m][1] * rs); }
        }
    }
};

template <class Epi, class Sched, bool ALIGN_EPI = false, bool SP2 = false>
__device__ __forceinline__ void gemm_phase(PG8_LAS unsigned char* lds, const Gemm g, const Sched& S, const Epi& E) {
    const int tid = threadIdx.x, wid = __builtin_amdgcn_readfirstlane(tid >> 6), lane = tid & 63, wr = wid >> 2, wc = wid & 3, fr = lane & 15, fq = lane >> 4;
    const int K = g.K, nt = K / BK;
    unsigned voffA[2], voffB[2];
#pragma unroll
    for (int i = 0; i < 2; ++i) { int R, C; stage_rc(tid * 16 + i * 8192, R, C); const int Rb = Epi::PERM ? ((R & ~31) + perm32(R & 31)) : R;
        voffA[i] = (unsigned)(R * K + C) * 2u; voffB[i] = (unsigned)(Rb * K + C) * 2u; }
    const size_t kstep = (size_t)(BK * 2);
    const size_t hstep = (size_t)HALF * K * 2;
    const size_t tstep = 2 * hstep;
    const unsigned ldsw = (unsigned)wid * 1024u;
    const int aoff = lds_byte(wr * 64 + fr, fq * 8), boff = lds_byte(wc * 32 + fr, fq * 8);
#define PG8_SA(b, h) (((b) * 2 + (h)) * HTB)
#define PG8_SB(b, h) ((4 + (b) * 2 + (h)) * HTB)
#define PG8_STAGE(bufoff, gbase, voff) do { _Pragma("unroll") for (int _i = 0; _i < 2; ++_i) \
        __builtin_amdgcn_global_load_lds((const unsigned*)((const char*)(gbase) + (voff)[_i]), (PG8_LAS unsigned*)(lds + (bufoff) + ldsw + _i * 8192), 16, 0, 0); } while (0)
#define PG8_LDA(dst, b, h) do { _Pragma("unroll") for (int m = 0; m < 4; ++m) _Pragma("unroll") for (int k = 0; k < 2; ++k) dst[m][k] = *(const PG8_LAS bf16x8*)(lds + PG8_SA(b, h) + aoff + m * 2048 + k * 1024); } while (0)
#define PG8_LDB(dst, b, h) do { _Pragma("unroll") for (int n = 0; n < 2; ++n) _Pragma("unroll") for (int k = 0; k < 2; ++k) dst[n][k] = *(const PG8_LAS bf16x8*)(lds + PG8_SB(b, h) + boff + n * 2048 + k * 1024); } while (0)
#define PG8_MMA(ai, bj, At, Bt) do { __builtin_amdgcn_s_setprio(1); _Pragma("unroll") for (int m = 0; m < 4; ++m) _Pragma("unroll") for (int n = 0; n < 2; ++n) _Pragma("unroll") for (int k = 0; k < 2; ++k) \
        acc[ai][bj][m][n] = __builtin_amdgcn_mfma_f32_16x16x32_bf16(Bt[n][k], At[m][k], acc[ai][bj][m][n], 0, 0, 0); __builtin_amdgcn_s_setprio(0); } while (0)
#define PG8_WAIT_V(n) asm volatile("s_waitcnt vmcnt(" #n ")" ::: "memory")
#define PG8_WAIT_L(n) asm volatile("s_waitcnt lgkmcnt(" #n ")" ::: "memory")
#define PG8_BAR __builtin_amdgcn_s_barrier()
#define PG8_SCHED __builtin_amdgcn_sched_barrier(0)
    Unit cur, nxt; int ui = 0;
    if (!S.next(0, cur)) return;
    f32x4 acc[2][2][4][2];
#pragma unroll
    for (int a = 0; a < 2; ++a)
#pragma unroll
        for (int b = 0; b < 2; ++b)
#pragma unroll
            for (int m = 0; m < 4; ++m)
#pragma unroll
                for (int n = 0; n < 2; ++n) acc[a][b][m][n] = (f32x4){0.f, 0.f, 0.f, 0.f};
    bf16x8 At[4][2], B0[2][2], B1[2][2];
    const char* cA = (const char*)g.A + (size_t)cur.pm * tstep; const char* cB = (const char*)g.Bt + (size_t)cur.pn * tstep;
    S.a_ready(cur);
    if constexpr (SP2) {
        PG8_STAGE(PG8_SB(0, 0), cB, voffB); PG8_STAGE(PG8_SB(0, 1), cB + hstep, voffB); PG8_STAGE(PG8_SA(0, 0), cA, voffA); PG8_STAGE(PG8_SA(0, 1), cA + hstep, voffA);
        if (wr == 1) PG8_BAR;
        PG8_WAIT_V(2); PG8_BAR;
        PG8_STAGE(PG8_SB(1, 0), cB + kstep, voffB); PG8_STAGE(PG8_SA(1, 0), cA + kstep, voffA); PG8_STAGE(PG8_SB(1, 1), cB + hstep + kstep, voffB);
        PG8_WAIT_V(6); PG8_BAR;
    } else {
        PG8_STAGE(PG8_SB(0, 0), cB, voffB); PG8_STAGE(PG8_SA(0, 0), cA, voffA); PG8_STAGE(PG8_SB(0, 1), cB + hstep, voffB); PG8_STAGE(PG8_SA(0, 1), cA + hstep, voffA);
        if (wr == 1) PG8_BAR;
        PG8_WAIT_V(4); PG8_BAR;
        PG8_STAGE(PG8_SB(1, 0), cB + kstep, voffB); PG8_STAGE(PG8_SA(1, 0), cA + kstep, voffA); PG8_STAGE(PG8_SB(1, 1), cB + hstep + kstep, voffB);
        PG8_WAIT_V(6); PG8_BAR;
    }
    for (;;) {
        const bool has_next = S.next(ui + 1, nxt);
        const char* nA = has_next ? (const char*)g.A + (size_t)nxt.pm * tstep : cA; const char* nB = has_next ? (const char*)g.Bt + (size_t)nxt.pn * tstep : cB;
        for (int t = 0; t < nt; t += 2) {
            const bool last = (t == nt - 2);
            const char* a1 = cA + (size_t)(t + 1) * kstep;
            const char* a2 = last ? nA : cA + (size_t)(t + 2) * kstep; const char* b2 = last ? nB : cB + (size_t)(t + 2) * kstep;
            const char* a3 = a2 + kstep; const char* b3 = b2 + kstep;
            if (last && has_next) S.a_ready(nxt);
            if constexpr (SP2) {
            PG8_LDB(B0, 0, 0); PG8_LDB(B1, 0, 1); PG8_SCHED; PG8_LDA(At, 0, 0); PG8_STAGE(PG8_SA(1, 1), a1 + hstep, voffA);
            PG8_WAIT_V(8); PG8_WAIT_L(0); PG8_BAR; PG8_MMA(0, 0, At, B0); PG8_MMA(0, 1, At, B1); PG8_BAR; PG8_SCHED;
            PG8_LDA(At, 0, 1); PG8_STAGE(PG8_SB(0, 0), b2, voffB); PG8_STAGE(PG8_SB(0, 1), b2 + hstep, voffB); PG8_STAGE(PG8_SA(0, 0), a2, voffA);
            PG8_WAIT_V(8); PG8_WAIT_L(0); PG8_BAR; PG8_MMA(1, 0, At, B0); PG8_MMA(1, 1, At, B1); PG8_BAR; PG8_SCHED;
            PG8_LDB(B0, 1, 0); PG8_LDB(B1, 1, 1); PG8_SCHED; PG8_LDA(At, 1, 0); PG8_STAGE(PG8_SA(0, 1), a2 + hstep, voffA);
            PG8_WAIT_V(8); PG8_WAIT_L(0); PG8_BAR; PG8_MMA(0, 0, At, B0); PG8_MMA(0, 1, At, B1); PG8_BAR; PG8_SCHED;
            PG8_LDA(At, 1, 1); PG8_STAGE(PG8_SB(1, 0), b3, voffB); PG8_STAGE(PG8_SB(1, 1), b3 + hstep, voffB); PG8_STAGE(PG8_SA(1, 0), a3, voffA);
            PG8_WAIT_V(8); PG8_WAIT_L(0); PG8_BAR; PG8_MMA(1, 0, At, B0); PG8_MMA(1, 1, At, B1); PG8_BAR; PG8_SCHED;
            } else {
            PG8_LDB(B0, 0, 0); PG8_SCHED; PG8_LDA(At, 0, 0); PG8_STAGE(PG8_SA(1, 1), a1 + hstep, voffA);
            PG8_WAIT_L(8); PG8_BAR; PG8_WAIT_L(0); PG8_MMA(0, 0, At, B0); PG8_BAR; PG8_SCHED;
            PG8_LDB(B1, 0, 1); PG8_STAGE(PG8_SB(0, 0), b2, voffB);
            PG8_BAR; PG8_WAIT_L(0); PG8_MMA(0, 1, At, B1); PG8_BAR;
            PG8_LDA(At, 0, 1); PG8_STAGE(PG8_SA(0, 0), a2, voffA);
            PG8_BAR; PG8_WAIT_L(0); PG8_MMA(1, 0, At, B0); PG8_BAR; PG8_SCHED;
            PG8_STAGE(PG8_SB(0, 1), b2 + hstep, voffB);
            PG8_WAIT_V(6); PG8_BAR; PG8_MMA(1, 1, At, B1); PG8_BAR;
            PG8_LDB(B0, 1, 0); PG8_SCHED; PG8_LDA(At, 1, 0); PG8_STAGE(PG8_SA(0, 1), a2 + hstep, voffA);
            PG8_WAIT_L(8); PG8_BAR; PG8_WAIT_L(0); PG8_MMA(0, 0, At, B0); PG8_BAR; PG8_SCHED;
            PG8_LDB(B1, 1, 1); PG8_STAGE(PG8_SB(1, 0), b3, voffB);
            PG8_BAR; PG8_WAIT_L(0); PG8_MMA(0, 1, At, B1); PG8_BAR;
            PG8_LDA(At, 1, 1); PG8_STAGE(PG8_SA(1, 0), a3, voffA);
            PG8_BAR; PG8_WAIT_L(0); PG8_MMA(1, 0, At, B0); PG8_BAR; PG8_SCHED;
            PG8_STAGE(PG8_SB(1, 1), b3 + hstep, voffB);
            PG8_WAIT_V(6); PG8_BAR; PG8_MMA(1, 1, At, B1); PG8_BAR;
            }
        }
        if constexpr (ALIGN_EPI) { if (wr == 0) PG8_BAR; }
        if constexpr (!Epi::AFTER_DRAIN) { E(acc, cur, wr, wc, fr, fq); S.done(cur); }
        if (!has_next) break;
#pragma unroll
        for (int a = 0; a < 2; ++a)
#pragma unroll
            for (int b = 0; b < 2; ++b)
#pragma unroll
                for (int m = 0; m < 4; ++m)
#pragma unroll
                    for (int n = 0; n < 2; ++n) acc[a][b][m][n] = (f32x4){0.f, 0.f, 0.f, 0.f};
        cur = nxt; cA = nA; cB = nB; ++ui;
        if constexpr (ALIGN_EPI) { if (wr == 1) PG8_BAR; }
    }
    PG8_WAIT_V(0);
    if constexpr (!ALIGN_EPI) { if (wr == 0) PG8_BAR; }
    PG8_BAR;
    if constexpr (Epi::AFTER_DRAIN) { E.fused(acc, cur, wr, wc, fr, fq, lds, wid, lane); S.done(cur); }
#undef PG8_SA
#undef PG8_SB
#undef PG8_STAGE
#undef PG8_LDA
#undef PG8_LDB
#undef PG8_MMA
#undef PG8_WAIT_V
#undef PG8_WAIT_L
#undef PG8_BAR
#undef PG8_SCHED
}
}

constexpr int NWAVES = 8;
constexpr int SEQ = 2048, D = 1024, M = 16 * SEQ;
constexpr int EA = 2048, NH = 16, CH = 128;
constexpr int FF = 2816;
constexpr float LN_EPS = 1e-6f;
#ifndef MK_ONE_LAUNCH
#define MK_ONE_LAUNCH 1
#endif
constexpr int N_PHASES = 12;

constexpr size_t MiB = 1u << 20;
constexpr size_t WS_AIN = 2 * MiB, WS_AOUT = 10 * MiB, WS_WS = 14 * MiB, WS_GU0 = 15 * MiB, WS_D0 = 26 * MiB, WS_GU1 = 32 * MiB, WS_D1 = 43 * MiB, WS_BIN = 49 * MiB, WS_BOUT = 55 * MiB;
constexpr size_t WS_SS = 58 * MiB, WS_VST = 60 * MiB;
constexpr size_t WS_XB = 64 * MiB;
constexpr size_t WS_U = 128 * MiB, WS_VT = 256 * MiB;
constexpr size_t WS_A = 128 * MiB;
constexpr size_t WS_YC = 304 * MiB, WS_Z = 384 * MiB, WS_BG = 448 * MiB, WS_END = 512 * MiB;
constexpr size_t WS_Y = 384 * MiB;
static_assert(WS_A + (size_t)M * FF * 2 <= WS_YC && WS_YC + (size_t)M * D * 2 <= WS_Z && WS_BG + (size_t)M * D * 2 <= WS_END, "d_ws map");
static_assert(WS_GU0 + (size_t)2 * FF * D * 2 <= WS_D0 && WS_D0 + (size_t)FF * D * 2 <= WS_GU1 && WS_D1 + (size_t)FF * D * 2 <= WS_BIN, "weight map");

constexpr int RING_BYTES = 131072, LDSCTL_OFF = RING_BYTES, MISC_OFF = LDSCTL_OFF + 320, LDS_BYTES = 147456;
constexpr size_t WS_CTL = 0, CTL_ZERO_BYTES = 65536;
constexpr int CW_BAR = 4096;

#define GAS __attribute__((address_space(1)))
#define LAS __attribute__((address_space(3)))
typedef unsigned short bf16;
typedef unsigned v4u __attribute__((ext_vector_type(4)));
typedef unsigned v2u __attribute__((ext_vector_type(2)));
typedef float f32x4 __attribute__((ext_vector_type(4)));
typedef float f32x2 __attribute__((ext_vector_type(2)));
typedef short bf16x8 __attribute__((ext_vector_type(8)));
#define LDS_WAIT() asm volatile("s_waitcnt lgkmcnt(0)" ::: "memory")
__device__ __forceinline__ unsigned f2bf(float f) { unsigned u = __builtin_bit_cast(unsigned, f); return (u + 0x7fffu + ((u >> 16) & 1u)) >> 16; }
__device__ __forceinline__ unsigned pk2(float lo, float hi) { return f2bf(lo) | (f2bf(hi) << 16); }
__device__ __forceinline__ float bflo(unsigned w) { return __builtin_bit_cast(float, w << 16); }
__device__ __forceinline__ float bfhi(unsigned w) { return __builtin_bit_cast(float, w & 0xffff0000u); }

typedef GAS unsigned gu32;
#define RLX_AGENT __ATOMIC_RELAXED, __HIP_MEMORY_SCOPE_AGENT
#define XB_TMO      128
#define XB_XCNT(j)  (256  + 64 * (j))
#define XB_XSUB(j)  (1280 + 64 * (j))
#define XB_XGEN(j)  (2304 + 64 * (j))
#define XB_TOP      3328
#define XB_TOPGEN   3392
#define XCD_BAR_WORDS 3456
#define XB_SPIN_CAP (1u << 18)

__device__ __forceinline__ unsigned xb_ld(unsigned* p)              { return __hip_atomic_load(p, __ATOMIC_RELAXED, __HIP_MEMORY_SCOPE_AGENT); }
__device__ __forceinline__ unsigned xb_add(unsigned* p, unsigned v) { return __hip_atomic_fetch_add(p, v, __ATOMIC_RELAXED, __HIP_MEMORY_SCOPE_AGENT); }
__device__ __forceinline__ unsigned xb_xcc_id() { return (unsigned)__builtin_amdgcn_s_getreg((3 << 11) | 20) & 0xFu; }
#define XB_SPIN(cond, bar) do { unsigned _sp = 0; while (cond) { __builtin_amdgcn_s_sleep(1); \
    if ((++_sp & 255u) == 0u) { if (xb_ld(&(bar)[XB_TMO])) break; if (_sp > XB_SPIN_CAP) { atomicAdd(&(bar)[XB_TMO], 1u); break; } } } } while (0)

struct XcdBarrier {
    unsigned* bar; unsigned x;
    volatile LAS unsigned* st;
};

__device__ __forceinline__ XcdBarrier xcd_barrier_post(unsigned* bar, volatile LAS unsigned* st) {
    XcdBarrier b; b.bar = bar; b.x = xb_xcc_id(); b.st = st;
    if (threadIdx.x == 0) (void)xb_add(&bar[XB_XCNT(b.x)], 1u);
    return b;
}
__device__ __forceinline__ void xcd_barrier_complete(unsigned* bar, unsigned x, unsigned& nloc, unsigned& nx) {
    const unsigned G = gridDim.x * gridDim.y * gridDim.z;
    unsigned sum, cnt, mine, sp = 0u;
    for (;;) {
        sum = 0u; cnt = 0u; mine = 0u;
#pragma unroll
        for (unsigned j = 0; j < 16; ++j) { const unsigned c = xb_ld(&bar[XB_XCNT(j)]); sum += c; cnt += (c > 0u) ? 1u : 0u; mine = (j == x) ? c : mine; }
        if (sum == G) break;
        __builtin_amdgcn_s_sleep(1);
        if ((++sp & 255u) == 0u) { if (xb_ld(&bar[XB_TMO])) break; if (sp > XB_SPIN_CAP) { atomicAdd(&bar[XB_TMO], 1u); break; } }
    }
    nloc = mine > 0u ? mine : 1u; nx = cnt > 0u ? cnt : 1u;
}

__device__ __forceinline__ void xcd_barrier(const XcdBarrier& b) {
    asm volatile("s_waitcnt vmcnt(0)" ::: "memory");
    __syncthreads();
    if (threadIdx.x == 0) {
        unsigned* bar = b.bar;
        __builtin_amdgcn_s_waitcnt(0);
        unsigned nloc = b.st[0], nx = b.st[1];
        if (nloc == 0u) { xcd_barrier_complete(bar, b.x, nloc, nx); b.st[0] = nloc; b.st[1] = nx; }
        const unsigned old = xb_add(&bar[XB_XSUB(b.x)], 1u);
        const unsigned gen = old / nloc;
        if (old + 1u == (gen + 1u) * nloc) {
            __builtin_amdgcn_fence(__ATOMIC_RELEASE, "agent");
            asm volatile("s_waitcnt vmcnt(0)" ::: "memory");
            const unsigned og = xb_add(&bar[XB_TOP], 1u);
            const unsigned tg = og / nx;
            if (og + 1u == (tg + 1u) * nx) xb_add(&bar[XB_TOPGEN], 1u);
            else XB_SPIN(xb_ld(&bar[XB_TOPGEN]) == tg, bar);
            __builtin_amdgcn_fence(__ATOMIC_ACQUIRE, "agent");
            xb_add(&bar[XB_XGEN(b.x)], 1u);
            asm volatile("s_waitcnt vmcnt(0)" ::: "memory");
        } else {
            XB_SPIN(xb_ld(&bar[XB_XGEN(b.x)]) == gen, bar);
            __builtin_amdgcn_fence(__ATOMIC_ACQUIRE, "agent");
            asm volatile("s_waitcnt vmcnt(0)" ::: "memory");
        }
    }
    __syncthreads();
}

struct Frame {
    LAS unsigned char* lds;
    int tid, lane, wave, vcu, G;
    const float *x, *mix_norm, *ffn_norm, *a_w_in, *a_v_gain, *a_v_bias, *a_w_s, *a_b_s, *a_w_out, *b_w_in, *b_conv_w, *b_w_out, *w_gate, *w_up, *w_down, *final_norm;
    float* out; unsigned char* ws;
};

__device__ __forceinline__ float wave_sum(float v) {
#pragma unroll
    for (int o = 1; o < 64; o <<= 1) v += __shfl_xor(v, o);
    return v;
}
template <int MODE> __device__ __forceinline__ void p0_transpose_item(const float* W, int K, int N, bf16* WT, int row_off, const float* gain, LAS float* scr, int item, int lane) {
    const int nblk = N / 32, kb = item / nblk, nb = item % nblk, k0 = 64 * kb, n0 = 32 * nb;
#pragma unroll 8
    for (int i = 0; i < 32; ++i) { const int kk = 2 * i + (lane >> 5); float w = W[(size_t)(k0 + kk) * N + n0 + (lane & 31)]; if (gain) w *= gain[k0 + kk]; scr[kk * 33 + (lane & 31)] = w; }
    LDS_WAIT(); asm volatile("" ::: "memory");
    const int c = lane & 7;
    const int rbase = (MODE == 0) ? (row_off + n0) : (row_off + 256 * (n0 / 128) + (n0 % 128));
#pragma unroll
    for (int j = 0; j < 4; ++j) { const int n = (lane >> 3) + 8 * j; const LAS float* s = scr + (8 * c) * 33 + n;
        v4u o; o.x = pk2(s[0 * 33], s[1 * 33]); o.y = pk2(s[2 * 33], s[3 * 33]); o.z = pk2(s[4 * 33], s[5 * 33]); o.w = pk2(s[6 * 33], s[7 * 33]);
        *(GAS v4u*)(WT + (size_t)(rbase + n) * K + k0 + 8 * c) = o; }
    LDS_WAIT(); asm volatile("" ::: "memory");
}
__device__ __forceinline__ void p0_prologue(Frame& F) {
    LAS float* scr = (LAS float*)(F.lds + F.wave * 16384);
    const int gw = F.vcu * NWAVES + F.wave, NGW = F.G * NWAVES;
    unsigned char* ws = F.ws;
    constexpr int I_AIN = (D / 64) * (2 * EA / 32), I_AOUT = (EA / 64) * (D / 32), I_G = (D / 64) * (FF / 32), I_DN = (FF / 64) * (D / 32), I_BIN = (D / 64) * (D / 32), I_BOUT = (D / 64) * (D / 32);
    constexpr int NITEMS = I_AIN + I_AOUT + 4 * I_G + 2 * I_DN + 3 * I_BIN + I_BOUT;
    for (int it = gw; it < NITEMS; it += NGW) {
        int r = it;
        if (r < I_AIN) { p0_transpose_item<0>(F.a_w_in, D, 2 * EA, (bf16*)(ws + WS_AIN), 0, F.mix_norm, scr, r, F.lane); continue; } r -= I_AIN;
        if (r < I_AOUT) { p0_transpose_item<0>(F.a_w_out, EA, D, (bf16*)(ws + WS_AOUT), 0, nullptr, scr, r, F.lane); continue; } r -= I_AOUT;
        if (r < I_G) { p0_transpose_item<1>(F.w_gate, D, FF, (bf16*)(ws + WS_GU0), 0, F.ffn_norm, scr, r, F.lane); continue; } r -= I_G;
        if (r < I_G) { p0_transpose_item<1>(F.w_up, D, FF, (bf16*)(ws + WS_GU0), 128, F.ffn_norm, scr, r, F.lane); continue; } r -= I_G;
        if (r < I_G) { p0_transpose_item<1>(F.w_gate + (size_t)D * FF, D, FF, (bf16*)(ws + WS_GU1), 0, F.ffn_norm + D, scr, r, F.lane); continue; } r -= I_G;
        if (r < I_G) { p0_transpose_item<1>(F.w_up + (size_t)D * FF, D, FF, (bf16*)(ws + WS_GU1), 128, F.ffn_norm + D, scr, r, F.lane); continue; } r -= I_G;
        if (r < I_DN) { p0_transpose_item<0>(F.w_down, FF, D, (bf16*)(ws + WS_D0), 0, nullptr, scr, r, F.lane); continue; } r -= I_DN;
        if (r < I_DN) { p0_transpose_item<0>(F.w_down + (size_t)FF * D, FF, D, (bf16*)(ws + WS_D1), 0, nullptr, scr, r, F.lane); continue; } r -= I_DN;
        if (r < 3 * I_BIN) {
            const int nblk = 3 * D / 32, nb = r % nblk, n0 = 32 * nb, part = n0 / D;
            const int kb = r / nblk, k0 = 64 * kb; const float* W = F.b_w_in; bf16* WT = (bf16*)(ws + WS_BIN); const float* gain = F.mix_norm + D;
#pragma unroll 8
            for (int i = 0; i < 32; ++i) { const int kk = 2 * i + (F.lane >> 5); scr[kk * 33 + (F.lane & 31)] = W[(size_t)(k0 + kk) * (3 * D) + n0 + (F.lane & 31)] * gain[k0 + kk]; }
            LDS_WAIT(); asm volatile("" ::: "memory");
            const int e0 = n0 - part * D;
            const int rbase = (part == 0) ? (2048 + e0) : (256 * (e0 / 128) + (e0 % 128) + (part == 2 ? 128 : 0));
            const int c = F.lane & 7;
#pragma unroll
            for (int j = 0; j < 4; ++j) { const int n = (F.lane >> 3) + 8 * j; const LAS float* s = scr + (8 * c) * 33 + n;
                v4u o; o.x = pk2(s[0 * 33], s[1 * 33]); o.y = pk2(s[2 * 33], s[3 * 33]); o.z = pk2(s[4 * 33], s[5 * 33]); o.w = pk2(s[6 * 33], s[7 * 33]);
                *(GAS v4u*)(WT + (size_t)(rbase + n) * D + k0 + 8 * c) = o; }
            LDS_WAIT(); asm volatile("" ::: "memory");
            continue; } r -= 3 * I_BIN;
        p0_transpose_item<0>(F.b_w_out, D, D, (bf16*)(ws + WS_BOUT), 0, nullptr, scr, r, F.lane);
    }
    { const int gt = (F.vcu * NWAVES + F.wave) * 64 + F.lane, NGT = NGW * 64; bf16* o = (bf16*)(ws + WS_WS);
      for (int i = gt; i < NH * CH * CH / 2; i += NGT) { const int e = 2 * i, t = (e / CH) % CH, s = e % CH; const float a = F.a_w_s[e], b = F.a_w_s[e + 1];
          ((GAS unsigned*)o)[i] = pk2(s <= t ? a : 0.f, (s + 1) <= t ? b : 0.f); } }
    for (int m = gw; m < M; m += NGW) {
        const GAS f32x4* xr = (const GAS f32x4*)(F.x + (size_t)m * D) + F.lane;
        f32x4 v[4]; float s = 0.f;
#pragma unroll
        for (int j = 0; j < 4; ++j) { v[j] = xr[64 * j]; s += (v[j].x * v[j].x + v[j].y * v[j].y) + (v[j].z * v[j].z + v[j].w * v[j].w); }
        const float rstd = 1.f / sqrtf(wave_sum(s) * (1.f / D) + pg8::RMS_EPS);
        GAS unsigned long long* o8 = (GAS unsigned long long*)((bf16*)(ws + WS_XB) + (size_t)m * D) + F.lane;
#pragma unroll
        for (int j = 0; j < 4; ++j) o8[64 * j] = (unsigned long long)pk2(v[j].x * rstd, v[j].y * rstd) | ((unsigned long long)pk2(v[j].z * rstd, v[j].w * rstd) << 32);
    }
}

constexpr int SG_PITCH = 272;
constexpr int SG_W = 0, SG_V = 128 * SG_PITCH, SG_ST = 2 * 128 * SG_PITCH;
__device__ __forceinline__ void sgu_phase(Frame& F) {
    LAS unsigned char* lds = F.lds;
    const int tid = F.tid, lane = F.lane, w = F.wave, fr = lane & 15, fq = lane >> 4;
    const bf16* U = (const bf16*)(F.ws + WS_U); bf16* Y = (bf16*)(F.ws + WS_Y); const bf16* VT = (const bf16*)(F.ws + WS_VT); const bf16* WSB = (const bf16*)(F.ws + WS_WS);
    const f32x2* vst = (const f32x2*)(F.ws + WS_VST);
    for (int chunk = F.vcu; chunk < M / CH; chunk += F.G) {
        const int t0 = chunk * CH;
        if (tid < CH) { const f32x4* p = (const f32x4*)(vst + (size_t)(t0 + tid) * 16); float s = 0.f, q = 0.f;
#pragma unroll
            for (int i = 0; i < 8; ++i) { const f32x4 a = p[i]; s += a[0] + a[2]; q += a[1] + a[3]; }
            const float mean = s * (1.f / EA); const float var = q * (1.f / EA) - mean * mean;
            ((LAS f32x2*)(lds + SG_ST))[tid] = (f32x2){mean, 1.f / sqrtf(var + LN_EPS)}; }
        __syncthreads();
        for (int h = 0; h < NH; ++h) {
#pragma unroll
            for (int i = 0; i < 4; ++i) { const int p = tid + 512 * i, r = p >> 4, cs = p & 15;
                const v4u wv = *(const GAS v4u*)(WSB + (size_t)h * CH * CH + r * CH + cs * 8);
                *(LAS v4u*)(lds + SG_W + r * SG_PITCH + cs * 16) = wv; }
#pragma unroll
            for (int i = 0; i < 4; ++i) { const int p = tid + 512 * i, r = p >> 4, cs = p & 15; const int c = h * CH + r;
                const v4u vv = *(const GAS v4u*)(VT + (size_t)c * M + t0 + cs * 8);
                const float g = F.a_v_gain[c], b = F.a_v_bias[c];
                const LAS f32x2* st = (const LAS f32x2*)(lds + SG_ST) + cs * 8;
                float o[8]; const unsigned wd[4] = {vv.x, vv.y, vv.z, vv.w};
#pragma unroll
                for (int k = 0; k < 4; ++k) { const f32x2 s0 = st[2 * k], s1 = st[2 * k + 1];
                    o[2 * k] = (bflo(wd[k]) - s0.x) * s0.y * g + b; o[2 * k + 1] = (bfhi(wd[k]) - s1.x) * s1.y * g + b; }
                v4u ov; ov.x = pk2(o[0], o[1]); ov.y = pk2(o[2], o[3]); ov.z = pk2(o[4], o[5]); ov.w = pk2(o[6], o[7]);
                *(LAS v4u*)(lds + SG_V + r * SG_PITCH + cs * 16) = ov; }
            __syncthreads();
            f32x4 acc[4][2];
#pragma unroll
            for (int g = 0; g < 4; ++g) { acc[g][0] = (f32x4){0.f, 0.f, 0.f, 0.f}; acc[g][1] = (f32x4){0.f, 0.f, 0.f, 0.f}; }
            const int kmax = (16 * w + 15) / 32;
            for (int kk = 0; kk <= kmax; ++kk) {
                const bf16x8 a = *(const LAS bf16x8*)(lds + SG_W + (16 * w + fr) * SG_PITCH + kk * 64 + fq * 16);
#pragma unroll
                for (int g = 0; g < 4; ++g)
#pragma unroll
                    for (int n = 0; n < 2; ++n) { const int crow = 32 * g + 8 * (fr >> 2) + 4 * n + (fr & 3);
                        const bf16x8 b = *(const LAS bf16x8*)(lds + SG_V + crow * SG_PITCH + kk * 64 + fq * 16);
                        acc[g][n] = __builtin_amdgcn_mfma_f32_16x16x32_bf16(b, a, acc[g][n], 0, 0, 0); }
            }
            const int t = 16 * w + fr; const float bs = F.a_b_s[h * CH + t];
            const bf16* up = U + (size_t)(t0 + t) * EA + h * CH + 8 * fq; bf16* yp = Y + (size_t)(t0 + t) * EA + h * CH + 8 * fq;
#pragma unroll
            for (int g = 0; g < 4; ++g) { const v4u uv = *(const GAS v4u*)(up + 32 * g);
                v4u ov; ov.x = pk2(bflo(uv.x) * (acc[g][0][0] + bs), bfhi(uv.x) * (acc[g][0][1] + bs)); ov.y = pk2(bflo(uv.y) * (acc[g][0][2] + bs), bfhi(uv.y) * (acc[g][0][3] + bs));
                ov.z = pk2(bflo(uv.z) * (acc[g][1][0] + bs), bfhi(uv.z) * (acc[g][1][1] + bs)); ov.w = pk2(bflo(uv.w) * (acc[g][1][2] + bs), bfhi(uv.w) * (acc[g][1][3] + bs));
                *(GAS v4u*)(yp + 32 * g) = ov; }
            __syncthreads();
        }
    }
}

__device__ __forceinline__ void conv_phase(Frame& F) {
    const bf16* Z = (const bf16*)(F.ws + WS_Z); const bf16* BG = (const bf16*)(F.ws + WS_BG); bf16* YC = (bf16*)(F.ws + WS_YC);
    const int gt = F.vcu * 512 + F.tid, NGT = F.G * 512;
    for (int i = gt; i < M * (D / 8); i += NGT) {
        const int row = i >> 7, c8 = (i & 127) * 8, tpos = row & (SEQ - 1);
        const size_t off = (size_t)row * D + c8;
        const v4u z2 = *(const GAS v4u*)(Z + off), bg = *(const GAS v4u*)(BG + off);
        v4u z1 = (v4u){0u, 0u, 0u, 0u}, z0 = (v4u){0u, 0u, 0u, 0u};
        if (tpos >= 1) z1 = *(const GAS v4u*)(Z + off - D);
        if (tpos >= 2) z0 = *(const GAS v4u*)(Z + off - 2 * D);
        const f32x4 w0a = *(const GAS f32x4*)(F.b_conv_w + c8), w0b = *(const GAS f32x4*)(F.b_conv_w + c8 + 4);
        const f32x4 w1a = *(const GAS f32x4*)(F.b_conv_w + D + c8), w1b = *(const GAS f32x4*)(F.b_conv_w + D + c8 + 4);
        const f32x4 w2a = *(const GAS f32x4*)(F.b_conv_w + 2 * D + c8), w2b = *(const GAS f32x4*)(F.b_conv_w + 2 * D + c8 + 4);
        const unsigned a0[4] = {z0.x, z0.y, z0.z, z0.w}, a1[4] = {z1.x, z1.y, z1.z, z1.w}, a2[4] = {z2.x, z2.y, z2.z, z2.w}, ab[4] = {bg.x, bg.y, bg.z, bg.w};
        const float w0[8] = {w0a[0], w0a[1], w0a[2], w0a[3], w0b[0], w0b[1], w0b[2], w0b[3]}, w1[8] = {w1a[0], w1a[1], w1a[2], w1a[3], w1b[0], w1b[1], w1b[2], w1b[3]}, w2[8] = {w2a[0], w2a[1], w2a[2], w2a[3], w2b[0], w2b[1], w2b[2], w2b[3]};
        unsigned o[4];
#pragma unroll
        for (int k = 0; k < 4; ++k) {
            const float lo = bflo(ab[k]) * (bflo(a0[k]) * w0[2 * k] + bflo(a1[k]) * w1[2 * k] + bflo(a2[k]) * w2[2 * k]);
            const float hi = bfhi(ab[k]) * (bfhi(a0[k]) * w0[2 * k + 1] + bfhi(a1[k]) * w1[2 * k + 1] + bfhi(a2[k]) * w2[2 * k + 1]);
            o[k] = pk2(lo, hi); }
        *(GAS v4u*)(YC + off) = (v4u){o[0], o[1], o[2], o[3]};
    }
}
__device__ __forceinline__ void final_norm_phase(Frame& F) {
    const int gw = F.vcu * NWAVES + F.wave, NGW = F.G * NWAVES; const float* ss = (const float*)(F.ws + WS_SS);
    for (int m = gw; m < M; m += NGW) {
        float s = (F.lane < 16) ? ss[(size_t)m * 16 + F.lane] : 0.f;
        s = wave_sum(s);
        const float rstd = 1.f / sqrtf(s * (1.f / D) + pg8::RMS_EPS);
        GAS f32x4* xr = (GAS f32x4*)(F.out + (size_t)m * D) + F.lane; const GAS f32x4* gr = (const GAS f32x4*)F.final_norm + F.lane;
#pragma unroll
        for (int j = 0; j < 4; ++j) { const f32x4 v = xr[64 * j], g = gr[64 * j]; xr[64 * j] = v * rstd * g; }
    }
}

struct Args { const float* in[16]; float* out; unsigned char* ws; int ph_lo, ph_hi; };
__global__ void __launch_bounds__(NWAVES * 64, 2) hybrid_fwd(Args args) {
    extern __shared__ __attribute__((aligned(16))) unsigned char lds[];
    cg::grid_group grid = cg::this_grid();
    Frame F;
    F.lds = (LAS unsigned char*)lds;
    F.tid = threadIdx.x; F.lane = F.tid & 63; F.wave = __builtin_amdgcn_readfirstlane(F.tid >> 6);
    F.G = gridDim.x; { const int bx = blockIdx.x; F.vcu = (F.G % 8 == 0) ? (bx % 8) * (F.G / 8) + bx / 8 : bx; }
    F.x = args.in[0]; F.mix_norm = args.in[1]; F.ffn_norm = args.in[2]; F.a_w_in = args.in[3]; F.a_v_gain = args.in[4]; F.a_v_bias = args.in[5]; F.a_w_s = args.in[6]; F.a_b_s = args.in[7];
    F.a_w_out = args.in[8]; F.b_w_in = args.in[9]; F.b_conv_w = args.in[10]; F.b_w_out = args.in[11]; F.w_gate = args.in[12]; F.w_up = args.in[13]; F.w_down = args.in[14]; F.final_norm = args.in[15];
    F.out = args.out; F.ws = args.ws;
    unsigned char* ws = args.ws;
    for (int u = F.tid; u < (LDS_BYTES - LDSCTL_OFF) / 4; u += NWAVES * 64) ((LAS unsigned*)(F.lds + LDSCTL_OFF))[u] = 0u;
    __syncthreads();
    XcdBarrier bar = xcd_barrier_post((unsigned*)(ws + WS_CTL) + CW_BAR, (volatile LAS unsigned*)(F.lds + MISC_OFF) + 8);
    const int lo = args.ph_lo, hi = args.ph_hi;
    if (lo < 0) grid.sync();
#ifndef REP_MASK
#define REP_MASK 0
#endif
#ifndef EXTRA_SYNCS
#define EXTRA_SYNCS 0
#endif
#define REPS(k) (1 + ((REP_MASK >> (k)) & 1))
#define IN(k) (lo <= (k) && (k) < hi)
#define SEAM(k) do { if (IN(k) && IN((k) + 1)) xcd_barrier(bar); } while (0)
    pg8::bf16_t* XB = (pg8::bf16_t*)(ws + WS_XB); float* SS = (float*)(ws + WS_SS);
    const int c = (int)blockIdx.x;

    if (IN(0)) for (int rep = 0; rep < REPS(0); ++rep) { if (rep) xcd_barrier(bar); p0_prologue(F); __syncthreads(); } SEAM(0);

    if (IN(1)) for (int rep = 0; rep < REPS(1); ++rep) { if (rep) xcd_barrier(bar);
        { pg8::Gemm g{XB, (const pg8::bf16_t*)(ws + WS_AIN), M, EA, D}; pg8::StaticOrder S; S.init(M, EA, F.G, c);
          pg8::EpiGelu E{(pg8::bf16_t*)(ws + WS_U), EA};
          pg8::gemm_phase<pg8::EpiGelu, pg8::StaticOrder, true, true>(F.lds, g, S, E); }
        { pg8::Gemm g{(const pg8::bf16_t*)(ws + WS_AIN) + (size_t)EA * D, XB, EA, M, D}; pg8::StaticOrder S; S.init(EA, M, F.G, c);
          pg8::EpiGeluT E{(pg8::bf16_t*)(ws + WS_VT), M, (pg8::f32x2*)(ws + WS_VST)};
          pg8::gemm_phase<pg8::EpiGeluT, pg8::StaticOrder, true, true>(F.lds, g, S, E); }
    } SEAM(1);

    if (IN(2)) for (int rep = 0; rep < REPS(2); ++rep) { if (rep) xcd_barrier(bar); sgu_phase(F); } SEAM(2);

    if (IN(3)) for (int rep = 0; rep < REPS(3); ++rep) { if (rep) xcd_barrier(bar);
        pg8::Gemm g{(const pg8::bf16_t*)(ws + WS_Y), (const pg8::bf16_t*)(ws + WS_AOUT), M, D, EA}; pg8::StaticOrder S; S.init(M, D, F.G, c);
        pg8::EpiRes E{F.x, F.out, XB, SS};
        pg8::gemm_phase<pg8::EpiRes, pg8::StaticOrder, true, true>(F.lds, g, S, E);
    } SEAM(3);

    if (IN(4)) for (int rep = 0; rep < REPS(4); ++rep) { if (rep) xcd_barrier(bar);
        pg8::Gemm g{XB, (const pg8::bf16_t*)(ws + WS_GU0), M, 2 * FF, D}; pg8::StaticOrder S; S.init(M, 2 * FF, F.G, c);
        pg8::EpiSwiglu E{(pg8::bf16_t*)(ws + WS_A), FF, SS};
        pg8::gemm_phase<pg8::EpiSwiglu, pg8::StaticOrder, true, true>(F.lds, g, S, E);
    } SEAM(4);

    if (IN(5)) for (int rep = 0; rep < REPS(5); ++rep) { if (rep) xcd_barrier(bar);
        pg8::Gemm g{(const pg8::bf16_t*)(ws + WS_A), (const pg8::bf16_t*)(ws + WS_D0), M, D, FF}; pg8::StaticOrder S; S.init(M, D, F.G, c);
        pg8::EpiRes E{F.out, F.out, XB, SS};
        pg8::gemm_phase<pg8::EpiRes, pg8::StaticOrder, true, true>(F.lds, g, S, E);
    } SEAM(5);

    if (IN(6)) for (int rep = 0; rep < REPS(6); ++rep) { if (rep) xcd_barrier(bar);
        pg8::Gemm g{XB, (const pg8::bf16_t*)(ws + WS_BIN), M, 3 * D, D}; pg8::StaticOrder S; S.init(M, 3 * D, F.G, c);
        pg8::EpiConvIn E{(pg8::bf16_t*)(ws + WS_Z), (pg8::bf16_t*)(ws + WS_BG), SS};
        pg8::gemm_phase<pg8::EpiConvIn, pg8::StaticOrder, true, true>(F.lds, g, S, E);
    } SEAM(6);

    if (IN(7)) for (int rep = 0; rep < REPS(7); ++rep) { if (rep) xcd_barrier(bar); conv_phase(F); } SEAM(7);

    if (IN(8)) for (int rep = 0; rep < REPS(8); ++rep) { if (rep) xcd_barrier(bar);
        pg8::Gemm g{(const pg8::bf16_t*)(ws + WS_YC), (const pg8::bf16_t*)(ws + WS_BOUT), M, D, D}; pg8::StaticOrder S; S.init(M, D, F.G, c);
        pg8::EpiRes E{F.out, F.out, XB, SS};
        pg8::gemm_phase<pg8::EpiRes, pg8::StaticOrder, true, true>(F.lds, g, S, E);
    } SEAM(8);

    if (IN(9)) for (int rep = 0; rep < REPS(9); ++rep) { if (rep) xcd_barrier(bar);
        pg8::Gemm g{XB, (const pg8::bf16_t*)(ws + WS_GU1), M, 2 * FF, D}; pg8::StaticOrder S; S.init(M, 2 * FF, F.G, c);
        pg8::EpiSwiglu E{(pg8::bf16_t*)(ws + WS_A), FF, SS};
        pg8::gemm_phase<pg8::EpiSwiglu, pg8::StaticOrder, true, true>(F.lds, g, S, E);
    } SEAM(9);

    if (IN(10)) for (int rep = 0; rep < REPS(10); ++rep) { if (rep) xcd_barrier(bar);
        pg8::Gemm g{(const pg8::bf16_t*)(ws + WS_A), (const pg8::bf16_t*)(ws + WS_D1), M, D, FF}; pg8::StaticOrder S; S.init(M, D, F.G, c);
        pg8::EpiRes E{F.out, F.out, XB, SS};
        pg8::gemm_phase<pg8::EpiRes, pg8::StaticOrder, true, true>(F.lds, g, S, E);
    } SEAM(10);

    for (int i = 0; i < EXTRA_SYNCS; ++i) xcd_barrier(bar);
    if (IN(11)) for (int rep = 0; rep < REPS(11); ++rep) { if (rep) xcd_barrier(bar); final_norm_phase(F); }
#undef IN
#undef SEAM
}

extern "C" void kernel_launch(void* const* d_in, const int* in_sizes, int n_in, void* d_out, int out_size, void* d_ws, size_t ws_size, hipStream_t stream) {
    static int grid = 0;
    if (grid == 0) {
        if (n_in != 16 || in_sizes[0] != M * D || out_size != M * D || ws_size < WS_END) { fprintf(stderr, "kernel_launch: unexpected shapes (n_in %d, in0 %d, out %d, ws %zu); nothing launched\n", n_in, n_in > 0 ? in_sizes[0] : -1, out_size, ws_size); grid = -1; return; }
        int dev = 0, cus = 0, per_cu = 0;
        if (hipGetDevice(&dev) != hipSuccess || hipDeviceGetAttribute(&cus, hipDeviceAttributeMultiprocessorCount, dev) != hipSuccess) { grid = -1; return; }
        if (hipFuncSetAttribute((const void*)hybrid_fwd, hipFuncAttributeMaxDynamicSharedMemorySize, LDS_BYTES) != hipSuccess) { fprintf(stderr, "kernel_launch: hipFuncSetAttribute failed\n"); grid = -1; return; }
        if (hipOccupancyMaxActiveBlocksPerMultiprocessor(&per_cu, (const void*)hybrid_fwd, NWAVES * 64, LDS_BYTES) != hipSuccess || per_cu < 1) { fprintf(stderr, "kernel_launch: occupancy query says %d blocks per CU\n", per_cu); per_cu = 1; }
        (void)hipGetLastError();
        grid = cus;
    }
    if (grid < 0) return;
    if (hipMemsetAsync((char*)d_ws + WS_CTL, 0, CTL_ZERO_BYTES, stream) != hipSuccess) { fprintf(stderr, "kernel_launch: memset failed\n"); return; }
    Args a{};
    for (int i = 0; i < 16; ++i) a.in[i] = (const float*)d_in[i];
    a.out = (float*)d_out; a.ws = (unsigned char*)d_ws;
#if MK_ONE_LAUNCH
    a.ph_lo = 0; a.ph_hi = N_PHASES;
    void* kargs[] = {&a};
    const hipError_t e = hipLaunchCooperativeKernel((const void*)hybrid_fwd, dim3(grid), dim3(NWAVES * 64), kargs, LDS_BYTES, stream);
    if (e != hipSuccess) fprintf(stderr, "kernel_launch: cooperative launch failed: %s (grid %d)\n", hipGetErrorString(e), grid);
#else
    for (int p = 0; p < N_PHASES; ++p) { a.ph_lo = p; a.ph_hi = p + 1; hipLaunchKernelGGL(hybrid_fwd, dim3(grid), dim3(NWAVES * 64), LDS_BYTES, stream, a); }
#endif
}
```

```cpp
#include <hip/hip_runtime.h>
#include <hip/hip_cooperative_groups.h>
#include <cstdio>
#include <cstdint>
namespace cg = cooperative_groups;

namespace pg8 {
#define PG8_LAS __attribute__((address_space(3)))
typedef unsigned short bf16_t;
typedef short bf16x8 __attribute__((ext_vector_type(8)));
typedef float f32x4 __attribute__((ext_vector_type(4)));
typedef unsigned u32x4 __attribute__((ext_vector_type(4)));
constexpr int BM = 256, BK = 64, HALF = 128, HTB = HALF * BK * 2  , STAGE_BYTES = 8 * HTB, NXCD = 8, WGM = 8;

__host__ __device__ __forceinline__ int lds_byte(int r, int c) { const int st = (r >> 4) * 2 + (c >> 5), rr = r & 15, cc = c & 31, ob = rr * 64 + cc * 2; return st * 1024 + (ob ^ (((ob >> 9) & 1) << 5)); }
__host__ __device__ __forceinline__ void stage_rc(int b, int& R, int& C) { const int st = b / 1024, sb = b % 1024, swz = sb ^ (((sb >> 9) & 1) << 5); R = (st >> 1) * 16 + swz / 64; C = (st & 1) * 32 + (swz % 64) / 2; }
__host__ __device__ __forceinline__ int perm32(int rho) { const int n = rho >> 4, i = rho & 15; return 8 * (i >> 2) + 4 * n + (i & 3); }

struct Unit { int pm, pn; };
struct Gemm { const bf16_t* A; const bf16_t* Bt; int M, N, K; };

struct StaticOrder {
    int nM, nN, nwg, G, c;
    __host__ __device__ void init(int M, int N, int G_, int c_) { nM = M / BM; nN = N / BM; nwg = nM * nN; G = G_; c = c_; }
    __host__ __device__ bool next(int i, Unit& u) const {
        const long L = (long)i * G + c; if (L >= nwg) return false;
        int wgid = (int)L; { const int q = nwg / NXCD, r = nwg % NXCD, xcd = wgid % NXCD, off = wgid / NXCD; wgid = (xcd < r ? xcd * (q + 1) : r * (q + 1) + (xcd - r) * q) + off; }
        const int nig = WGM * nN, gid = wgid / nig, fm = gid * WGM, gsz = (nM - fm) < WGM ? (nM - fm) : WGM;
        u.pm = fm + ((wgid % nig) % gsz); u.pn = (wgid % nig) / gsz; return true;
    }
    __device__ __forceinline__ void a_ready(const Unit&) const {}
    __device__ __forceinline__ void done(const Unit&) const {}
};

__device__ __forceinline__ unsigned cvt_pk_bf16(float lo, float hi) { unsigned r; asm volatile("v_cvt_pk_bf16_f32 %0, %1, %2" : "=v"(r) : "v"(lo), "v"(hi)); return r; }
typedef float f32x2 __attribute__((ext_vector_type(2)));
typedef unsigned u32x2 __attribute__((ext_vector_type(2)));
constexpr float RMS_EPS = 1e-6f;
__device__ __forceinline__ float gelu_tanh(float v) {
    const float w = v * (1.0f + 0.044715f * v * v);
    const float e = __builtin_amdgcn_exp2f(w * (-2.0f * 0.7978845608028654f * 1.4426950408889634f));
    return v * __builtin_amdgcn_rcpf(1.0f + e);
}
__device__ __forceinline__ float silu_f(float v) {
    const float e = __builtin_amdgcn_exp2f(v * (-1.4426950408889634f));
    return v * __builtin_amdgcn_rcpf(1.0f + e);
}
__device__ __forceinline__ u32x4 pack8(const f32x4 a, const f32x4 b) {
    u32x4 w; w.x = cvt_pk_bf16(a[0], a[1]); w.y = cvt_pk_bf16(a[2], a[3]); w.z = cvt_pk_bf16(b[0], b[1]); w.w = cvt_pk_bf16(b[2], b[3]); return w;
}
__device__ __forceinline__ float row_rstd(const float* ss, int row, int fq) {
    const f32x4 p = *(const f32x4*)(ss + (size_t)row * 16 + fq * 4);
    float s = (p[0] + p[1]) + (p[2] + p[3]);
    s += __shfl_xor(s, 16); s += __shfl_xor(s, 32);
    return 1.0f / sqrtf(s * (1.0f / 1024.0f) + RMS_EPS);
}

struct EpiGelu {
    static constexpr bool PERM = true, AFTER_DRAIN = false;
    bf16_t* O; int ldc;
    __device__ __forceinline__ void operator()(const f32x4 (&acc)[2][2][4][2], const Unit& u, int wr, int wc, int fr, int fq) const {
        const int row0 = u.pm * BM + wr * 64 + fr, col0 = u.pn * BM + wc * 32 + 8 * fq;
#pragma unroll
        for (int ai = 0; ai < 2; ++ai)
#pragma unroll
            for (int m = 0; m < 4; ++m) { bf16_t* rowp = O + (size_t)(row0 + ai * HALF + m * 16) * ldc + col0;
#pragma unroll
                for (int bj = 0; bj < 2; ++bj) { f32x4 v0 = acc[ai][bj][m][0], v1 = acc[ai][bj][m][1];
#pragma unroll
                    for (int e = 0; e < 4; ++e) { v0[e] = gelu_tanh(v0[e]); v1[e] = gelu_tanh(v1[e]); }
                    *(u32x4*)(rowp + bj * HALF) = pack8(v0, v1); } }
    }
};
struct EpiGeluT {
    static constexpr bool PERM = true, AFTER_DRAIN = false;
    bf16_t* O; int ldc; f32x2* vst;
    __device__ __forceinline__ void operator()(const f32x4 (&acc)[2][2][4][2], const Unit& u, int wr, int wc, int fr, int fq) const {
        const int row0 = u.pm * BM + wr * 64 + fr, col0 = u.pn * BM + wc * 32 + 8 * fq;
        float v[32];
#pragma unroll
        for (int i = 0; i < 32; ++i) v[i] = 0.f;
#pragma unroll
        for (int ai = 0; ai < 2; ++ai)
#pragma unroll
            for (int m = 0; m < 4; ++m) { bf16_t* rowp = O + (size_t)(row0 + ai * HALF + m * 16) * ldc + col0;
#pragma unroll
                for (int bj = 0; bj < 2; ++bj) { f32x4 v0 = acc[ai][bj][m][0], v1 = acc[ai][bj][m][1];
#pragma unroll
                    for (int e = 0; e < 4; ++e) { v0[e] = gelu_tanh(v0[e]); v1[e] = gelu_tanh(v1[e]);
                        v[2 * (8 * bj + e)] += v0[e]; v[2 * (8 * bj + e) + 1] += v0[e] * v0[e];
                        v[2 * (8 * bj + 4 + e)] += v1[e]; v[2 * (8 * bj + 4 + e) + 1] += v1[e] * v1[e]; }
                    *(u32x4*)(rowp + bj * HALF) = pack8(v0, v1); } }
#define PG8_XSTEP(H, MASK) { const bool bit = (fr & (MASK)) != 0; _Pragma("unroll") for (int i = 0; i < (H); ++i) { const float send = bit ? v[i] : v[i + (H)]; const float keep = bit ? v[i + (H)] : v[i]; v[i] = keep + __shfl_xor(send, (MASK)); } }
        PG8_XSTEP(16, 8) PG8_XSTEP(8, 4) PG8_XSTEP(4, 2) PG8_XSTEP(2, 1)
#undef PG8_XSTEP
        const int token = u.pn * BM + (fr >> 3) * HALF + wc * 32 + 8 * fq + (fr & 7);
        vst[(size_t)token * 16 + u.pm * 2 + wr] = (f32x2){v[0], v[1]};
    }
};
template <bool F32BASE> struct EpiRes {
    static constexpr bool PERM = true, AFTER_DRAIN = false;
    const float* base; bf16_t* xb; float* ss;
    __device__ __forceinline__ void operator()(const f32x4 (&acc)[2][2][4][2], const Unit& u, int wr, int wc, int fr, int fq) const {
        const int row0 = u.pm * BM + wr * 64 + fr, col0 = u.pn * BM + wc * 32 + 8 * fq;
        if constexpr (F32BASE) {
#pragma unroll
            for (int ai = 0; ai < 2; ++ai) {
                f32x4 pre[4][2][2];
#pragma unroll
                for (int m = 0; m < 4; ++m) { const size_t off = (size_t)(row0 + ai * HALF + m * 16) * 1024 + col0;
#pragma unroll
                    for (int bj = 0; bj < 2; ++bj) { pre[m][bj][0] = *(const f32x4*)(base + off + bj * HALF); pre[m][bj][1] = *(const f32x4*)(base + off + bj * HALF + 4); } }
                asm volatile("" ::: "memory");
#pragma unroll
                for (int m = 0; m < 4; ++m) { const int row = row0 + ai * HALF + m * 16; const size_t off = (size_t)row * 1024 + col0; float q = 0.f;
#pragma unroll
                    for (int bj = 0; bj < 2; ++bj) {
                        const f32x4 o0 = pre[m][bj][0] + acc[ai][bj][m][0], o1 = pre[m][bj][1] + acc[ai][bj][m][1];
                        q += (o0[0] * o0[0] + o0[1] * o0[1]) + (o0[2] * o0[2] + o0[3] * o0[3]) + (o1[0] * o1[0] + o1[1] * o1[1]) + (o1[2] * o1[2] + o1[3] * o1[3]);
                        *(u32x4*)(xb + off + bj * HALF) = pack8(o0, o1); }
                    q += __shfl_xor(q, 16); q += __shfl_xor(q, 32);
                    if (fq == 0) ss[(size_t)row * 16 + u.pn * 4 + wc] = q; }
                asm volatile("" ::: "memory");
            }
        } else {
            u32x4 pre[2][4][2];
#pragma unroll
            for (int ai = 0; ai < 2; ++ai)
#pragma unroll
                for (int m = 0; m < 4; ++m) { const size_t off = (size_t)(row0 + ai * HALF + m * 16) * 1024 + col0;
#pragma unroll
                    for (int bj = 0; bj < 2; ++bj) pre[ai][m][bj] = *(const u32x4*)(xb + off + bj * HALF); }
            asm volatile("" ::: "memory");
#pragma unroll
            for (int ai = 0; ai < 2; ++ai)
#pragma unroll
                for (int m = 0; m < 4; ++m) { const int row = row0 + ai * HALF + m * 16; const size_t off = (size_t)row * 1024 + col0; float q = 0.f;
#pragma unroll
                    for (int bj = 0; bj < 2; ++bj) { const u32x4 p = pre[ai][m][bj];
                        const f32x4 b0 = {__builtin_bit_cast(float, p.x << 16), __builtin_bit_cast(float, p.x & 0xffff0000u), __builtin_bit_cast(float, p.y << 16), __builtin_bit_cast(float, p.y & 0xffff0000u)};
                        const f32x4 b1 = {__builtin_bit_cast(float, p.z << 16), __builtin_bit_cast(float, p.z & 0xffff0000u), __builtin_bit_cast(float, p.w << 16), __builtin_bit_cast(float, p.w & 0xffff0000u)};
                        const f32x4 o0 = b0 + acc[ai][bj][m][0], o1 = b1 + acc[ai][bj][m][1];
                        q += (o0[0] * o0[0] + o0[1] * o0[1]) + (o0[2] * o0[2] + o0[3] * o0[3]) + (o1[0] * o1[0] + o1[1] * o1[1]) + (o1[2] * o1[2] + o1[3] * o1[3]);
                        *(u32x4*)(xb + off + bj * HALF) = pack8(o0, o1); }
                    q += __shfl_xor(q, 16); q += __shfl_xor(q, 32);
                    if (fq == 0) ss[(size_t)row * 16 + u.pn * 4 + wc] = q; }
        }
    }
};
__device__ __forceinline__ void rows_rstd(float (&rs)[2][4], const float* ss, int row0, int fq) {
    f32x4 p[2][4];
#pragma unroll
    for (int ai = 0; ai < 2; ++ai)
#pragma unroll
        for (int m = 0; m < 4; ++m) p[ai][m] = *(const f32x4*)(ss + (size_t)(row0 + ai * HALF + m * 16) * 16 + fq * 4);
    asm volatile("" ::: "memory");
#pragma unroll
    for (int ai = 0; ai < 2; ++ai)
#pragma unroll
        for (int m = 0; m < 4; ++m) { float s = (p[ai][m][0] + p[ai][m][1]) + (p[ai][m][2] + p[ai][m][3]); s += __shfl_xor(s, 16); s += __shfl_xor(s, 32);
            rs[ai][m] = __builtin_amdgcn_rsqf(s * (1.0f / 1024.0f) + RMS_EPS); }
}
struct EpiSwiglu {
    static constexpr bool PERM = true, AFTER_DRAIN = false;
    bf16_t* O; int ldc; const float* ss;
    __device__ __forceinline__ void operator()(const f32x4 (&acc)[2][2][4][2], const Unit& u, int wr, int wc, int fr, int fq) const {
        const int row0 = u.pm * BM + wr * 64 + fr, col0 = u.pn * HALF + wc * 32 + 8 * fq;
        float rs[2][4]; rows_rstd(rs, ss, row0, fq);
#pragma unroll
        for (int ai = 0; ai < 2; ++ai)
#pragma unroll
            for (int m = 0; m < 4; ++m) { const int row = row0 + ai * HALF + m * 16; const float r = rs[ai][m];
                f32x4 a0, a1;
#pragma unroll
                for (int e = 0; e < 4; ++e) { a0[e] = silu_f(acc[ai][0][m][0][e] * r) * (acc[ai][1][m][0][e] * r); a1[e] = silu_f(acc[ai][0][m][1][e] * r) * (acc[ai][1][m][1][e] * r); }
                *(u32x4*)(O + (size_t)row * ldc + col0) = pack8(a0, a1); }
    }
};
struct EpiConvIn {
    static constexpr bool PERM = true, AFTER_DRAIN = false;
    bf16_t* Z; bf16_t* BG; const float* ss;
    __device__ __forceinline__ void operator()(const f32x4 (&acc)[2][2][4][2], const Unit& u, int wr, int wc, int fr, int fq) const {
        const int row0 = u.pm * BM + wr * 64 + fr;
        float rs[2][4]; rows_rstd(rs, ss, row0, fq);
        if (u.pn < 8) {
            const int col0 = u.pn * HALF + wc * 32 + 8 * fq;
#pragma unroll
            for (int ai = 0; ai < 2; ++ai)
#pragma unroll
                for (int m = 0; m < 4; ++m) { const int row = row0 + ai * HALF + m * 16; const float r2 = rs[ai][m] * rs[ai][m];
                    const f32x4 a0 = acc[ai][0][m][0] * acc[ai][1][m][0] * r2, a1 = acc[ai][0][m][1] * acc[ai][1][m][1] * r2;
                    *(u32x4*)(Z + (size_t)row * 1024 + col0) = pack8(a0, a1); }
        } else {
            const int col0 = (u.pn - 8) * BM + wc * 32 + 8 * fq;
#pragma unroll
            for (int ai = 0; ai < 2; ++ai)
#pragma unroll
                for (int m = 0; m < 4; ++m) { const int row = row0 + ai * HALF + m * 16; const float r = rs[ai][m];
#pragma unroll
                    for (int bj = 0; bj < 2; ++bj) *(u32x4*)(BG + (size_t)row * 1024 + col0 + bj * HALF) = pack8(acc[ai][bj][m][0] * r, acc[ai][bj][m][1] * r); }
        }
    }
};

template <class Epi, class Sched, bool ALIGN_EPI = false, bool SP2 = false>
__device__ __forceinline__ void gemm_phase(PG8_LAS unsigned char* lds, const Gemm g, const Sched& S, const Epi& E) {
    const int tid = threadIdx.x, wid = __builtin_amdgcn_readfirstlane(tid >> 6), lane = tid & 63, wr = wid >> 2, wc = wid & 3, fr = lane & 15, fq = lane >> 4;
    const int K = g.K, nt = K / BK;
    unsigned voffA[2], voffB[2];
#pragma unroll
    for (int i = 0; i < 2; ++i) { int R, C; stage_rc(tid * 16 + i * 8192, R, C); const int Rb = Epi::PERM ? ((R & ~31) + perm32(R & 31)) : R;
        voffA[i] = (unsigned)(R * K + C) * 2u; voffB[i] = (unsigned)(Rb * K + C) * 2u; }
    const size_t kstep = (size_t)(BK * 2);
    const size_t hstep = (size_t)HALF * K * 2;
    const size_t tstep = 2 * hstep;
    const unsigned ldsw = (unsigned)wid * 1024u;
    const int aoff = lds_byte(wr * 64 + fr, fq * 8), boff = lds_byte(wc * 32 + fr, fq * 8);
#define PG8_SA(b, h) (((b) * 2 + (h)) * HTB)
#define PG8_SB(b, h) ((4 + (b) * 2 + (h)) * HTB)
#define PG8_STAGE(bufoff, gbase, voff) do { _Pragma("unroll") for (int _i = 0; _i < 2; ++_i) \
        __builtin_amdgcn_global_load_lds((const unsigned*)((const char*)(gbase) + (voff)[_i]), (PG8_LAS unsigned*)(lds + (bufoff) + ldsw + _i * 8192), 16, 0, 0); } while (0)
#define PG8_LDA(dst, b, h) do { _Pragma("unroll") for (int m = 0; m < 4; ++m) _Pragma("unroll") for (int k = 0; k < 2; ++k) dst[m][k] = *(const PG8_LAS bf16x8*)(lds + PG8_SA(b, h) + aoff + m * 2048 + k * 1024); } while (0)
#define PG8_LDB(dst, b, h) do { _Pragma("unroll") for (int n = 0; n < 2; ++n) _Pragma("unroll") for (int k = 0; k < 2; ++k) dst[n][k] = *(const PG8_LAS bf16x8*)(lds + PG8_SB(b, h) + boff + n * 2048 + k * 1024); } while (0)
#define PG8_MMA(ai, bj, At, Bt) do { __builtin_amdgcn_s_setprio(1); _Pragma("unroll") for (int m = 0; m < 4; ++m) _Pragma("unroll") for (int n = 0; n < 2; ++n) _Pragma("unroll") for (int k = 0; k < 2; ++k) \
        acc[ai][bj][m][n] = __builtin_amdgcn_mfma_f32_16x16x32_bf16(Bt[n][k], At[m][k], acc[ai][bj][m][n], 0, 0, 0); __builtin_amdgcn_s_setprio(0); } while (0)
#define PG8_WAIT_V(n) asm volatile("s_waitcnt vmcnt(" #n ")" ::: "memory")
#define PG8_WAIT_L(n) asm volatile("s_waitcnt lgkmcnt(" #n ")" ::: "memory")
#define PG8_BAR __builtin_amdgcn_s_barrier()
#define PG8_SCHED __builtin_amdgcn_sched_barrier(0)
    Unit cur, nxt; int ui = 0;
    if (!S.next(0, cur)) return;
    f32x4 acc[2][2][4][2];
#pragma unroll
    for (int a = 0; a < 2; ++a)
#pragma unroll
        for (int b = 0; b < 2; ++b)
#pragma unroll
            for (int m = 0; m < 4; ++m)
#pragma unroll
                for (int n = 0; n < 2; ++n) acc[a][b][m][n] = (f32x4){0.f, 0.f, 0.f, 0.f};
    bf16x8 At[4][2], B0[2][2], B1[2][2];
    const char* cA = (const char*)g.A + (size_t)cur.pm * tstep; const char* cB = (const char*)g.Bt + (size_t)cur.pn * tstep;
    S.a_ready(cur);
    if constexpr (SP2) {
        PG8_STAGE(PG8_SB(0, 0), cB, voffB); PG8_STAGE(PG8_SB(0, 1), cB + hstep, voffB); PG8_STAGE(PG8_SA(0, 0), cA, voffA); PG8_STAGE(PG8_SA(0, 1), cA + hstep, voffA);
        if (wr == 1) PG8_BAR;
        PG8_WAIT_V(2); PG8_BAR;
        PG8_STAGE(PG8_SB(1, 0), cB + kstep, voffB); PG8_STAGE(PG8_SA(1, 0), cA + kstep, voffA); PG8_STAGE(PG8_SB(1, 1), cB + hstep + kstep, voffB);
        PG8_WAIT_V(6); PG8_BAR;
    } else {
        PG8_STAGE(PG8_SB(0, 0), cB, voffB); PG8_STAGE(PG8_SA(0, 0), cA, voffA); PG8_STAGE(PG8_SB(0, 1), cB + hstep, voffB); PG8_STAGE(PG8_SA(0, 1), cA + hstep, voffA);
        if (wr == 1) PG8_BAR;
        PG8_WAIT_V(4); PG8_BAR;
        PG8_STAGE(PG8_SB(1, 0), cB + kstep, voffB); PG8_STAGE(PG8_SA(1, 0), cA + kstep, voffA); PG8_STAGE(PG8_SB(1, 1), cB + hstep + kstep, voffB);
        PG8_WAIT_V(6); PG8_BAR;
    }
    for (;;) {
        const bool has_next = S.next(ui + 1, nxt);
        const char* nA = has_next ? (const char*)g.A + (size_t)nxt.pm * tstep : cA; const char* nB = has_next ? (const char*)g.Bt + (size_t)nxt.pn * tstep : cB;
        for (int t = 0; t < nt; t += 2) {
            const bool last = (t == nt - 2);
            const char* a1 = cA + (size_t)(t + 1) * kstep;
            const char* a2 = last ? nA : cA + (size_t)(t + 2) * kstep; const char* b2 = last ? nB : cB + (size_t)(t + 2) * kstep;
            const char* a3 = a2 + kstep; const char* b3 = b2 + kstep;
            if (last && has_next) S.a_ready(nxt);
            if constexpr (SP2) {
            PG8_LDB(B0, 0, 0); PG8_LDB(B1, 0, 1); PG8_SCHED; PG8_LDA(At, 0, 0); PG8_STAGE(PG8_SA(1, 1), a1 + hstep, voffA);
            PG8_WAIT_V(8); PG8_WAIT_L(0); PG8_BAR; PG8_MMA(0, 0, At, B0); PG8_MMA(0, 1, At, B1); PG8_BAR; PG8_SCHED;
            PG8_LDA(At, 0, 1); PG8_STAGE(PG8_SB(0, 0), b2, voffB); PG8_STAGE(PG8_SB(0, 1), b2 + hstep, voffB); PG8_STAGE(PG8_SA(0, 0), a2, voffA);
            PG8_WAIT_V(8); PG8_WAIT_L(0); PG8_BAR; PG8_MMA(1, 0, At, B0); PG8_MMA(1, 1, At, B1); PG8_BAR; PG8_SCHED;
            PG8_LDB(B0, 1, 0); PG8_LDB(B1, 1, 1); PG8_SCHED; PG8_LDA(At, 1, 0); PG8_STAGE(PG8_SA(0, 1), a2 + hstep, voffA);
            PG8_WAIT_V(8); PG8_WAIT_L(0); PG8_BAR; PG8_MMA(0, 0, At, B0); PG8_MMA(0, 1, At, B1); PG8_BAR; PG8_SCHED;
            PG8_LDA(At, 1, 1); PG8_STAGE(PG8_SB(1, 0), b3, voffB); PG8_STAGE(PG8_SB(1, 1), b3 + hstep, voffB); PG8_STAGE(PG8_SA(1, 0), a3, voffA);
            PG8_WAIT_V(8); PG8_WAIT_L(0); PG8_BAR; PG8_MMA(1, 0, At, B0); PG8_MMA(1, 1, At, B1); PG8_BAR; PG8_SCHED;
            } else {
            PG8_LDB(B0, 0, 0); PG8_SCHED; PG8_LDA(At, 0, 0); PG8_STAGE(PG8_SA(1, 1), a1 + hstep, voffA);
            PG8_WAIT_L(8); PG8_BAR; PG8_WAIT_L(0); PG8_MMA(0, 0, At, B0); PG8_BAR; PG8_SCHED;
            PG8_LDB(B1, 0, 1); PG8_STAGE(PG8_SB(0, 0), b2, voffB);
            PG8_BAR; PG8_WAIT_L(0); PG8_MMA(0, 1, At, B1); PG8_BAR;
            PG8_LDA(At, 0, 1); PG8_STAGE(PG8_SA(0, 0), a2, voffA);
            PG8_BAR; PG8_WAIT_L(0); PG8_MMA(1, 0, At, B0); PG8_BAR; PG8_SCHED;
            PG8_STAGE(PG8_SB(0, 1), b2 + hstep, voffB);
            PG8_WAIT_V(6); PG8_BAR; PG8_MMA(1, 1, At, B1); PG8_BAR;
            PG8_LDB(B0, 1, 0); PG8_SCHED; PG8_LDA(At, 1, 0); PG8_STAGE(PG8_SA(0, 1), a2 + hstep, voffA);
            PG8_WAIT_L(8); PG8_BAR; PG8_WAIT_L(0); PG8_MMA(0, 0, At, B0); PG8_BAR; PG8_SCHED;
            PG8_LDB(B1, 1, 1); PG8_STAGE(PG8_SB(1, 0), b3, voffB);
            PG8_BAR; PG8_WAIT_L(0); PG8_MMA(0, 1, At, B1); PG8_BAR;
            PG8_LDA(At, 1, 1); PG8_STAGE(PG8_SA(1, 0), a3, voffA);
            PG8_BAR; PG8_WAIT_L(0); PG8_MMA(1, 0, At, B0); PG8_BAR; PG8_SCHED;
            PG8_STAGE(PG8_SB(1, 1), b3 + hstep, voffB);
            PG8_WAIT_V(6); PG8_BAR; PG8_MMA(1, 1, At, B1); PG8_BAR;
            }
        }
        if constexpr (ALIGN_EPI) { if (wr == 0) PG8_BAR; }
        if constexpr (!Epi::AFTER_DRAIN) { E(acc, cur, wr, wc, fr, fq); S.done(cur); }
        if (!has_next) break;
#pragma unroll
        for (int a = 0; a < 2; ++a)
#pragma unroll
            for (int b = 0; b < 2; ++b)
#pragma unroll
                for (int m = 0; m < 4; ++m)
#pragma unroll
                    for (int n = 0; n < 2; ++n) acc[a][b][m][n] = (f32x4){0.f, 0.f, 0.f, 0.f};
        cur = nxt; cA = nA; cB = nB; ++ui;
        if constexpr (ALIGN_EPI) { if (wr == 1) PG8_BAR; }
    }
    PG8_WAIT_V(0);
    if constexpr (!ALIGN_EPI) { if (wr == 0) PG8_BAR; }
    PG8_BAR;
    if constexpr (Epi::AFTER_DRAIN) { E.fused(acc, cur, wr, wc, fr, fq, lds, wid, lane); S.done(cur); }
#undef PG8_SA
#undef PG8_SB
#undef PG8_STAGE
#undef PG8_LDA
#undef PG8_LDB
#undef PG8_MMA
#undef PG8_WAIT_V
#undef PG8_WAIT_L
#undef PG8_BAR
#undef PG8_SCHED
}
}

constexpr int NWAVES = 8;
constexpr int SEQ = 2048, D = 1024, M = 16 * SEQ;
constexpr int EA = 2048, NH = 16, CH = 128;
constexpr int FF = 2816;
constexpr float LN_EPS = 1e-6f;
#ifndef MK_ONE_LAUNCH
#define MK_ONE_LAUNCH 1
#endif
constexpr int N_PHASES = 12;

constexpr size_t MiB = 1u << 20;
constexpr size_t WS_AIN = 2 * MiB, WS_AOUT = 10 * MiB, WS_WS = 14 * MiB, WS_GU0 = 15 * MiB, WS_D0 = 26 * MiB, WS_GU1 = 32 * MiB, WS_D1 = 43 * MiB, WS_BIN = 49 * MiB, WS_BOUT = 55 * MiB;
constexpr size_t WS_SS = 58 * MiB, WS_VST = 60 * MiB;
constexpr size_t WS_XB = 64 * MiB;
constexpr size_t WS_U = 128 * MiB, WS_VT = 256 * MiB;
constexpr size_t WS_A = 128 * MiB;
constexpr size_t WS_YC = 304 * MiB, WS_Z = 384 * MiB, WS_BG = 448 * MiB, WS_END = 512 * MiB;
constexpr size_t WS_Y = 384 * MiB;
static_assert(WS_A + (size_t)M * FF * 2 <= WS_YC && WS_YC + (size_t)M * D * 2 <= WS_Z && WS_BG + (size_t)M * D * 2 <= WS_END, "d_ws map");
static_assert(WS_GU0 + (size_t)2 * FF * D * 2 <= WS_D0 && WS_D0 + (size_t)FF * D * 2 <= WS_GU1 && WS_D1 + (size_t)FF * D * 2 <= WS_BIN, "weight map");

constexpr int RING_BYTES = 131072, LDSCTL_OFF = RING_BYTES, MISC_OFF = LDSCTL_OFF + 320, LDS_BYTES = 147456;
constexpr size_t WS_CTL = 0, CTL_ZERO_BYTES = 65536;
constexpr int CW_BAR = 4096;

#define GAS __attribute__((address_space(1)))
#define LAS __attribute__((address_space(3)))
typedef unsigned short bf16;
typedef unsigned v4u __attribute__((ext_vector_type(4)));
typedef unsigned v2u __attribute__((ext_vector_type(2)));
typedef float f32x4 __attribute__((ext_vector_type(4)));
typedef float f32x2 __attribute__((ext_vector_type(2)));
typedef short bf16x8 __attribute__((ext_vector_type(8)));
#define LDS_WAIT() asm volatile("s_waitcnt lgkmcnt(0)" ::: "memory")
__device__ __forceinline__ unsigned f2bf(float f) { unsigned u = __builtin_bit_cast(unsigned, f); return (u + 0x7fffu + ((u >> 16) & 1u)) >> 16; }
__device__ __forceinline__ unsigned pk2(float lo, float hi) { return f2bf(lo) | (f2bf(hi) << 16); }
__device__ __forceinline__ float bflo(unsigned w) { return __builtin_bit_cast(float, w << 16); }
__device__ __forceinline__ float bfhi(unsigned w) { return __builtin_bit_cast(float, w & 0xffff0000u); }

typedef GAS unsigned gu32;
#define RLX_AGENT __ATOMIC_RELAXED, __HIP_MEMORY_SCOPE_AGENT
#define XB_TMO      128
#define XB_XCNT(j)  (256  + 64 * (j))
#define XB_XSUB(j)  (1280 + 64 * (j))
#define XB_XGEN(j)  (2304 + 64 * (j))
#define XB_TOP      3328
#define XB_TOPGEN   3392
#define XCD_BAR_WORDS 3456
#define XB_SPIN_CAP (1u << 18)

__device__ __forceinline__ unsigned xb_ld(unsigned* p)              { return __hip_atomic_load(p, __ATOMIC_RELAXED, __HIP_MEMORY_SCOPE_AGENT); }
__device__ __forceinline__ unsigned xb_add(unsigned* p, unsigned v) { return __hip_atomic_fetch_add(p, v, __ATOMIC_RELAXED, __HIP_MEMORY_SCOPE_AGENT); }
__device__ __forceinline__ unsigned xb_xcc_id() { return (unsigned)__builtin_amdgcn_s_getreg((3 << 11) | 20) & 0xFu; }
#define XB_SPIN(cond, bar) do { unsigned _sp = 0; while (cond) { __builtin_amdgcn_s_sleep(1); \
    if ((++_sp & 255u) == 0u) { if (xb_ld(&(bar)[XB_TMO])) break; if (_sp > XB_SPIN_CAP) { atomicAdd(&(bar)[XB_TMO], 1u); break; } } } } while (0)

struct XcdBarrier {
    unsigned* bar; unsigned x;
    volatile LAS unsigned* st;
};

__device__ __forceinline__ XcdBarrier xcd_barrier_post(unsigned* bar, volatile LAS unsigned* st) {
    XcdBarrier b; b.bar = bar; b.x = xb_xcc_id(); b.st = st;
    if (threadIdx.x == 0) (void)xb_add(&bar[XB_XCNT(b.x)], 1u);
    return b;
}
__device__ __forceinline__ void xcd_barrier_complete(unsigned* bar, unsigned x, unsigned& nloc, unsigned& nx) {
    const unsigned G = gridDim.x * gridDim.y * gridDim.z;
    unsigned sum, cnt, mine, sp = 0u;
    for (;;) {
        sum = 0u; cnt = 0u; mine = 0u;
#pragma unroll
        for (unsigned j = 0; j < 16; ++j) { const unsigned c = xb_ld(&bar[XB_XCNT(j)]); sum += c; cnt += (c > 0u) ? 1u : 0u; mine = (j == x) ? c : mine; }
        if (sum == G) break;
        __builtin_amdgcn_s_sleep(1);
        if ((++sp & 255u) == 0u) { if (xb_ld(&bar[XB_TMO])) break; if (sp > XB_SPIN_CAP) { atomicAdd(&bar[XB_TMO], 1u); break; } }
    }
    nloc = mine > 0u ? mine : 1u; nx = cnt > 0u ? cnt : 1u;
}

__device__ __forceinline__ void xcd_barrier(const XcdBarrier& b) {
    asm volatile("s_waitcnt vmcnt(0)" ::: "memory");
    __syncthreads();
    if (threadIdx.x == 0) {
        unsigned* bar = b.bar;
        __builtin_amdgcn_s_waitcnt(0);
        unsigned nloc = b.st[0], nx = b.st[1];
        if (nloc == 0u) { xcd_barrier_complete(bar, b.x, nloc, nx); b.st[0] = nloc; b.st[1] = nx; }
        const unsigned old = xb_add(&bar[XB_XSUB(b.x)], 1u);
        const unsigned gen = old / nloc;
        if (old + 1u == (gen + 1u) * nloc) {
            __builtin_amdgcn_fence(__ATOMIC_RELEASE, "agent");
            asm volatile("s_waitcnt vmcnt(0)" ::: "memory");
            const unsigned og = xb_add(&bar[XB_TOP], 1u);
            const unsigned tg = og / nx;
            if (og + 1u == (tg + 1u) * nx) xb_add(&bar[XB_TOPGEN], 1u);
            else XB_SPIN(xb_ld(&bar[XB_TOPGEN]) == tg, bar);
            __builtin_amdgcn_fence(__ATOMIC_ACQUIRE, "agent");
            xb_add(&bar[XB_XGEN(b.x)], 1u);
            asm volatile("s_waitcnt vmcnt(0)" ::: "memory");
        } else {
            XB_SPIN(xb_ld(&bar[XB_XGEN(b.x)]) == gen, bar);
            __builtin_amdgcn_fence(__ATOMIC_ACQUIRE, "agent");
            asm volatile("s_waitcnt vmcnt(0)" ::: "memory");
        }
    }
    __syncthreads();
}

struct Frame {
    LAS unsigned char* lds;
    int tid, lane, wave, vcu, G;
    const float *x, *mix_norm, *ffn_norm, *a_w_in, *a_v_gain, *a_v_bias, *a_w_s, *a_b_s, *a_w_out, *b_w_in, *b_conv_w, *b_w_out, *w_gate, *w_up, *w_down, *final_norm;
    float* out; unsigned char* ws;
};

__device__ __forceinline__ float wave_sum(float v) {
#pragma unroll
    for (int o = 1; o < 64; o <<= 1) v += __shfl_xor(v, o);
    return v;
}
template <int MODE> __device__ __forceinline__ void p0_transpose_item(const float* W, int K, int N, bf16* WT, int row_off, const float* gain, LAS float* scr, int item, int lane) {
    const int nblk = N / 32, kb = item / nblk, nb = item % nblk, k0 = 64 * kb, n0 = 32 * nb;
#pragma unroll 8
    for (int i = 0; i < 32; ++i) { const int kk = 2 * i + (lane >> 5); float w = W[(size_t)(k0 + kk) * N + n0 + (lane & 31)]; if (gain) w *= gain[k0 + kk]; scr[kk * 33 + (lane & 31)] = w; }
    LDS_WAIT(); asm volatile("" ::: "memory");
    const int c = lane & 7;
    const int rbase = (MODE == 0) ? (row_off + n0) : (row_off + 256 * (n0 / 128) + (n0 % 128));
#pragma unroll
    for (int j = 0; j < 4; ++j) { const int n = (lane >> 3) + 8 * j; const LAS float* s = scr + (8 * c) * 33 + n;
        v4u o; o.x = pk2(s[0 * 33], s[1 * 33]); o.y = pk2(s[2 * 33], s[3 * 33]); o.z = pk2(s[4 * 33], s[5 * 33]); o.w = pk2(s[6 * 33], s[7 * 33]);
        *(GAS v4u*)(WT + (size_t)(rbase + n) * K + k0 + 8 * c) = o; }
    LDS_WAIT(); asm volatile("" ::: "memory");
}
__device__ __forceinline__ void p0_prologue(Frame& F) {
    LAS float* scr = (LAS float*)(F.lds + F.wave * 16384);
    const int gw = F.vcu * NWAVES + F.wave, NGW = F.G * NWAVES;
    unsigned char* ws = F.ws;
    constexpr int I_AIN = (D / 64) * (2 * EA / 32), I_AOUT = (EA / 64) * (D / 32), I_G = (D / 64) * (FF / 32), I_DN = (FF / 64) * (D / 32), I_BIN = (D / 64) * (D / 32), I_BOUT = (D / 64) * (D / 32);
    constexpr int NITEMS = I_AIN + I_AOUT + 4 * I_G + 2 * I_DN + 3 * I_BIN + I_BOUT;
    for (int it = gw; it < NITEMS; it += NGW) {
        int r = it;
        if (r < I_AIN) { p0_transpose_item<0>(F.a_w_in, D, 2 * EA, (bf16*)(ws + WS_AIN), 0, F.mix_norm, scr, r, F.lane); continue; } r -= I_AIN;
        if (r < I_AOUT) { p0_transpose_item<0>(F.a_w_out, EA, D, (bf16*)(ws + WS_AOUT), 0, nullptr, scr, r, F.lane); continue; } r -= I_AOUT;
        if (r < I_G) { p0_transpose_item<1>(F.w_gate, D, FF, (bf16*)(ws + WS_GU0), 0, F.ffn_norm, scr, r, F.lane); continue; } r -= I_G;
        if (r < I_G) { p0_transpose_item<1>(F.w_up, D, FF, (bf16*)(ws + WS_GU0), 128, F.ffn_norm, scr, r, F.lane); continue; } r -= I_G;
        if (r < I_G) { p0_transpose_item<1>(F.w_gate + (size_t)D * FF, D, FF, (bf16*)(ws + WS_GU1), 0, F.ffn_norm + D, scr, r, F.lane); continue; } r -= I_G;
        if (r < I_G) { p0_transpose_item<1>(F.w_up + (size_t)D * FF, D, FF, (bf16*)(ws + WS_GU1), 128, F.ffn_norm + D, scr, r, F.lane); continue; } r -= I_G;
        if (r < I_DN) { p0_transpose_item<0>(F.w_down, FF, D, (bf16*)(ws + WS_D0), 0, nullptr, scr, r, F.lane); continue; } r -= I_DN;
        if (r < I_DN) { p0_transpose_item<0>(F.w_down + (size_t)FF * D, FF, D, (bf16*)(ws + WS_D1), 0, nullptr, scr, r, F.lane); continue; } r -= I_DN;
        if (r < 3 * I_BIN) {
            const int nblk = 3 * D / 32, nb = r % nblk, n0 = 32 * nb, part = n0 / D;
            const int kb = r / nblk, k0 = 64 * kb; const float* W = F.b_w_in; bf16* WT = (bf16*)(ws + WS_BIN); const float* gain = F.mix_norm + D;
#pragma unroll 8
            for (int i = 0; i < 32; ++i) { const int kk = 2 * i + (F.lane >> 5); scr[kk * 33 + (F.lane & 31)] = W[(size_t)(k0 + kk) * (3 * D) + n0 + (F.lane & 31)] * gain[k0 + kk]; }
            LDS_WAIT(); asm volatile("" ::: "memory");
            const int e0 = n0 - part * D;
            const int rbase = (part == 0) ? (2048 + e0) : (256 * (e0 / 128) + (e0 % 128) + (part == 2 ? 128 : 0));
            const int c = F.lane & 7;
#pragma unroll
            for (int j = 0; j < 4; ++j) { const int n = (F.lane >> 3) + 8 * j; const LAS float* s = scr + (8 * c) * 33 + n;
                v4u o; o.x = pk2(s[0 * 33], s[1 * 33]); o.y = pk2(s[2 * 33], s[3 * 33]); o.z = pk2(s[4 * 33], s[5 * 33]); o.w = pk2(s[6 * 33], s[7 * 33]);
                *(GAS v4u*)(WT + (size_t)(rbase + n) * D + k0 + 8 * c) = o; }
            LDS_WAIT(); asm volatile("" ::: "memory");
            continue; } r -= 3 * I_BIN;
        p0_transpose_item<0>(F.b_w_out, D, D, (bf16*)(ws + WS_BOUT), 0, nullptr, scr, r, F.lane);
    }
    { const int gt = (F.vcu * NWAVES + F.wave) * 64 + F.lane, NGT = NGW * 64; bf16* o = (bf16*)(ws + WS_WS);
      for (int i = gt; i < NH * CH * CH / 2; i += NGT) { const int e = 2 * i, t = (e / CH) % CH, s = e % CH; const float a = F.a_w_s[e], b = F.a_w_s[e + 1];
          ((GAS unsigned*)o)[i] = pk2(s <= t ? a : 0.f, (s + 1) <= t ? b : 0.f); } }
    for (int m = gw; m < M; m += NGW) {
        const GAS f32x4* xr = (const GAS f32x4*)(F.x + (size_t)m * D) + F.lane;
        f32x4 v[4]; float s = 0.f;
#pragma unroll
        for (int j = 0; j < 4; ++j) { v[j] = xr[64 * j]; s += (v[j].x * v[j].x + v[j].y * v[j].y) + (v[j].z * v[j].z + v[j].w * v[j].w); }
        const float rstd = 1.f / sqrtf(wave_sum(s) * (1.f / D) + pg8::RMS_EPS);
        GAS unsigned long long* o8 = (GAS unsigned long long*)((bf16*)(ws + WS_XB) + (size_t)m * D) + F.lane;
#pragma unroll
        for (int j = 0; j < 4; ++j) o8[64 * j] = (unsigned long long)pk2(v[j].x * rstd, v[j].y * rstd) | ((unsigned long long)pk2(v[j].z * rstd, v[j].w * rstd) << 32);
    }
}

constexpr int SG_PITCH = 272;
constexpr int SG_W = 0, SG_V = 128 * SG_PITCH, SG_ST = 2 * 128 * SG_PITCH;
__device__ __forceinline__ void sgu_phase(Frame& F) {
    LAS unsigned char* lds = F.lds;
    const int tid = F.tid, lane = F.lane, w = F.wave, fr = lane & 15, fq = lane >> 4;
    const bf16* U = (const bf16*)(F.ws + WS_U); bf16* Y = (bf16*)(F.ws + WS_Y); const bf16* VT = (const bf16*)(F.ws + WS_VT); const bf16* WSB = (const bf16*)(F.ws + WS_WS);
    const f32x2* vst = (const f32x2*)(F.ws + WS_VST);
    for (int chunk = F.vcu; chunk < M / CH; chunk += F.G) {
        const int t0 = chunk * CH;
        if (tid < CH) { const f32x4* p = (const f32x4*)(vst + (size_t)(t0 + tid) * 16); float s = 0.f, q = 0.f;
#pragma unroll
            for (int i = 0; i < 8; ++i) { const f32x4 a = p[i]; s += a[0] + a[2]; q += a[1] + a[3]; }
            const float mean = s * (1.f / EA); const float var = q * (1.f / EA) - mean * mean;
            ((LAS f32x2*)(lds + SG_ST))[tid] = (f32x2){mean, 1.f / sqrtf(var + LN_EPS)}; }
        __syncthreads();
        for (int h = 0; h < NH; ++h) {
#pragma unroll
            for (int i = 0; i < 4; ++i) { const int p = tid + 512 * i, r = p >> 4, cs = p & 15;
                const v4u wv = *(const GAS v4u*)(WSB + (size_t)h * CH * CH + r * CH + cs * 8);
                *(LAS v4u*)(lds + SG_W + r * SG_PITCH + cs * 16) = wv; }
#pragma unroll
            for (int i = 0; i < 4; ++i) { const int p = tid + 512 * i, r = p >> 4, cs = p & 15; const int c = h * CH + r;
                const v4u vv = *(const GAS v4u*)(VT + (size_t)c * M + t0 + cs * 8);
                const float g = F.a_v_gain[c], b = F.a_v_bias[c];
                const LAS f32x2* st = (const LAS f32x2*)(lds + SG_ST) + cs * 8;
                float o[8]; const unsigned wd[4] = {vv.x, vv.y, vv.z, vv.w};
#pragma unroll
                for (int k = 0; k < 4; ++k) { const f32x2 s0 = st[2 * k], s1 = st[2 * k + 1];
                    o[2 * k] = (bflo(wd[k]) - s0.x) * s0.y * g + b; o[2 * k + 1] = (bfhi(wd[k]) - s1.x) * s1.y * g + b; }
                v4u ov; ov.x = pk2(o[0], o[1]); ov.y = pk2(o[2], o[3]); ov.z = pk2(o[4], o[5]); ov.w = pk2(o[6], o[7]);
                *(LAS v4u*)(lds + SG_V + r * SG_PITCH + cs * 16) = ov; }
            __syncthreads();
            f32x4 acc[4][2];
#pragma unroll
            for (int g = 0; g < 4; ++g) { acc[g][0] = (f32x4){0.f, 0.f, 0.f, 0.f}; acc[g][1] = (f32x4){0.f, 0.f, 0.f, 0.f}; }
            const int kmax = (16 * w + 15) / 32;
            for (int kk = 0; kk <= kmax; ++kk) {
                const bf16x8 a = *(const LAS bf16x8*)(lds + SG_W + (16 * w + fr) * SG_PITCH + kk * 64 + fq * 16);
#pragma unroll
                for (int g = 0; g < 4; ++g)
#pragma unroll
                    for (int n = 0; n < 2; ++n) { const int crow = 32 * g + 8 * (fr >> 2) + 4 * n + (fr & 3);
                        const bf16x8 b = *(const LAS bf16x8*)(lds + SG_V + crow * SG_PITCH + kk * 64 + fq * 16);
                        acc[g][n] = __builtin_amdgcn_mfma_f32_16x16x32_bf16(b, a, acc[g][n], 0, 0, 0); }
            }
            const int t = 16 * w + fr; const float bs = F.a_b_s[h * CH + t];
            const bf16* up = U + (size_t)(t0 + t) * EA + h * CH + 8 * fq; bf16* yp = Y + (size_t)(t0 + t) * EA + h * CH + 8 * fq;
#pragma unroll
            for (int g = 0; g < 4; ++g) { const v4u uv = *(const GAS v4u*)(up + 32 * g);
                v4u ov; ov.x = pk2(bflo(uv.x) * (acc[g][0][0] + bs), bfhi(uv.x) * (acc[g][0][1] + bs)); ov.y = pk2(bflo(uv.y) * (acc[g][0][2] + bs), bfhi(uv.y) * (acc[g][0][3] + bs));
                ov.z = pk2(bflo(uv.z) * (acc[g][1][0] + bs), bfhi(uv.z) * (acc[g][1][1] + bs)); ov.w = pk2(bflo(uv.w) * (acc[g][1][2] + bs), bfhi(uv.w) * (acc[g][1][3] + bs));
                *(GAS v4u*)(yp + 32 * g) = ov; }
            __syncthreads();
        }
    }
}

__device__ __forceinline__ void conv_phase(Frame& F) {
    const bf16* Z = (const bf16*)(F.ws + WS_Z); const bf16* BG = (const bf16*)(F.ws + WS_BG); bf16* YC = (bf16*)(F.ws + WS_YC);
    const int gt = F.vcu * 512 + F.tid, NGT = F.G * 512;
    for (int i = gt; i < M * (D / 8); i += NGT) {
        const int row = i >> 7, c8 = (i & 127) * 8, tpos = row & (SEQ - 1);
        const size_t off = (size_t)row * D + c8;
        const v4u z2 = *(const GAS v4u*)(Z + off), bg = *(const GAS v4u*)(BG + off);
        v4u z1 = (v4u){0u, 0u, 0u, 0u}, z0 = (v4u){0u, 0u, 0u, 0u};
        if (tpos >= 1) z1 = *(const GAS v4u*)(Z + off - D);
        if (tpos >= 2) z0 = *(const GAS v4u*)(Z + off - 2 * D);
        const f32x4 w0a = *(const GAS f32x4*)(F.b_conv_w + c8), w0b = *(const GAS f32x4*)(F.b_conv_w + c8 + 4);
        const f32x4 w1a = *(const GAS f32x4*)(F.b_conv_w + D + c8), w1b = *(const GAS f32x4*)(F.b_conv_w + D + c8 + 4);
        const f32x4 w2a = *(const GAS f32x4*)(F.b_conv_w + 2 * D + c8), w2b = *(const GAS f32x4*)(F.b_conv_w + 2 * D + c8 + 4);
        const unsigned a0[4] = {z0.x, z0.y, z0.z, z0.w}, a1[4] = {z1.x, z1.y, z1.z, z1.w}, a2[4] = {z2.x, z2.y, z2.z, z2.w}, ab[4] = {bg.x, bg.y, bg.z, bg.w};
        const float w0[8] = {w0a[0], w0a[1], w0a[2], w0a[3], w0b[0], w0b[1], w0b[2], w0b[3]}, w1[8] = {w1a[0], w1a[1], w1a[2], w1a[3], w1b[0], w1b[1], w1b[2], w1b[3]}, w2[8] = {w2a[0], w2a[1], w2a[2], w2a[3], w2b[0], w2b[1], w2b[2], w2b[3]};
        unsigned o[4];
#pragma unroll
        for (int k = 0; k < 4; ++k) {
            const float lo = bflo(ab[k]) * (bflo(a0[k]) * w0[2 * k] + bflo(a1[k]) * w1[2 * k] + bflo(a2[k]) * w2[2 * k]);
            const float hi = bfhi(ab[k]) * (bfhi(a0[k]) * w0[2 * k + 1] + bfhi(a1[k]) * w1[2 * k + 1] + bfhi(a2[k]) * w2[2 * k + 1]);
            o[k] = pk2(lo, hi); }
        *(GAS v4u*)(YC + off) = (v4u){o[0], o[1], o[2], o[3]};
    }
}
__device__ __forceinline__ void final_norm_phase(Frame& F) {
    const int gw = F.vcu * NWAVES + F.wave, NGW = F.G * NWAVES; const float* ss = (const float*)(F.ws + WS_SS); const bf16* XBp = (const bf16*)(F.ws + WS_XB);
    const GAS f32x4* gr = (const GAS f32x4*)F.final_norm + 2 * F.lane;
    for (int m = gw; m < M; m += NGW) {
        float s = (F.lane < 16) ? ss[(size_t)m * 16 + F.lane] : 0.f;
        s = wave_sum(s);
        const float rstd = 1.f / sqrtf(s * (1.f / D) + pg8::RMS_EPS);
        const GAS v4u* xr = (const GAS v4u*)(XBp + (size_t)m * D) + F.lane; GAS f32x4* orow = (GAS f32x4*)(F.out + (size_t)m * D) + 2 * F.lane;
#pragma unroll
        for (int j = 0; j < 2; ++j) { const v4u v = xr[64 * j]; const f32x4 g0 = gr[128 * j], g1 = gr[128 * j + 1];
            orow[128 * j] = (f32x4){bflo(v.x), bfhi(v.x), bflo(v.y), bfhi(v.y)} * rstd * g0;
            orow[128 * j + 1] = (f32x4){bflo(v.z), bfhi(v.z), bflo(v.w), bfhi(v.w)} * rstd * g1; }
    }
}

struct Args { const float* in[16]; float* out; unsigned char* ws; int ph_lo, ph_hi, rep_mask, pad; };
__global__ void __launch_bounds__(NWAVES * 64, 2) hybrid_fwd(Args args) {
    extern __shared__ __attribute__((aligned(16))) unsigned char lds[];
    cg::grid_group grid = cg::this_grid();
    Frame F;
    F.lds = (LAS unsigned char*)lds;
    F.tid = threadIdx.x; F.lane = F.tid & 63; F.wave = __builtin_amdgcn_readfirstlane(F.tid >> 6);
    F.G = gridDim.x; { const int bx = blockIdx.x; F.vcu = (F.G % 8 == 0) ? (bx % 8) * (F.G / 8) + bx / 8 : bx; }
    F.x = args.in[0]; F.mix_norm = args.in[1]; F.ffn_norm = args.in[2]; F.a_w_in = args.in[3]; F.a_v_gain = args.in[4]; F.a_v_bias = args.in[5]; F.a_w_s = args.in[6]; F.a_b_s = args.in[7];
    F.a_w_out = args.in[8]; F.b_w_in = args.in[9]; F.b_conv_w = args.in[10]; F.b_w_out = args.in[11]; F.w_gate = args.in[12]; F.w_up = args.in[13]; F.w_down = args.in[14]; F.final_norm = args.in[15];
    F.out = args.out; F.ws = args.ws;
    unsigned char* ws = args.ws;
    for (int u = F.tid; u < (LDS_BYTES - LDSCTL_OFF) / 4; u += NWAVES * 64) ((LAS unsigned*)(F.lds + LDSCTL_OFF))[u] = 0u;
    __syncthreads();
    XcdBarrier bar = xcd_barrier_post((unsigned*)(ws + WS_CTL) + CW_BAR, (volatile LAS unsigned*)(F.lds + MISC_OFF) + 8);
    const int lo = args.ph_lo, hi = args.ph_hi;
    if (lo < 0) grid.sync();
#ifndef REP_MASK
#define REP_MASK 0
#endif
#ifndef EXTRA_SYNCS
#define EXTRA_SYNCS 0
#endif
#define REPS(k) 1
#define IN(k) (lo <= (k) && (k) < hi)
#define SEAM(k) do { if (IN(k) && IN((k) + 1)) xcd_barrier(bar); } while (0)
    pg8::bf16_t* XB = (pg8::bf16_t*)(ws + WS_XB); float* SS = (float*)(ws + WS_SS);
    const int c = (int)blockIdx.x;

    if (IN(0)) { p0_prologue(F); __syncthreads(); } SEAM(0);

    if (IN(1)) {
        { pg8::Gemm g{XB, (const pg8::bf16_t*)(ws + WS_AIN), M, EA, D}; pg8::StaticOrder S; S.init(M, EA, F.G, c);
          pg8::EpiGelu E{(pg8::bf16_t*)(ws + WS_U), EA};
          pg8::gemm_phase<pg8::EpiGelu, pg8::StaticOrder, true, true>(F.lds, g, S, E); }
        { pg8::Gemm g{(const pg8::bf16_t*)(ws + WS_AIN) + (size_t)EA * D, XB, EA, M, D}; pg8::StaticOrder S; S.init(EA, M, F.G, c);
          pg8::EpiGeluT E{(pg8::bf16_t*)(ws + WS_VT), M, (pg8::f32x2*)(ws + WS_VST)};
          pg8::gemm_phase<pg8::EpiGeluT, pg8::StaticOrder, true, true>(F.lds, g, S, E); }
    } SEAM(1);

    if (IN(2)) { sgu_phase(F); } SEAM(2);

    if (IN(3)) {
        pg8::Gemm g{(const pg8::bf16_t*)(ws + WS_Y), (const pg8::bf16_t*)(ws + WS_AOUT), M, D, EA}; pg8::StaticOrder S; S.init(M, D, F.G, c);
        pg8::EpiRes<true> E{F.x, XB, SS};
        pg8::gemm_phase<pg8::EpiRes<true>, pg8::StaticOrder, true, true>(F.lds, g, S, E);
    } SEAM(3);

    if (IN(4)) {
        pg8::Gemm g{XB, (const pg8::bf16_t*)(ws + WS_GU0), M, 2 * FF, D}; pg8::StaticOrder S; S.init(M, 2 * FF, F.G, c);
        pg8::EpiSwiglu E{(pg8::bf16_t*)(ws + WS_A), FF, SS};
        pg8::gemm_phase<pg8::EpiSwiglu, pg8::StaticOrder, true, true>(F.lds, g, S, E);
    } SEAM(4);

    if (IN(5)) {
        pg8::Gemm g{(const pg8::bf16_t*)(ws + WS_A), (const pg8::bf16_t*)(ws + WS_D0), M, D, FF}; pg8::StaticOrder S; S.init(M, D, F.G, c);
        pg8::EpiRes<false> E{nullptr, XB, SS};
        pg8::gemm_phase<pg8::EpiRes<false>, pg8::StaticOrder, true, true>(F.lds, g, S, E);
    } SEAM(5);

    if (IN(6)) {
        pg8::Gemm g{XB, (const pg8::bf16_t*)(ws + WS_BIN), M, 3 * D, D}; pg8::StaticOrder S; S.init(M, 3 * D, F.G, c);
        pg8::EpiConvIn E{(pg8::bf16_t*)(ws + WS_Z), (pg8::bf16_t*)(ws + WS_BG), SS};
        pg8::gemm_phase<pg8::EpiConvIn, pg8::StaticOrder, true, true>(F.lds, g, S, E);
    } SEAM(6);

    if (IN(7)) { conv_phase(F); } SEAM(7);

    if (IN(8)) {
        pg8::Gemm g{(const pg8::bf16_t*)(ws + WS_YC), (const pg8::bf16_t*)(ws + WS_BOUT), M, D, D}; pg8::StaticOrder S; S.init(M, D, F.G, c);
        pg8::EpiRes<false> E{nullptr, XB, SS};
        pg8::gemm_phase<pg8::EpiRes<false>, pg8::StaticOrder, true, true>(F.lds, g, S, E);
    } SEAM(8);

    if (IN(9)) {
        pg8::Gemm g{XB, (const pg8::bf16_t*)(ws + WS_GU1), M, 2 * FF, D}; pg8::StaticOrder S; S.init(M, 2 * FF, F.G, c);
        pg8::EpiSwiglu E{(pg8::bf16_t*)(ws + WS_A), FF, SS};
        pg8::gemm_phase<pg8::EpiSwiglu, pg8::StaticOrder, true, true>(F.lds, g, S, E);
    } SEAM(9);

    if (IN(10)) {
        pg8::Gemm g{(const pg8::bf16_t*)(ws + WS_A), (const pg8::bf16_t*)(ws + WS_D1), M, D, FF}; pg8::StaticOrder S; S.init(M, D, F.G, c);
        pg8::EpiRes<false> E{nullptr, XB, SS};
        pg8::gemm_phase<pg8::EpiRes<false>, pg8::StaticOrder, true, true>(F.lds, g, S, E);
    } SEAM(10);

    for (int i = 0; i < EXTRA_SYNCS; ++i) xcd_barrier(bar);
    if (IN(11)) { final_norm_phase(F); }
#undef IN
#undef SEAM
}

extern "C" void kernel_launch(void* const* d_in, const int* in_sizes, int n_in, void* d_out, int out_size, void* d_ws, size_t ws_size, hipStream_t stream) {
    static int grid = 0;
    if (grid == 0) {
        if (n_in != 16 || in_sizes[0] != M * D || out_size != M * D || ws_size < WS_END) { fprintf(stderr, "kernel_launch: unexpected shapes (n_in %d, in0 %d, out %d, ws %zu); nothing launched\n", n_in, n_in > 0 ? in_sizes[0] : -1, out_size, ws_size); grid = -1; return; }
        int dev = 0, cus = 0, per_cu = 0;
        if (hipGetDevice(&dev) != hipSuccess || hipDeviceGetAttribute(&cus, hipDeviceAttributeMultiprocessorCount, dev) != hipSuccess) { grid = -1; return; }
        if (hipFuncSetAttribute((const void*)hybrid_fwd, hipFuncAttributeMaxDynamicSharedMemorySize, LDS_BYTES) != hipSuccess) { fprintf(stderr, "kernel_launch: hipFuncSetAttribute failed\n"); grid = -1; return; }
        if (hipOccupancyMaxActiveBlocksPerMultiprocessor(&per_cu, (const void*)hybrid_fwd, NWAVES * 64, LDS_BYTES) != hipSuccess || per_cu < 1) { fprintf(stderr, "kernel_launch: occupancy query says %d blocks per CU\n", per_cu); per_cu = 1; }
        (void)hipGetLastError();
        grid = cus;
    }
    if (grid < 0) return;
    if (hipMemsetAsync((char*)d_ws + WS_CTL, 0, CTL_ZERO_BYTES, stream) != hipSuccess) { fprintf(stderr, "kernel_launch: memset failed\n"); return; }
    Args a{};
    for (int i = 0; i < 16; ++i) a.in[i] = (const float*)d_in[i];
    a.out = (float*)d_out; a.ws = (unsigned char*)d_ws; a.rep_mask = REP_MASK;
#if MK_ONE_LAUNCH
    a.ph_lo = 0; a.ph_hi = N_PHASES;
    void* kargs[] = {&a};
    const hipError_t e = hipLaunchCooperativeKernel((const void*)hybrid_fwd, dim3(grid), dim3(NWAVES * 64), kargs, LDS_BYTES, stream);
    if (e != hipSuccess) fprintf(stderr, "kernel_launch: cooperative launch failed: %s (grid %d)\n", hipGetErrorString(e), grid);
#else
    for (int p = 0; p < N_PHASES; ++p) { a.ph_lo = p; a.ph_hi = p + 1; hipLaunchKernelGGL(hybrid_fwd, dim3(grid), dim3(NWAVES * 64), LDS_BYTES, stream, a); }
#endif
}
```

```cpp
#include <hip/hip_runtime.h>
#include <hip/hip_cooperative_groups.h>
#include <cstdio>
#include <cstdint>
namespace cg = cooperative_groups;

namespace pg8 {
#define PG8_LAS __attribute__((address_space(3)))
typedef unsigned short bf16_t;
typedef short bf16x8 __attribute__((ext_vector_type(8)));
typedef float f32x4 __attribute__((ext_vector_type(4)));
typedef unsigned u32x4 __attribute__((ext_vector_type(4)));
constexpr int BM = 256, BK = 64, HALF = 128, HTB = HALF * BK * 2  , STAGE_BYTES = 8 * HTB, NXCD = 8, WGM = 8;

__host__ __device__ __forceinline__ int lds_byte(int r, int c) { const int st = (r >> 4) * 2 + (c >> 5), rr = r & 15, cc = c & 31, ob = rr * 64 + cc * 2; return st * 1024 + (ob ^ (((ob >> 9) & 1) << 5)); }
__host__ __device__ __forceinline__ void stage_rc(int b, int& R, int& C) { const int st = b / 1024, sb = b % 1024, swz = sb ^ (((sb >> 9) & 1) << 5); R = (st >> 1) * 16 + swz / 64; C = (st & 1) * 32 + (swz % 64) / 2; }
__host__ __device__ __forceinline__ int perm32(int rho) { const int n = rho >> 4, i = rho & 15; return 8 * (i >> 2) + 4 * n + (i & 3); }

struct Unit { int pm, pn; };
struct Gemm { const bf16_t* A; const bf16_t* Bt; int M, N, K; };

struct StaticOrder {
    int nM, nN, nwg, G, c;
    __host__ __device__ void init(int M, int N, int G_, int c_) { nM = M / BM; nN = N / BM; nwg = nM * nN; G = G_; c = c_; }
    __host__ __device__ bool next(int i, Unit& u) const {
        const long L = (long)i * G + c; if (L >= nwg) return false;
        int wgid = (int)L; { const int q = nwg / NXCD, r = nwg % NXCD, xcd = wgid % NXCD, off = wgid / NXCD; wgid = (xcd < r ? xcd * (q + 1) : r * (q + 1) + (xcd - r) * q) + off; }
        const int nig = WGM * nN, gid = wgid / nig, fm = gid * WGM, gsz = (nM - fm) < WGM ? (nM - fm) : WGM;
        u.pm = fm + ((wgid % nig) % gsz); u.pn = (wgid % nig) / gsz; return true;
    }
    __device__ __forceinline__ void a_ready(const Unit&) const {}
    __device__ __forceinline__ void done(const Unit&) const {}
};

__device__ __forceinline__ unsigned cvt_pk_bf16(float lo, float hi) { unsigned r; asm volatile("v_cvt_pk_bf16_f32 %0, %1, %2" : "=v"(r) : "v"(lo), "v"(hi)); return r; }
typedef float f32x2 __attribute__((ext_vector_type(2)));
typedef unsigned u32x2 __attribute__((ext_vector_type(2)));
constexpr float RMS_EPS = 1e-6f;
constexpr int SS_M = 32768;
__device__ __forceinline__ float gelu_tanh(float v) {
    const float w = v * (1.0f + 0.044715f * v * v);
    const float e = __builtin_amdgcn_exp2f(w * (-2.0f * 0.7978845608028654f * 1.4426950408889634f));
    return v * __builtin_amdgcn_rcpf(1.0f + e);
}
__device__ __forceinline__ float silu_f(float v) {
    const float e = __builtin_amdgcn_exp2f(v * (-1.4426950408889634f));
    return v * __builtin_amdgcn_rcpf(1.0f + e);
}
__device__ __forceinline__ u32x4 pack8(const f32x4 a, const f32x4 b) {
    u32x4 w; w.x = cvt_pk_bf16(a[0], a[1]); w.y = cvt_pk_bf16(a[2], a[3]); w.z = cvt_pk_bf16(b[0], b[1]); w.w = cvt_pk_bf16(b[2], b[3]); return w;
}
__device__ __forceinline__ float row_rstd(const float* ss, int row, int fq) {
    const f32x4 p = *(const f32x4*)(ss + (size_t)row * 16 + fq * 4);
    float s = (p[0] + p[1]) + (p[2] + p[3]);
    s += __shfl_xor(s, 16); s += __shfl_xor(s, 32);
    return 1.0f / sqrtf(s * (1.0f / 1024.0f) + RMS_EPS);
}

struct EpiGelu {
    static constexpr bool PERM = true, AFTER_DRAIN = false;
    bf16_t* O; int ldc;
    __device__ __forceinline__ void operator()(const f32x4 (&acc)[2][2][4][2], const Unit& u, int wr, int wc, int fr, int fq) const {
        const int row0 = u.pm * BM + wr * 64 + fr, col0 = u.pn * BM + wc * 32 + 8 * fq;
#pragma unroll
        for (int ai = 0; ai < 2; ++ai)
#pragma unroll
            for (int m = 0; m < 4; ++m) { bf16_t* rowp = O + (size_t)(row0 + ai * HALF + m * 16) * ldc + col0;
#pragma unroll
                for (int bj = 0; bj < 2; ++bj) { f32x4 v0 = acc[ai][bj][m][0], v1 = acc[ai][bj][m][1];
#pragma unroll
                    for (int e = 0; e < 4; ++e) { v0[e] = gelu_tanh(v0[e]); v1[e] = gelu_tanh(v1[e]); }
                    *(u32x4*)(rowp + bj * HALF) = pack8(v0, v1); } }
    }
};
struct EpiGeluT {
    static constexpr bool PERM = true, AFTER_DRAIN = false;
    bf16_t* O; f32x2* vst;
    __device__ __forceinline__ void operator()(const f32x4 (&acc)[2][2][4][2], const Unit& u, int wr, int wc, int fr, int fq) const {
        const int row0 = u.pm * BM + wr * 64 + fr, col0 = u.pn * BM + wc * 32 + 8 * fq;
        float v[32];
#pragma unroll
        for (int i = 0; i < 32; ++i) v[i] = 0.f;
#pragma unroll
        for (int ai = 0; ai < 2; ++ai)
#pragma unroll
            for (int m = 0; m < 4; ++m) { bf16_t* rowp = O + ((size_t)(2 * u.pn) * 2048 + (row0 + ai * HALF + m * 16)) * 128 + wc * 32 + 8 * fq;
#pragma unroll
                for (int bj = 0; bj < 2; ++bj) { f32x4 v0 = acc[ai][bj][m][0], v1 = acc[ai][bj][m][1];
#pragma unroll
                    for (int e = 0; e < 4; ++e) { v0[e] = gelu_tanh(v0[e]); v1[e] = gelu_tanh(v1[e]);
                        v[2 * (8 * bj + e)] += v0[e]; v[2 * (8 * bj + e) + 1] += v0[e] * v0[e];
                        v[2 * (8 * bj + 4 + e)] += v1[e]; v[2 * (8 * bj + 4 + e) + 1] += v1[e] * v1[e]; }
                    *(u32x4*)(rowp + (size_t)bj * 2048 * 128) = pack8(v0, v1); } }
#define PG8_XSTEP(H, MASK) { const bool bit = (fr & (MASK)) != 0; _Pragma("unroll") for (int i = 0; i < (H); ++i) { const float send = bit ? v[i] : v[i + (H)]; const float keep = bit ? v[i + (H)] : v[i]; v[i] = keep + __shfl_xor(send, (MASK)); } }
        PG8_XSTEP(16, 8) PG8_XSTEP(8, 4) PG8_XSTEP(4, 2) PG8_XSTEP(2, 1)
#undef PG8_XSTEP
        const int token = u.pn * BM + (fr >> 3) * HALF + wc * 32 + 8 * fq + (fr & 7);
        vst[(size_t)(u.pm * 2 + wr) * SS_M + token] = (f32x2){v[0], v[1]};
    }
};
template <bool F32BASE> struct EpiRes {
    static constexpr bool PERM = true, AFTER_DRAIN = false;
    const float* base; bf16_t* xb; float* ss;
    __device__ __forceinline__ void operator()(const f32x4 (&acc)[2][2][4][2], const Unit& u, int wr, int wc, int fr, int fq) const {
        const int row0 = u.pm * BM + wr * 64 + fr, col0 = u.pn * BM + wc * 32 + 8 * fq;
        if constexpr (F32BASE) {
#pragma unroll
            for (int ai = 0; ai < 2; ++ai) {
                f32x4 pre[4][2][2];
#pragma unroll
                for (int m = 0; m < 4; ++m) { const size_t off = (size_t)(row0 + ai * HALF + m * 16) * 1024 + col0;
#pragma unroll
                    for (int bj = 0; bj < 2; ++bj) { pre[m][bj][0] = *(const f32x4*)(base + off + bj * HALF); pre[m][bj][1] = *(const f32x4*)(base + off + bj * HALF + 4); } }
                asm volatile("" ::: "memory");
#pragma unroll
                for (int m = 0; m < 4; ++m) { const int row = row0 + ai * HALF + m * 16; const size_t off = (size_t)row * 1024 + col0; float q = 0.f;
#pragma unroll
                    for (int bj = 0; bj < 2; ++bj) {
                        const f32x4 o0 = pre[m][bj][0] + acc[ai][bj][m][0], o1 = pre[m][bj][1] + acc[ai][bj][m][1];
                        q += (o0[0] * o0[0] + o0[1] * o0[1]) + (o0[2] * o0[2] + o0[3] * o0[3]) + (o1[0] * o1[0] + o1[1] * o1[1]) + (o1[2] * o1[2] + o1[3] * o1[3]);
                        *(u32x4*)(xb + off + bj * HALF) = pack8(o0, o1); }
                    q += __shfl_xor(q, 16); q += __shfl_xor(q, 32);
                    if (fq == 0) ss[(size_t)(u.pn * 4 + wc) * SS_M + row] = q; }
                asm volatile("" ::: "memory");
            }
        } else {
            u32x4 pre[2][4][2];
#pragma unroll
            for (int ai = 0; ai < 2; ++ai)
#pragma unroll
                for (int m = 0; m < 4; ++m) { const size_t off = (size_t)(row0 + ai * HALF + m * 16) * 1024 + col0;
#pragma unroll
                    for (int bj = 0; bj < 2; ++bj) pre[ai][m][bj] = *(const u32x4*)(xb + off + bj * HALF); }
            asm volatile("" ::: "memory");
#pragma unroll
            for (int ai = 0; ai < 2; ++ai)
#pragma unroll
                for (int m = 0; m < 4; ++m) { const int row = row0 + ai * HALF + m * 16; const size_t off = (size_t)row * 1024 + col0; float q = 0.f;
#pragma unroll
                    for (int bj = 0; bj < 2; ++bj) { const u32x4 p = pre[ai][m][bj];
                        const f32x4 b0 = {__builtin_bit_cast(float, p.x << 16), __builtin_bit_cast(float, p.x & 0xffff0000u), __builtin_bit_cast(float, p.y << 16), __builtin_bit_cast(float, p.y & 0xffff0000u)};
                        const f32x4 b1 = {__builtin_bit_cast(float, p.z << 16), __builtin_bit_cast(float, p.z & 0xffff0000u), __builtin_bit_cast(float, p.w << 16), __builtin_bit_cast(float, p.w & 0xffff0000u)};
                        const f32x4 o0 = b0 + acc[ai][bj][m][0], o1 = b1 + acc[ai][bj][m][1];
                        q += (o0[0] * o0[0] + o0[1] * o0[1]) + (o0[2] * o0[2] + o0[3] * o0[3]) + (o1[0] * o1[0] + o1[1] * o1[1]) + (o1[2] * o1[2] + o1[3] * o1[3]);
                        *(u32x4*)(xb + off + bj * HALF) = pack8(o0, o1); }
                    q += __shfl_xor(q, 16); q += __shfl_xor(q, 32);
                    if (fq == 0) ss[(size_t)(u.pn * 4 + wc) * SS_M + row] = q; }
        }
    }
};
__device__ __forceinline__ void rows_rstd(float (&rs)[2][4], const float* ss, int row0, int fq) {
    f32x4 p[2][4];
#pragma unroll
    for (int ai = 0; ai < 2; ++ai)
#pragma unroll
        for (int m = 0; m < 4; ++m) { const float* q = ss + (size_t)(fq * 4) * SS_M + (row0 + ai * HALF + m * 16); p[ai][m] = (f32x4){q[0], q[SS_M], q[2 * SS_M], q[3 * SS_M]}; }
    asm volatile("" ::: "memory");
#pragma unroll
    for (int ai = 0; ai < 2; ++ai)
#pragma unroll
        for (int m = 0; m < 4; ++m) { float s = (p[ai][m][0] + p[ai][m][1]) + (p[ai][m][2] + p[ai][m][3]); s += __shfl_xor(s, 16); s += __shfl_xor(s, 32);
            rs[ai][m] = __builtin_amdgcn_rsqf(s * (1.0f / 1024.0f) + RMS_EPS); }
}
struct EpiSwiglu {
    static constexpr bool PERM = true, AFTER_DRAIN = false;
    bf16_t* O; int ldc; const float* ss;
    __device__ __forceinline__ void operator()(const f32x4 (&acc)[2][2][4][2], const Unit& u, int wr, int wc, int fr, int fq) const {
        const int row0 = u.pm * BM + wr * 64 + fr, col0 = u.pn * HALF + wc * 32 + 8 * fq;
        float rs[2][4]; rows_rstd(rs, ss, row0, fq);
#pragma unroll
        for (int ai = 0; ai < 2; ++ai)
#pragma unroll
            for (int m = 0; m < 4; ++m) { const int row = row0 + ai * HALF + m * 16; const float r = rs[ai][m];
                f32x4 a0, a1;
#pragma unroll
                for (int e = 0; e < 4; ++e) { a0[e] = silu_f(acc[ai][0][m][0][e] * r) * (acc[ai][1][m][0][e] * r); a1[e] = silu_f(acc[ai][0][m][1][e] * r) * (acc[ai][1][m][1][e] * r); }
                *(u32x4*)(O + (size_t)row * ldc + col0) = pack8(a0, a1); }
    }
};
struct EpiConvIn {
    static constexpr bool PERM = true, AFTER_DRAIN = false;
    bf16_t* Z; bf16_t* BG; const float* ss;
    __device__ __forceinline__ void operator()(const f32x4 (&acc)[2][2][4][2], const Unit& u, int wr, int wc, int fr, int fq) const {
        const int row0 = u.pm * BM + wr * 64 + fr;
        float rs[2][4]; rows_rstd(rs, ss, row0, fq);
        if (u.pn < 8) {
            const int col0 = u.pn * HALF + wc * 32 + 8 * fq;
#pragma unroll
            for (int ai = 0; ai < 2; ++ai)
#pragma unroll
                for (int m = 0; m < 4; ++m) { const int row = row0 + ai * HALF + m * 16; const float r2 = rs[ai][m] * rs[ai][m];
                    const f32x4 a0 = acc[ai][0][m][0] * acc[ai][1][m][0] * r2, a1 = acc[ai][0][m][1] * acc[ai][1][m][1] * r2;
                    *(u32x4*)(Z + (size_t)row * 1024 + col0) = pack8(a0, a1); }
        } else {
            const int col0 = (u.pn - 8) * BM + wc * 32 + 8 * fq;
#pragma unroll
            for (int ai = 0; ai < 2; ++ai)
#pragma unroll
                for (int m = 0; m < 4; ++m) { const int row = row0 + ai * HALF + m * 16; const float r = rs[ai][m];
#pragma unroll
                    for (int bj = 0; bj < 2; ++bj) *(u32x4*)(BG + (size_t)row * 1024 + col0 + bj * HALF) = pack8(acc[ai][bj][m][0] * r, acc[ai][bj][m][1] * r); }
        }
    }
};

template <class Epi, class Sched, bool ALIGN_EPI = false, bool SP2 = false>
__device__ __forceinline__ void gemm_phase(PG8_LAS unsigned char* lds, const Gemm g, const Sched& S, const Epi& E) {
    const int tid = threadIdx.x, wid = __builtin_amdgcn_readfirstlane(tid >> 6), lane = tid & 63, wr = wid >> 2, wc = wid & 3, fr = lane & 15, fq = lane >> 4;
    const int K = g.K, nt = K / BK;
    unsigned voffA[2], voffB[2];
#pragma unroll
    for (int i = 0; i < 2; ++i) { int R, C; stage_rc(tid * 16 + i * 8192, R, C); const int Rb = Epi::PERM ? ((R & ~31) + perm32(R & 31)) : R;
        voffA[i] = (unsigned)(R * K + C) * 2u; voffB[i] = (unsigned)(Rb * K + C) * 2u; }
    const size_t kstep = (size_t)(BK * 2);
    const size_t hstep = (size_t)HALF * K * 2;
    const size_t tstep = 2 * hstep;
    const unsigned ldsw = (unsigned)wid * 1024u;
    const int aoff = lds_byte(wr * 64 + fr, fq * 8), boff = lds_byte(wc * 32 + fr, fq * 8);
#define PG8_SA(b, h) (((b) * 2 + (h)) * HTB)
#define PG8_SB(b, h) ((4 + (b) * 2 + (h)) * HTB)
#define PG8_STAGE(bufoff, gbase, voff) do { _Pragma("unroll") for (int _i = 0; _i < 2; ++_i) \
        __builtin_amdgcn_global_load_lds((const unsigned*)((const char*)(gbase) + (voff)[_i]), (PG8_LAS unsigned*)(lds + (bufoff) + ldsw + _i * 8192), 16, 0, 0); } while (0)
#define PG8_LDA(dst, b, h) do { _Pragma("unroll") for (int m = 0; m < 4; ++m) _Pragma("unroll") for (int k = 0; k < 2; ++k) dst[m][k] = *(const PG8_LAS bf16x8*)(lds + PG8_SA(b, h) + aoff + m * 2048 + k * 1024); } while (0)
#define PG8_LDB(dst, b, h) do { _Pragma("unroll") for (int n = 0; n < 2; ++n) _Pragma("unroll") for (int k = 0; k < 2; ++k) dst[n][k] = *(const PG8_LAS bf16x8*)(lds + PG8_SB(b, h) + boff + n * 2048 + k * 1024); } while (0)
#define PG8_MMA(ai, bj, At, Bt) do { __builtin_amdgcn_s_setprio(1); _Pragma("unroll") for (int m = 0; m < 4; ++m) _Pragma("unroll") for (int n = 0; n < 2; ++n) _Pragma("unroll") for (int k = 0; k < 2; ++k) \
        acc[ai][bj][m][n] = __builtin_amdgcn_mfma_f32_16x16x32_bf16(Bt[n][k], At[m][k], acc[ai][bj][m][n], 0, 0, 0); __builtin_amdgcn_s_setprio(0); } while (0)
#define PG8_WAIT_V(n) asm volatile("s_waitcnt vmcnt(" #n ")" ::: "memory")
#define PG8_WAIT_L(n) asm volatile("s_waitcnt lgkmcnt(" #n ")" ::: "memory")
#define PG8_BAR __builtin_amdgcn_s_barrier()
#define PG8_SCHED __builtin_amdgcn_sched_barrier(0)
    Unit cur, nxt; int ui = 0;
    if (!S.next(0, cur)) return;
    f32x4 acc[2][2][4][2];
#pragma unroll
    for (int a = 0; a < 2; ++a)
#pragma unroll
        for (int b = 0; b < 2; ++b)
#pragma unroll
            for (int m = 0; m < 4; ++m)
#pragma unroll
                for (int n = 0; n < 2; ++n) acc[a][b][m][n] = (f32x4){0.f, 0.f, 0.f, 0.f};
    bf16x8 At[4][2], B0[2][2], B1[2][2];
    const char* cA = (const char*)g.A + (size_t)cur.pm * tstep; const char* cB = (const char*)g.Bt + (size_t)cur.pn * tstep;
    S.a_ready(cur);
    if constexpr (SP2) {
        PG8_STAGE(PG8_SB(0, 0), cB, voffB); PG8_STAGE(PG8_SB(0, 1), cB + hstep, voffB); PG8_STAGE(PG8_SA(0, 0), cA, voffA); PG8_STAGE(PG8_SA(0, 1), cA + hstep, voffA);
        if (wr == 1) PG8_BAR;
        PG8_WAIT_V(2); PG8_BAR;
        PG8_STAGE(PG8_SB(1, 0), cB + kstep, voffB); PG8_STAGE(PG8_SA(1, 0), cA + kstep, voffA); PG8_STAGE(PG8_SB(1, 1), cB + hstep + kstep, voffB);
        PG8_WAIT_V(6); PG8_BAR;
    } else {
        PG8_STAGE(PG8_SB(0, 0), cB, voffB); PG8_STAGE(PG8_SA(0, 0), cA, voffA); PG8_STAGE(PG8_SB(0, 1), cB + hstep, voffB); PG8_STAGE(PG8_SA(0, 1), cA + hstep, voffA);
        if (wr == 1) PG8_BAR;
        PG8_WAIT_V(4); PG8_BAR;
        PG8_STAGE(PG8_SB(1, 0), cB + kstep, voffB); PG8_STAGE(PG8_SA(1, 0), cA + kstep, voffA); PG8_STAGE(PG8_SB(1, 1), cB + hstep + kstep, voffB);
        PG8_WAIT_V(6); PG8_BAR;
    }
    for (;;) {
        const bool has_next = S.next(ui + 1, nxt);
        const char* nA = has_next ? (const char*)g.A + (size_t)nxt.pm * tstep : cA; const char* nB = has_next ? (const char*)g.Bt + (size_t)nxt.pn * tstep : cB;
        for (int t = 0; t < nt; t += 2) {
            const bool last = (t == nt - 2);
            const char* a1 = cA + (size_t)(t + 1) * kstep;
            const char* a2 = last ? nA : cA + (size_t)(t + 2) * kstep; const char* b2 = last ? nB : cB + (size_t)(t + 2) * kstep;
            const char* a3 = a2 + kstep; const char* b3 = b2 + kstep;
            if (last && has_next) S.a_ready(nxt);
            if constexpr (SP2) {
            PG8_LDB(B0, 0, 0); PG8_LDB(B1, 0, 1); PG8_SCHED; PG8_LDA(At, 0, 0); PG8_STAGE(PG8_SA(1, 1), a1 + hstep, voffA);
            PG8_WAIT_V(8); PG8_WAIT_L(0); PG8_BAR; PG8_MMA(0, 0, At, B0); PG8_MMA(0, 1, At, B1); PG8_BAR; PG8_SCHED;
            PG8_LDA(At, 0, 1); PG8_STAGE(PG8_SB(0, 0), b2, voffB); PG8_STAGE(PG8_SB(0, 1), b2 + hstep, voffB); PG8_STAGE(PG8_SA(0, 0), a2, voffA);
            PG8_WAIT_V(8); PG8_WAIT_L(0); PG8_BAR; PG8_MMA(1, 0, At, B0); PG8_MMA(1, 1, At, B1); PG8_BAR; PG8_SCHED;
            PG8_LDB(B0, 1, 0); PG8_LDB(B1, 1, 1); PG8_SCHED; PG8_LDA(At, 1, 0); PG8_STAGE(PG8_SA(0, 1), a2 + hstep, voffA);
            PG8_WAIT_V(8); PG8_WAIT_L(0); PG8_BAR; PG8_MMA(0, 0, At, B0); PG8_MMA(0, 1, At, B1); PG8_BAR; PG8_SCHED;
            PG8_LDA(At, 1, 1); PG8_STAGE(PG8_SB(1, 0), b3, voffB); PG8_STAGE(PG8_SB(1, 1), b3 + hstep, voffB); PG8_STAGE(PG8_SA(1, 0), a3, voffA);
            PG8_WAIT_V(8); PG8_WAIT_L(0); PG8_BAR; PG8_MMA(1, 0, At, B0); PG8_MMA(1, 1, At, B1); PG8_BAR; PG8_SCHED;
            } else {
            PG8_LDB(B0, 0, 0); PG8_SCHED; PG8_LDA(At, 0, 0); PG8_STAGE(PG8_SA(1, 1), a1 + hstep, voffA);
            PG8_WAIT_L(8); PG8_BAR; PG8_WAIT_L(0); PG8_MMA(0, 0, At, B0); PG8_BAR; PG8_SCHED;
            PG8_LDB(B1, 0, 1); PG8_STAGE(PG8_SB(0, 0), b2, voffB);
            PG8_BAR; PG8_WAIT_L(0); PG8_MMA(0, 1, At, B1); PG8_BAR;
            PG8_LDA(At, 0, 1); PG8_STAGE(PG8_SA(0, 0), a2, voffA);
            PG8_BAR; PG8_WAIT_L(0); PG8_MMA(1, 0, At, B0); PG8_BAR; PG8_SCHED;
            PG8_STAGE(PG8_SB(0, 1), b2 + hstep, voffB);
            PG8_WAIT_V(6); PG8_BAR; PG8_MMA(1, 1, At, B1); PG8_BAR;
            PG8_LDB(B0, 1, 0); PG8_SCHED; PG8_LDA(At, 1, 0); PG8_STAGE(PG8_SA(0, 1), a2 + hstep, voffA);
            PG8_WAIT_L(8); PG8_BAR; PG8_WAIT_L(0); PG8_MMA(0, 0, At, B0); PG8_BAR; PG8_SCHED;
            PG8_LDB(B1, 1, 1); PG8_STAGE(PG8_SB(1, 0), b3, voffB);
            PG8_BAR; PG8_WAIT_L(0); PG8_MMA(0, 1, At, B1); PG8_BAR;
            PG8_LDA(At, 1, 1); PG8_STAGE(PG8_SA(1, 0), a3, voffA);
            PG8_BAR; PG8_WAIT_L(0); PG8_MMA(1, 0, At, B0); PG8_BAR; PG8_SCHED;
            PG8_STAGE(PG8_SB(1, 1), b3 + hstep, voffB);
            PG8_WAIT_V(6); PG8_BAR; PG8_MMA(1, 1, At, B1); PG8_BAR;
            }
        }
        if constexpr (ALIGN_EPI) { if (wr == 0) PG8_BAR; }
        if constexpr (!Epi::AFTER_DRAIN) { E(acc, cur, wr, wc, fr, fq); S.done(cur); }
        if (!has_next) break;
#pragma unroll
        for (int a = 0; a < 2; ++a)
#pragma unroll
            for (int b = 0; b < 2; ++b)
#pragma unroll
                for (int m = 0; m < 4; ++m)
#pragma unroll
                    for (int n = 0; n < 2; ++n) acc[a][b][m][n] = (f32x4){0.f, 0.f, 0.f, 0.f};
        cur = nxt; cA = nA; cB = nB; ++ui;
        if constexpr (ALIGN_EPI) { if (wr == 1) PG8_BAR; }
    }
    PG8_WAIT_V(0);
    if constexpr (!ALIGN_EPI) { if (wr == 0) PG8_BAR; }
    PG8_BAR;
    if constexpr (Epi::AFTER_DRAIN) { E.fused(acc, cur, wr, wc, fr, fq, lds, wid, lane); S.done(cur); }
#undef PG8_SA
#undef PG8_SB
#undef PG8_STAGE
#undef PG8_LDA
#undef PG8_LDB
#undef PG8_MMA
#undef PG8_WAIT_V
#undef PG8_WAIT_L
#undef PG8_BAR
#undef PG8_SCHED
}
}

constexpr int NWAVES = 8;
constexpr int SEQ = 2048, D = 1024, M = 16 * SEQ;
constexpr int EA = 2048, NH = 16, CH = 128;
constexpr int FF = 2816;
constexpr float LN_EPS = 1e-6f;
#ifndef MK_ONE_LAUNCH
#define MK_ONE_LAUNCH 1
#endif
constexpr int N_PHASES = 12;

constexpr size_t MiB = 1u << 20;
constexpr size_t WS_AIN = 2 * MiB, WS_AOUT = 10 * MiB, WS_WS = 14 * MiB, WS_GU0 = 15 * MiB, WS_D0 = 26 * MiB, WS_GU1 = 32 * MiB, WS_D1 = 43 * MiB, WS_BIN = 49 * MiB, WS_BOUT = 55 * MiB;
constexpr size_t WS_SS = 58 * MiB, WS_VST = 60 * MiB;
constexpr size_t WS_XB = 64 * MiB;
constexpr size_t WS_U = 128 * MiB, WS_VT = 256 * MiB;
constexpr size_t WS_A = 128 * MiB;
constexpr size_t WS_YC = 304 * MiB, WS_Z = 384 * MiB, WS_BG = 448 * MiB, WS_END = 512 * MiB;
constexpr size_t WS_Y = 384 * MiB;
static_assert(WS_A + (size_t)M * FF * 2 <= WS_YC && WS_YC + (size_t)M * D * 2 <= WS_Z && WS_BG + (size_t)M * D * 2 <= WS_END, "d_ws map");
static_assert(WS_GU0 + (size_t)2 * FF * D * 2 <= WS_D0 && WS_D0 + (size_t)FF * D * 2 <= WS_GU1 && WS_D1 + (size_t)FF * D * 2 <= WS_BIN, "weight map");

constexpr int RING_BYTES = 131072, LDSCTL_OFF = 143360, MISC_OFF = LDSCTL_OFF + 320, LDS_BYTES = 147456;
constexpr size_t WS_CTL = 0, CTL_ZERO_BYTES = 65536;
constexpr int CW_BAR = 4096;

#define GAS __attribute__((address_space(1)))
#define LAS __attribute__((address_space(3)))
typedef unsigned short bf16;
typedef unsigned v4u __attribute__((ext_vector_type(4)));
typedef unsigned v2u __attribute__((ext_vector_type(2)));
typedef float f32x4 __attribute__((ext_vector_type(4)));
typedef float f32x2 __attribute__((ext_vector_type(2)));
typedef short bf16x8 __attribute__((ext_vector_type(8)));
#define LDS_WAIT() asm volatile("s_waitcnt lgkmcnt(0)" ::: "memory")
__device__ __forceinline__ unsigned f2bf(float f) { unsigned u = __builtin_bit_cast(unsigned, f); return (u + 0x7fffu + ((u >> 16) & 1u)) >> 16; }
__device__ __forceinline__ unsigned pk2(float lo, float hi) { return f2bf(lo) | (f2bf(hi) << 16); }
__device__ __forceinline__ float bflo(unsigned w) { return __builtin_bit_cast(float, w << 16); }
__device__ __forceinline__ float bfhi(unsigned w) { return __builtin_bit_cast(float, w & 0xffff0000u); }

typedef GAS unsigned gu32;
#define RLX_AGENT __ATOMIC_RELAXED, __HIP_MEMORY_SCOPE_AGENT
#define XB_TMO      128
#define XB_XCNT(j)  (256  + 64 * (j))
#define XB_XSUB(j)  (1280 + 64 * (j))
#define XB_XGEN(j)  (2304 + 64 * (j))
#define XB_TOP      3328
#define XB_TOPGEN   3392
#define XCD_BAR_WORDS 3456
#define XB_SPIN_CAP (1u << 18)

__device__ __forceinline__ unsigned xb_ld(unsigned* p)              { return __hip_atomic_load(p, __ATOMIC_RELAXED, __HIP_MEMORY_SCOPE_AGENT); }
__device__ __forceinline__ unsigned xb_add(unsigned* p, unsigned v) { return __hip_atomic_fetch_add(p, v, __ATOMIC_RELAXED, __HIP_MEMORY_SCOPE_AGENT); }
__device__ __forceinline__ unsigned xb_xcc_id() { return (unsigned)__builtin_amdgcn_s_getreg((3 << 11) | 20) & 0xFu; }
#define XB_SPIN(cond, bar) do { unsigned _sp = 0; while (cond) { __builtin_amdgcn_s_sleep(1); \
    if ((++_sp & 255u) == 0u) { if (xb_ld(&(bar)[XB_TMO])) break; if (_sp > XB_SPIN_CAP) { atomicAdd(&(bar)[XB_TMO], 1u); break; } } } } while (0)

struct XcdBarrier {
    unsigned* bar; unsigned x;
    volatile LAS unsigned* st;
};

__device__ __forceinline__ XcdBarrier xcd_barrier_post(unsigned* bar, volatile LAS unsigned* st) {
    XcdBarrier b; b.bar = bar; b.x = xb_xcc_id(); b.st = st;
    if (threadIdx.x == 0) (void)xb_add(&bar[XB_XCNT(b.x)], 1u);
    return b;
}
__device__ __forceinline__ void xcd_barrier_complete(unsigned* bar, unsigned x, unsigned& nloc, unsigned& nx) {
    const unsigned G = gridDim.x * gridDim.y * gridDim.z;
    unsigned sum, cnt, mine, sp = 0u;
    for (;;) {
        sum = 0u; cnt = 0u; mine = 0u;
#pragma unroll
        for (unsigned j = 0; j < 16; ++j) { const unsigned c = xb_ld(&bar[XB_XCNT(j)]); sum += c; cnt += (c > 0u) ? 1u : 0u; mine = (j == x) ? c : mine; }
        if (sum == G) break;
        __builtin_amdgcn_s_sleep(1);
        if ((++sp & 255u) == 0u) { if (xb_ld(&bar[XB_TMO])) break; if (sp > XB_SPIN_CAP) { atomicAdd(&bar[XB_TMO], 1u); break; } }
    }
    nloc = mine > 0u ? mine : 1u; nx = cnt > 0u ? cnt : 1u;
}

__device__ __forceinline__ void xcd_barrier(const XcdBarrier& b) {
    asm volatile("s_waitcnt vmcnt(0)" ::: "memory");
    __syncthreads();
    if (threadIdx.x == 0) {
        unsigned* bar = b.bar;
        __builtin_amdgcn_s_waitcnt(0);
        unsigned nloc = b.st[0], nx = b.st[1];
        if (nloc == 0u) { xcd_barrier_complete(bar, b.x, nloc, nx); b.st[0] = nloc; b.st[1] = nx; }
        const unsigned old = xb_add(&bar[XB_XSUB(b.x)], 1u);
        const unsigned gen = old / nloc;
        if (old + 1u == (gen + 1u) * nloc) {
            __builtin_amdgcn_fence(__ATOMIC_RELEASE, "agent");
            asm volatile("s_waitcnt vmcnt(0)" ::: "memory");
            const unsigned og = xb_add(&bar[XB_TOP], 1u);
            const unsigned tg = og / nx;
            if (og + 1u == (tg + 1u) * nx) xb_add(&bar[XB_TOPGEN], 1u);
            else XB_SPIN(xb_ld(&bar[XB_TOPGEN]) == tg, bar);
            __builtin_amdgcn_fence(__ATOMIC_ACQUIRE, "agent");
            xb_add(&bar[XB_XGEN(b.x)], 1u);
            asm volatile("s_waitcnt vmcnt(0)" ::: "memory");
        } else {
            XB_SPIN(xb_ld(&bar[XB_XGEN(b.x)]) == gen, bar);
            __builtin_amdgcn_fence(__ATOMIC_ACQUIRE, "agent");
            asm volatile("s_waitcnt vmcnt(0)" ::: "memory");
        }
    }
    __syncthreads();
}

struct Frame {
    LAS unsigned char* lds;
    int tid, lane, wave, vcu, G;
    const float *x, *mix_norm, *ffn_norm, *a_w_in, *a_v_gain, *a_v_bias, *a_w_s, *a_b_s, *a_w_out, *b_w_in, *b_conv_w, *b_w_out, *w_gate, *w_up, *w_down, *final_norm;
    float* out; unsigned char* ws;
};

__device__ __forceinline__ float wave_sum(float v) {
#pragma unroll
    for (int o = 1; o < 64; o <<= 1) v += __shfl_xor(v, o);
    return v;
}
template <int MODE> __device__ __forceinline__ void p0_transpose_item(const float* W, int K, int N, bf16* WT, int row_off, const float* gain, LAS float* scr, int item, int lane) {
    const int nblk = N / 32, kb = item / nblk, nb = item % nblk, k0 = 64 * kb, n0 = 32 * nb;
#pragma unroll 8
    for (int i = 0; i < 32; ++i) { const int kk = 2 * i + (lane >> 5); float w = W[(size_t)(k0 + kk) * N + n0 + (lane & 31)]; if (gain) w *= gain[k0 + kk]; scr[kk * 33 + (lane & 31)] = w; }
    LDS_WAIT(); asm volatile("" ::: "memory");
    const int c = lane & 7;
    const int rbase = (MODE == 0) ? (row_off + n0) : (row_off + 256 * (n0 / 128) + (n0 % 128));
#pragma unroll
    for (int j = 0; j < 4; ++j) { const int n = (lane >> 3) + 8 * j; const LAS float* s = scr + (8 * c) * 33 + n;
        v4u o; o.x = pk2(s[0 * 33], s[1 * 33]); o.y = pk2(s[2 * 33], s[3 * 33]); o.z = pk2(s[4 * 33], s[5 * 33]); o.w = pk2(s[6 * 33], s[7 * 33]);
        *(GAS v4u*)(WT + (size_t)(rbase + n) * K + k0 + 8 * c) = o; }
    LDS_WAIT(); asm volatile("" ::: "memory");
}
__device__ __forceinline__ void p0_prologue(Frame& F) {
    LAS float* scr = (LAS float*)(F.lds + F.wave * 16384);
    const int gw = F.vcu * NWAVES + F.wave, NGW = F.G * NWAVES;
    unsigned char* ws = F.ws;
    constexpr int I_AIN = (D / 64) * (2 * EA / 32), I_AOUT = (EA / 64) * (D / 32), I_G = (D / 64) * (FF / 32), I_DN = (FF / 64) * (D / 32), I_BIN = (D / 64) * (D / 32), I_BOUT = (D / 64) * (D / 32);
    constexpr int NITEMS = I_AIN + I_AOUT + 4 * I_G + 2 * I_DN + 3 * I_BIN + I_BOUT;
    for (int it = gw; it < NITEMS; it += NGW) {
        int r = it;
        if (r < I_AIN) { p0_transpose_item<0>(F.a_w_in, D, 2 * EA, (bf16*)(ws + WS_AIN), 0, F.mix_norm, scr, r, F.lane); continue; } r -= I_AIN;
        if (r < I_AOUT) { p0_transpose_item<0>(F.a_w_out, EA, D, (bf16*)(ws + WS_AOUT), 0, nullptr, scr, r, F.lane); continue; } r -= I_AOUT;
        if (r < I_G) { p0_transpose_item<1>(F.w_gate, D, FF, (bf16*)(ws + WS_GU0), 0, F.ffn_norm, scr, r, F.lane); continue; } r -= I_G;
        if (r < I_G) { p0_transpose_item<1>(F.w_up, D, FF, (bf16*)(ws + WS_GU0), 128, F.ffn_norm, scr, r, F.lane); continue; } r -= I_G;
        if (r < I_G) { p0_transpose_item<1>(F.w_gate + (size_t)D * FF, D, FF, (bf16*)(ws + WS_GU1), 0, F.ffn_norm + D, scr, r, F.lane); continue; } r -= I_G;
        if (r < I_G) { p0_transpose_item<1>(F.w_up + (size_t)D * FF, D, FF, (bf16*)(ws + WS_GU1), 128, F.ffn_norm + D, scr, r, F.lane); continue; } r -= I_G;
        if (r < I_DN) { p0_transpose_item<0>(F.w_down, FF, D, (bf16*)(ws + WS_D0), 0, nullptr, scr, r, F.lane); continue; } r -= I_DN;
        if (r < I_DN) { p0_transpose_item<0>(F.w_down + (size_t)FF * D, FF, D, (bf16*)(ws + WS_D1), 0, nullptr, scr, r, F.lane); continue; } r -= I_DN;
        if (r < 3 * I_BIN) {
            const int nblk = 3 * D / 32, nb = r % nblk, n0 = 32 * nb, part = n0 / D;
            const int kb = r / nblk, k0 = 64 * kb; const float* W = F.b_w_in; bf16* WT = (bf16*)(ws + WS_BIN); const float* gain = F.mix_norm + D;
#pragma unroll 8
            for (int i = 0; i < 32; ++i) { const int kk = 2 * i + (F.lane >> 5); scr[kk * 33 + (F.lane & 31)] = W[(size_t)(k0 + kk) * (3 * D) + n0 + (F.lane & 31)] * gain[k0 + kk]; }
            LDS_WAIT(); asm volatile("" ::: "memory");
            const int e0 = n0 - part * D;
            const int rbase = (part == 0) ? (2048 + e0) : (256 * (e0 / 128) + (e0 % 128) + (part == 2 ? 128 : 0));
            const int c = F.lane & 7;
#pragma unroll
            for (int j = 0; j < 4; ++j) { const int n = (F.lane >> 3) + 8 * j; const LAS float* s = scr + (8 * c) * 33 + n;
                v4u o; o.x = pk2(s[0 * 33], s[1 * 33]); o.y = pk2(s[2 * 33], s[3 * 33]); o.z = pk2(s[4 * 33], s[5 * 33]); o.w = pk2(s[6 * 33], s[7 * 33]);
                *(GAS v4u*)(WT + (size_t)(rbase + n) * D + k0 + 8 * c) = o; }
            LDS_WAIT(); asm volatile("" ::: "memory");
            continue; } r -= 3 * I_BIN;
        p0_transpose_item<0>(F.b_w_out, D, D, (bf16*)(ws + WS_BOUT), 0, nullptr, scr, r, F.lane);
    }
    { const int gt = (F.vcu * NWAVES + F.wave) * 64 + F.lane, NGT = NGW * 64; bf16* o = (bf16*)(ws + WS_WS);
      for (int i = gt; i < NH * CH * CH / 2; i += NGT) { const int e = 2 * i, t = (e / CH) % CH, s = e % CH; const float a = F.a_w_s[e], b = F.a_w_s[e + 1];
          ((GAS unsigned*)o)[i] = pk2(s <= t ? a : 0.f, (s + 1) <= t ? b : 0.f); } }
    for (int m = gw; m < M; m += NGW) {
        const GAS f32x4* xr = (const GAS f32x4*)(F.x + (size_t)m * D) + F.lane;
        f32x4 v[4]; float s = 0.f;
#pragma unroll
        for (int j = 0; j < 4; ++j) { v[j] = xr[64 * j]; s += (v[j].x * v[j].x + v[j].y * v[j].y) + (v[j].z * v[j].z + v[j].w * v[j].w); }
        const float rstd = 1.f / sqrtf(wave_sum(s) * (1.f / D) + pg8::RMS_EPS);
        GAS unsigned long long* o8 = (GAS unsigned long long*)((bf16*)(ws + WS_XB) + (size_t)m * D) + F.lane;
#pragma unroll
        for (int j = 0; j < 4; ++j) o8[64 * j] = (unsigned long long)pk2(v[j].x * rstd, v[j].y * rstd) | ((unsigned long long)pk2(v[j].z * rstd, v[j].w * rstd) << 32);
    }
}

constexpr int SG_PITCH = 272;
constexpr int SG_W = 0, SG_V = 128 * SG_PITCH, SG_ST = 2 * 128 * SG_PITCH;
__device__ __forceinline__ void sgu_phase(Frame& F) {
    LAS unsigned char* lds = F.lds;
    const int tid = F.tid, lane = F.lane, w = F.wave, fr = lane & 15, fq = lane >> 4;
    const bf16* U = (const bf16*)(F.ws + WS_U); bf16* Y = (bf16*)(F.ws + WS_Y); const bf16* VT = (const bf16*)(F.ws + WS_VT); const bf16* WSB = (const bf16*)(F.ws + WS_WS);
    const f32x2* vst = (const f32x2*)(F.ws + WS_VST);
    const int cs = tid & 15, r0 = tid >> 4;
    const int t = 16 * w + fr;
    for (int chunk = F.vcu; chunk < M / CH; chunk += F.G) {
        const int t0 = chunk * CH;
        __syncthreads();
        if (tid < CH) { float s = 0.f, q = 0.f;
#pragma unroll
            for (int i = 0; i < 16; ++i) { const f32x2 a = vst[(size_t)i * M + t0 + tid]; s += a.x; q += a.y; }
            const float mean = s * (1.f / EA); const float var = q * (1.f / EA) - mean * mean; const float rstd = 1.f / sqrtf(var + LN_EPS);
            ((LAS f32x2*)(lds + SG_ST))[tid] = (f32x2){rstd, -mean * rstd}; }
#define SG_BAR() do { asm volatile("s_waitcnt lgkmcnt(0)" ::: "memory"); __builtin_amdgcn_s_barrier(); asm volatile("" ::: "memory"); } while (0)
        v4u wreg[4], vreg[4], ureg[4]; float gn[4], bi[4];
#define SG_LOAD(h_) do { const int hh = (h_); \
            _Pragma("unroll") for (int i = 0; i < 4; ++i) { const int r = r0 + 32 * i; const int c = hh * CH + r; \
                wreg[i] = *(const GAS v4u*)(WSB + (size_t)hh * CH * CH + r * CH + cs * 8); \
                vreg[i] = *(const GAS v4u*)(VT + ((size_t)chunk * EA + c) * CH + cs * 8); gn[i] = F.a_v_gain[c]; bi[i] = F.a_v_bias[c]; } \
            _Pragma("unroll") for (int g = 0; g < 4; ++g) ureg[g] = *(const GAS v4u*)(U + (size_t)(t0 + t) * EA + hh * CH + 8 * fq + 32 * g); } while (0)
        SG_LOAD(0);
        __syncthreads();
        f32x2 st[8];
#pragma unroll
        for (int k = 0; k < 8; ++k) st[k] = ((const LAS f32x2*)(lds + SG_ST))[cs * 8 + k];
        for (int h = 0; h < NH; ++h) {
            if (h) SG_BAR();
#pragma unroll
            for (int i = 0; i < 4; ++i) { const int r = r0 + 32 * i;
                *(LAS v4u*)(lds + SG_W + r * SG_PITCH + cs * 16) = wreg[i];
                const float g = gn[i], b = bi[i]; const unsigned wd[4] = {vreg[i].x, vreg[i].y, vreg[i].z, vreg[i].w}; float o[8];
#pragma unroll
                for (int k = 0; k < 4; ++k) { o[2 * k] = (bflo(wd[k]) * st[2 * k].x + st[2 * k].y) * g + b; o[2 * k + 1] = (bfhi(wd[k]) * st[2 * k + 1].x + st[2 * k + 1].y) * g + b; }
                v4u ov; ov.x = pk2(o[0], o[1]); ov.y = pk2(o[2], o[3]); ov.z = pk2(o[4], o[5]); ov.w = pk2(o[6], o[7]);
                *(LAS v4u*)(lds + SG_V + r * SG_PITCH + cs * 16) = ov; }
            v4u ucur[4];
#pragma unroll
            for (int g = 0; g < 4; ++g) ucur[g] = ureg[g];
            __syncthreads();
            if (h + 1 < NH) SG_LOAD(h + 1);
            f32x4 acc[4][2];
#pragma unroll
            for (int g = 0; g < 4; ++g) { acc[g][0] = (f32x4){0.f, 0.f, 0.f, 0.f}; acc[g][1] = (f32x4){0.f, 0.f, 0.f, 0.f}; }
            const int kmax = (16 * w + 15) / 32;
            for (int kk = 0; kk <= kmax; ++kk) {
                const bf16x8 a = *(const LAS bf16x8*)(lds + SG_W + t * SG_PITCH + kk * 64 + fq * 16);
#pragma unroll
                for (int g = 0; g < 4; ++g)
#pragma unroll
                    for (int n = 0; n < 2; ++n) { const int crow = 32 * g + 8 * (fr >> 2) + 4 * n + (fr & 3);
                        const bf16x8 b = *(const LAS bf16x8*)(lds + SG_V + crow * SG_PITCH + kk * 64 + fq * 16);
                        acc[g][n] = __builtin_amdgcn_mfma_f32_16x16x32_bf16(b, a, acc[g][n], 0, 0, 0); }
            }
            const float bs = F.a_b_s[h * CH + t];
            bf16* yp = Y + (size_t)(t0 + t) * EA + h * CH + 8 * fq;
#pragma unroll
            for (int g = 0; g < 4; ++g) { const v4u uv = ucur[g];
                v4u ov; ov.x = pk2(bflo(uv.x) * (acc[g][0][0] + bs), bfhi(uv.x) * (acc[g][0][1] + bs)); ov.y = pk2(bflo(uv.y) * (acc[g][0][2] + bs), bfhi(uv.y) * (acc[g][0][3] + bs));
                ov.z = pk2(bflo(uv.z) * (acc[g][1][0] + bs), bfhi(uv.z) * (acc[g][1][1] + bs)); ov.w = pk2(bflo(uv.w) * (acc[g][1][2] + bs), bfhi(uv.w) * (acc[g][1][3] + bs));
                *(GAS v4u*)(yp + 32 * g) = ov; }
        }
#undef SG_LOAD
#undef SG_BAR
    }
}

__device__ __forceinline__ void conv_phase(Frame& F) {
    const bf16* Z = (const bf16*)(F.ws + WS_Z); const bf16* BG = (const bf16*)(F.ws + WS_BG); bf16* YC = (bf16*)(F.ws + WS_YC);
    const int gt = F.vcu * 512 + F.tid, NGT = F.G * 512;
    for (int i = gt; i < M * (D / 8); i += NGT) {
        const int row = i >> 7, c8 = (i & 127) * 8, tpos = row & (SEQ - 1);
        const size_t off = (size_t)row * D + c8;
        const v4u z2 = *(const GAS v4u*)(Z + off), bg = *(const GAS v4u*)(BG + off);
        v4u z1 = (v4u){0u, 0u, 0u, 0u}, z0 = (v4u){0u, 0u, 0u, 0u};
        if (tpos >= 1) z1 = *(const GAS v4u*)(Z + off - D);
        if (tpos >= 2) z0 = *(const GAS v4u*)(Z + off - 2 * D);
        const f32x4 w0a = *(const GAS f32x4*)(F.b_conv_w + c8), w0b = *(const GAS f32x4*)(F.b_conv_w + c8 + 4);
        const f32x4 w1a = *(const GAS f32x4*)(F.b_conv_w + D + c8), w1b = *(const GAS f32x4*)(F.b_conv_w + D + c8 + 4);
        const f32x4 w2a = *(const GAS f32x4*)(F.b_conv_w + 2 * D + c8), w2b = *(const GAS f32x4*)(F.b_conv_w + 2 * D + c8 + 4);
        const unsigned a0[4] = {z0.x, z0.y, z0.z, z0.w}, a1[4] = {z1.x, z1.y, z1.z, z1.w}, a2[4] = {z2.x, z2.y, z2.z, z2.w}, ab[4] = {bg.x, bg.y, bg.z, bg.w};
        const float w0[8] = {w0a[0], w0a[1], w0a[2], w0a[3], w0b[0], w0b[1], w0b[2], w0b[3]}, w1[8] = {w1a[0], w1a[1], w1a[2], w1a[3], w1b[0], w1b[1], w1b[2], w1b[3]}, w2[8] = {w2a[0], w2a[1], w2a[2], w2a[3], w2b[0], w2b[1], w2b[2], w2b[3]};
        unsigned o[4];
#pragma unroll
        for (int k = 0; k < 4; ++k) {
            const float lo = bflo(ab[k]) * (bflo(a0[k]) * w0[2 * k] + bflo(a1[k]) * w1[2 * k] + bflo(a2[k]) * w2[2 * k]);
            const float hi = bfhi(ab[k]) * (bfhi(a0[k]) * w0[2 * k + 1] + bfhi(a1[k]) * w1[2 * k + 1] + bfhi(a2[k]) * w2[2 * k + 1]);
            o[k] = pk2(lo, hi); }
        *(GAS v4u*)(YC + off) = (v4u){o[0], o[1], o[2], o[3]};
    }
}
__device__ __forceinline__ void final_norm_phase(Frame& F) {
    const int gw = F.vcu * NWAVES + F.wave, NGW = F.G * NWAVES; const float* ss = (const float*)(F.ws + WS_SS); const bf16* XBp = (const bf16*)(F.ws + WS_XB);
    const GAS f32x4* gr = (const GAS f32x4*)F.final_norm + 2 * F.lane;
    for (int m = gw; m < M; m += NGW) {
        float s = (F.lane < 16) ? ss[(size_t)F.lane * M + m] : 0.f;
        s = wave_sum(s);
        const float rstd = 1.f / sqrtf(s * (1.f / D) + pg8::RMS_EPS);
        const GAS v4u* xr = (const GAS v4u*)(XBp + (size_t)m * D) + F.lane; GAS f32x4* orow = (GAS f32x4*)(F.out + (size_t)m * D) + 2 * F.lane;
#pragma unroll
        for (int j = 0; j < 2; ++j) { const v4u v = xr[64 * j]; const f32x4 g0 = gr[128 * j], g1 = gr[128 * j + 1];
            orow[128 * j] = (f32x4){bflo(v.x), bfhi(v.x), bflo(v.y), bfhi(v.y)} * rstd * g0;
            orow[128 * j + 1] = (f32x4){bflo(v.z), bfhi(v.z), bflo(v.w), bfhi(v.w)} * rstd * g1; }
    }
}

struct Args { const float* in[16]; float* out; unsigned char* ws; int ph_lo, ph_hi, rep_mask, pad; };
__global__ void __launch_bounds__(NWAVES * 64, 2) hybrid_fwd(Args args) {
    extern __shared__ __attribute__((aligned(16))) unsigned char lds[];
    cg::grid_group grid = cg::this_grid();
    Frame F;
    F.lds = (LAS unsigned char*)lds;
    F.tid = threadIdx.x; F.lane = F.tid & 63; F.wave = __builtin_amdgcn_readfirstlane(F.tid >> 6);
    F.G = gridDim.x; { const int bx = blockIdx.x; F.vcu = (F.G % 8 == 0) ? (bx % 8) * (F.G / 8) + bx / 8 : bx; }
    F.x = args.in[0]; F.mix_norm = args.in[1]; F.ffn_norm = args.in[2]; F.a_w_in = args.in[3]; F.a_v_gain = args.in[4]; F.a_v_bias = args.in[5]; F.a_w_s = args.in[6]; F.a_b_s = args.in[7];
    F.a_w_out = args.in[8]; F.b_w_in = args.in[9]; F.b_conv_w = args.in[10]; F.b_w_out = args.in[11]; F.w_gate = args.in[12]; F.w_up = args.in[13]; F.w_down = args.in[14]; F.final_norm = args.in[15];
    F.out = args.out; F.ws = args.ws;
    unsigned char* ws = args.ws;
    for (int u = F.tid; u < (LDS_BYTES - LDSCTL_OFF) / 4; u += NWAVES * 64) ((LAS unsigned*)(F.lds + LDSCTL_OFF))[u] = 0u;
    __syncthreads();
    XcdBarrier bar = xcd_barrier_post((unsigned*)(ws + WS_CTL) + CW_BAR, (volatile LAS unsigned*)(F.lds + MISC_OFF) + 8);
    const int lo = args.ph_lo, hi = args.ph_hi;
    if (lo < 0) grid.sync();
#ifndef REP_MASK
#define REP_MASK 0
#endif
#ifndef EXTRA_SYNCS
#define EXTRA_SYNCS 0
#endif
#define REPS(k) 1
#define IN(k) (lo <= (k) && (k) < hi)
#ifndef PROBE_T
#define PROBE_T 0
#endif
#if PROBE_T
#define STAMP(i) do { if (blockIdx.x == 0 && F.tid == 0) ((volatile LAS unsigned long long*)(F.lds + MISC_OFF + 128))[(i)] = __builtin_amdgcn_s_memrealtime(); } while (0)
#else
#define STAMP(i) do { } while (0)
#endif
#define SEAM(k) do { if (IN(k) && IN((k) + 1)) xcd_barrier(bar); STAMP((k) + 1); } while (0)
    pg8::bf16_t* XB = (pg8::bf16_t*)(ws + WS_XB); float* SS = (float*)(ws + WS_SS);
    const int c = (int)blockIdx.x;

    STAMP(0);
    if (IN(0)) { p0_prologue(F); __syncthreads(); } SEAM(0);

    if (IN(1)) {
        { pg8::Gemm g{XB, (const pg8::bf16_t*)(ws + WS_AIN), M, EA, D}; pg8::StaticOrder S; S.init(M, EA, F.G, c);
          pg8::EpiGelu E{(pg8::bf16_t*)(ws + WS_U), EA};
          pg8::gemm_phase<pg8::EpiGelu, pg8::StaticOrder, true, true>(F.lds, g, S, E); }
        { pg8::Gemm g{(const pg8::bf16_t*)(ws + WS_AIN) + (size_t)EA * D, XB, EA, M, D}; pg8::StaticOrder S; S.init(EA, M, F.G, c);
          pg8::EpiGeluT E{(pg8::bf16_t*)(ws + WS_VT), (pg8::f32x2*)(ws + WS_VST)};
          pg8::gemm_phase<pg8::EpiGeluT, pg8::StaticOrder, true, true>(F.lds, g, S, E); }
    } SEAM(1);

    if (IN(2)) { sgu_phase(F); } SEAM(2);

    if (IN(3)) {
        pg8::Gemm g{(const pg8::bf16_t*)(ws + WS_Y), (const pg8::bf16_t*)(ws + WS_AOUT), M, D, EA}; pg8::StaticOrder S; S.init(M, D, F.G, c);
        pg8::EpiRes<true> E{F.x, XB, SS};
        pg8::gemm_phase<pg8::EpiRes<true>, pg8::StaticOrder, true, true>(F.lds, g, S, E);
    } SEAM(3);

    if (IN(4)) {
        pg8::Gemm g{XB, (const pg8::bf16_t*)(ws + WS_GU0), M, 2 * FF, D}; pg8::StaticOrder S; S.init(M, 2 * FF, F.G, c);
        pg8::EpiSwiglu E{(pg8::bf16_t*)(ws + WS_A), FF, SS};
        pg8::gemm_phase<pg8::EpiSwiglu, pg8::StaticOrder, true, true>(F.lds, g, S, E);
    } SEAM(4);

    if (IN(5)) {
        pg8::Gemm g{(const pg8::bf16_t*)(ws + WS_A), (const pg8::bf16_t*)(ws + WS_D0), M, D, FF}; pg8::StaticOrder S; S.init(M, D, F.G, c);
        pg8::EpiRes<false> E{nullptr, XB, SS};
        pg8::gemm_phase<pg8::EpiRes<false>, pg8::StaticOrder, true, true>(F.lds, g, S, E);
    } SEAM(5);

    if (IN(6)) {
        pg8::Gemm g{XB, (const pg8::bf16_t*)(ws + WS_BIN), M, 3 * D, D}; pg8::StaticOrder S; S.init(M, 3 * D, F.G, c);
        pg8::EpiConvIn E{(pg8::bf16_t*)(ws + WS_Z), (pg8::bf16_t*)(ws + WS_BG), SS};
        pg8::gemm_phase<pg8::EpiConvIn, pg8::StaticOrder, true, true>(F.lds, g, S, E);
    } SEAM(6);

    if (IN(7)) { conv_phase(F); } SEAM(7);

    if (IN(8)) {
        pg8::Gemm g{(const pg8::bf16_t*)(ws + WS_YC), (const pg8::bf16_t*)(ws + WS_BOUT), M, D, D}; pg8::StaticOrder S; S.init(M, D, F.G, c);
        pg8::EpiRes<false> E{nullptr, XB, SS};
        pg8::gemm_phase<pg8::EpiRes<false>, pg8::StaticOrder, true, true>(F.lds, g, S, E);
    } SEAM(8);

    if (IN(9)) {
        pg8::Gemm g{XB, (const pg8::bf16_t*)(ws + WS_GU1), M, 2 * FF, D}; pg8::StaticOrder S; S.init(M, 2 * FF, F.G, c);
        pg8::EpiSwiglu E{(pg8::bf16_t*)(ws + WS_A), FF, SS};
        pg8::gemm_phase<pg8::EpiSwiglu, pg8::StaticOrder, true, true>(F.lds, g, S, E);
    } SEAM(9);

    if (IN(10)) {
        pg8::Gemm g{(const pg8::bf16_t*)(ws + WS_A), (const pg8::bf16_t*)(ws + WS_D1), M, D, FF}; pg8::StaticOrder S; S.init(M, D, F.G, c);
        pg8::EpiRes<false> E{nullptr, XB, SS};
        pg8::gemm_phase<pg8::EpiRes<false>, pg8::StaticOrder, true, true>(F.lds, g, S, E);
    } SEAM(10);

    for (int i = 0; i < EXTRA_SYNCS; ++i) xcd_barrier(bar);
    if (IN(11)) { final_norm_phase(F); }
#if PROBE_T
    xcd_barrier(bar); STAMP(12);
    if (blockIdx.x == 0) {
        __syncthreads();
        volatile LAS unsigned long long* stp = (volatile LAS unsigned long long*)(F.lds + MISC_OFF + 128);
        const unsigned long long T = stp[PROBE_HI] - stp[PROBE_LO]; int K = (int)(T / 20ull); if (K > 4096) K = 4096;
        for (int j = F.tid; j < K; j += NWAVES * 64) F.out[(size_t)j * 8191] += 0.0625f;
    }
#endif
#undef IN
#undef SEAM
}

extern "C" void kernel_launch(void* const* d_in, const int* in_sizes, int n_in, void* d_out, int out_size, void* d_ws, size_t ws_size, hipStream_t stream) {
    static int grid = 0;
    if (grid == 0) {
        if (n_in != 16 || in_sizes[0] != M * D || out_size != M * D || ws_size < WS_END) { fprintf(stderr, "kernel_launch: unexpected shapes (n_in %d, in0 %d, out %d, ws %zu); nothing launched\n", n_in, n_in > 0 ? in_sizes[0] : -1, out_size, ws_size); grid = -1; return; }
        int dev = 0, cus = 0, per_cu = 0;
        if (hipGetDevice(&dev) != hipSuccess || hipDeviceGetAttribute(&cus, hipDeviceAttributeMultiprocessorCount, dev) != hipSuccess) { grid = -1; return; }
        if (hipFuncSetAttribute((const void*)hybrid_fwd, hipFuncAttributeMaxDynamicSharedMemorySize, LDS_BYTES) != hipSuccess) { fprintf(stderr, "kernel_launch: hipFuncSetAttribute failed\n"); grid = -1; return; }
        if (hipOccupancyMaxActiveBlocksPerMultiprocessor(&per_cu, (const void*)hybrid_fwd, NWAVES * 64, LDS_BYTES) != hipSuccess || per_cu < 1) { fprintf(stderr, "kernel_launch: occupancy query says %d blocks per CU\n", per_cu); per_cu = 1; }
        (void)hipGetLastError();
        grid = cus;
    }
    if (grid < 0) return;
    if (hipMemsetAsync((char*)d_ws + WS_CTL, 0, CTL_ZERO_BYTES, stream) != hipSuccess) { fprintf(stderr, "kernel_launch: memset failed\n"); return; }
    Args a{};
    for (int i = 0; i < 16; ++i) a.in[i] = (const float*)d_in[i];
    a.out = (float*)d_out; a.ws = (unsigned char*)d_ws; a.rep_mask = REP_MASK;
#if MK_ONE_LAUNCH
    a.ph_lo = 0; a.ph_hi = N_PHASES;
    void* kargs[] = {&a};
    const hipError_t e = hipLaunchCooperativeKernel((const void*)hybrid_fwd, dim3(grid), dim3(NWAVES * 64), kargs, LDS_BYTES, stream);
    if (e != hipSuccess) fprintf(stderr, "kernel_launch: cooperative launch failed: %s (grid %d)\n", hipGetErrorString(e), grid);
#else
    for (int p = 0; p < N_PHASES; ++p) { a.ph_lo = p; a.ph_hi = p + 1; hipLaunchKernelGGL(hybrid_fwd, dim3(grid), dim3(NWAVES * 64), LDS_BYTES, stream, a); }
#endif
}
```

```cpp
#include <hip/hip_runtime.h>
#include <hip/hip_cooperative_groups.h>
#include <cstdio>
#include <cstdint>
namespace cg = cooperative_groups;

namespace pg8 {
#define PG8_LAS __attribute__((address_space(3)))
typedef unsigned short bf16_t;
typedef short bf16x8 __attribute__((ext_vector_type(8)));
typedef float f32x4 __attribute__((ext_vector_type(4)));
typedef unsigned u32x4 __attribute__((ext_vector_type(4)));
constexpr int BM = 256, BK = 64, HALF = 128, HTB = HALF * BK * 2  , STAGE_BYTES = 8 * HTB, NXCD = 8, WGM = 8;

__host__ __device__ __forceinline__ int lds_byte(int r, int c) { const int st = (r >> 4) * 2 + (c >> 5), rr = r & 15, cc = c & 31, ob = rr * 64 + cc * 2; return st * 1024 + (ob ^ (((ob >> 9) & 1) << 5)); }
__host__ __device__ __forceinline__ void stage_rc(int b, int& R, int& C) { const int st = b / 1024, sb = b % 1024, swz = sb ^ (((sb >> 9) & 1) << 5); R = (st >> 1) * 16 + swz / 64; C = (st & 1) * 32 + (swz % 64) / 2; }
__host__ __device__ __forceinline__ int perm32(int rho) { const int n = rho >> 4, i = rho & 15; return 8 * (i >> 2) + 4 * n + (i & 3); }

struct Unit { int pm, pn; };
struct Gemm { const bf16_t* A; const bf16_t* Bt; int M, N, K; };

struct StaticOrder {
    int nM, nN, nwg, G, c;
    __host__ __device__ void init(int M, int N, int G_, int c_) { nM = M / BM; nN = N / BM; nwg = nM * nN; G = G_; c = c_; }
    __host__ __device__ bool next(int i, Unit& u) const {
        const long L = (long)i * G + c; if (L >= nwg) return false;
        int wgid = (int)L; { const int q = nwg / NXCD, r = nwg % NXCD, xcd = wgid % NXCD, off = wgid / NXCD; wgid = (xcd < r ? xcd * (q + 1) : r * (q + 1) + (xcd - r) * q) + off; }
        const int nig = WGM * nN, gid = wgid / nig, fm = gid * WGM, gsz = (nM - fm) < WGM ? (nM - fm) : WGM;
        u.pm = fm + ((wgid % nig) % gsz); u.pn = (wgid % nig) / gsz; return true;
    }
    __device__ __forceinline__ void a_ready(const Unit&) const {}
    __device__ __forceinline__ void done(const Unit&) const {}
};

__device__ __forceinline__ unsigned cvt_pk_bf16(float lo, float hi) { unsigned r; asm volatile("v_cvt_pk_bf16_f32 %0, %1, %2" : "=v"(r) : "v"(lo), "v"(hi)); return r; }
typedef float f32x2 __attribute__((ext_vector_type(2)));
typedef unsigned u32x2 __attribute__((ext_vector_type(2)));
constexpr float RMS_EPS = 1e-6f;
constexpr int SS_M = 32768;
__device__ __forceinline__ f32x2 gelu2(f32x2 v) {
    const f32x2 w = v * (v * v * 0.044715f + 1.0f) * (-2.0f * 0.7978845608028654f * 1.4426950408889634f);
    f32x2 e; e.x = __builtin_amdgcn_exp2f(w.x); e.y = __builtin_amdgcn_exp2f(w.y);
    e = e + 1.0f;
    f32x2 r; r.x = __builtin_amdgcn_rcpf(e.x); r.y = __builtin_amdgcn_rcpf(e.y);
    return v * r;
}
__device__ __forceinline__ f32x4 gelu4(f32x4 v) { const f32x2 a = gelu2((f32x2){v[0], v[1]}), b = gelu2((f32x2){v[2], v[3]}); return (f32x4){a.x, a.y, b.x, b.y}; }
__device__ __forceinline__ f32x2 swiglu2(f32x2 g, f32x2 u, float r) {
    g = g * r; u = u * r;
    const f32x2 w = g * (-1.4426950408889634f);
    f32x2 e; e.x = __builtin_amdgcn_exp2f(w.x); e.y = __builtin_amdgcn_exp2f(w.y);
    e = e + 1.0f;
    f32x2 q; q.x = __builtin_amdgcn_rcpf(e.x); q.y = __builtin_amdgcn_rcpf(e.y);
    return (g * u) * q;
}
__device__ __forceinline__ f32x4 swiglu4(f32x4 g, f32x4 u, float r) { const f32x2 a = swiglu2((f32x2){g[0], g[1]}, (f32x2){u[0], u[1]}, r), b = swiglu2((f32x2){g[2], g[3]}, (f32x2){u[2], u[3]}, r); return (f32x4){a.x, a.y, b.x, b.y}; }
__device__ __forceinline__ u32x4 pack8(const f32x4 a, const f32x4 b) {
    u32x4 w; w.x = cvt_pk_bf16(a[0], a[1]); w.y = cvt_pk_bf16(a[2], a[3]); w.z = cvt_pk_bf16(b[0], b[1]); w.w = cvt_pk_bf16(b[2], b[3]); return w;
}
__device__ __forceinline__ float row_rstd(const float* ss, int row, int fq) {
    const f32x4 p = *(const f32x4*)(ss + (size_t)row * 16 + fq * 4);
    float s = (p[0] + p[1]) + (p[2] + p[3]);
    s += __shfl_xor(s, 16); s += __shfl_xor(s, 32);
    return 1.0f / sqrtf(s * (1.0f / 1024.0f) + RMS_EPS);
}

struct EpiGelu {
    static constexpr bool PERM = true, AFTER_DRAIN = false;
    bf16_t* O; int ldc;
    __device__ __forceinline__ void operator()(const f32x4 (&acc)[2][2][4][2], const Unit& u, int wr, int wc, int fr, int fq) const {
        const int row0 = u.pm * BM + wr * 64 + fr, col0 = u.pn * BM + wc * 32 + 8 * fq;
#pragma unroll
        for (int ai = 0; ai < 2; ++ai)
#pragma unroll
            for (int m = 0; m < 4; ++m) { bf16_t* rowp = O + (size_t)(row0 + ai * HALF + m * 16) * ldc + col0;
#pragma unroll
                for (int bj = 0; bj < 2; ++bj) { f32x4 v0 = acc[ai][bj][m][0], v1 = acc[ai][bj][m][1];
                    v0 = gelu4(v0); v1 = gelu4(v1);
                    *(u32x4*)(rowp + bj * HALF) = pack8(v0, v1); } }
    }
};
struct EpiGeluT {
    static constexpr bool PERM = true, AFTER_DRAIN = false;
    bf16_t* O; f32x2* vst;
    __device__ __forceinline__ void operator()(const f32x4 (&acc)[2][2][4][2], const Unit& u, int wr, int wc, int fr, int fq) const {
        const int row0 = u.pm * BM + wr * 64 + fr, col0 = u.pn * BM + wc * 32 + 8 * fq;
        float v[32];
#pragma unroll
        for (int i = 0; i < 32; ++i) v[i] = 0.f;
#pragma unroll
        for (int ai = 0; ai < 2; ++ai)
#pragma unroll
            for (int m = 0; m < 4; ++m) { bf16_t* rowp = O + ((size_t)(2 * u.pn) * 2048 + (row0 + ai * HALF + m * 16)) * 128 + wc * 32 + 8 * fq;
#pragma unroll
                for (int bj = 0; bj < 2; ++bj) { f32x4 v0 = acc[ai][bj][m][0], v1 = acc[ai][bj][m][1];
                    v0 = gelu4(v0); v1 = gelu4(v1);
#pragma unroll
                    for (int e = 0; e < 4; ++e) {
                        v[2 * (8 * bj + e)] += v0[e]; v[2 * (8 * bj + e) + 1] += v0[e] * v0[e];
                        v[2 * (8 * bj + 4 + e)] += v1[e]; v[2 * (8 * bj + 4 + e) + 1] += v1[e] * v1[e]; }
                    *(u32x4*)(rowp + (size_t)bj * 2048 * 128) = pack8(v0, v1); } }
#define PG8_XSTEP(H, MASK) { const bool bit = (fr & (MASK)) != 0; _Pragma("unroll") for (int i = 0; i < (H); ++i) { const float send = bit ? v[i] : v[i + (H)]; const float keep = bit ? v[i + (H)] : v[i]; v[i] = keep + __shfl_xor(send, (MASK)); } }
        PG8_XSTEP(16, 8) PG8_XSTEP(8, 4) PG8_XSTEP(4, 2) PG8_XSTEP(2, 1)
#undef PG8_XSTEP
        const int token = u.pn * BM + (fr >> 3) * HALF + wc * 32 + 8 * fq + (fr & 7);
        vst[(size_t)(u.pm * 2 + wr) * SS_M + token] = (f32x2){v[0], v[1]};
    }
};
template <bool F32BASE> struct EpiRes {
    static constexpr bool PERM = true, AFTER_DRAIN = false;
    const float* base; bf16_t* xb; float* ss;
    __device__ __forceinline__ void operator()(const f32x4 (&acc)[2][2][4][2], const Unit& u, int wr, int wc, int fr, int fq) const {
        const int row0 = u.pm * BM + wr * 64 + fr, col0 = u.pn * BM + wc * 32 + 8 * fq;
        if constexpr (F32BASE) {
#pragma unroll
            for (int ai = 0; ai < 2; ++ai) {
                f32x4 pre[4][2][2];
#pragma unroll
                for (int m = 0; m < 4; ++m) { const size_t off = (size_t)(row0 + ai * HALF + m * 16) * 1024 + col0;
#pragma unroll
                    for (int bj = 0; bj < 2; ++bj) { pre[m][bj][0] = *(const f32x4*)(base + off + bj * HALF); pre[m][bj][1] = *(const f32x4*)(base + off + bj * HALF + 4); } }
                asm volatile("" ::: "memory");
#pragma unroll
                for (int m = 0; m < 4; ++m) { const int row = row0 + ai * HALF + m * 16; const size_t off = (size_t)row * 1024 + col0; float q = 0.f;
#pragma unroll
                    for (int bj = 0; bj < 2; ++bj) {
                        const f32x4 o0 = pre[m][bj][0] + acc[ai][bj][m][0], o1 = pre[m][bj][1] + acc[ai][bj][m][1];
                        q += (o0[0] * o0[0] + o0[1] * o0[1]) + (o0[2] * o0[2] + o0[3] * o0[3]) + (o1[0] * o1[0] + o1[1] * o1[1]) + (o1[2] * o1[2] + o1[3] * o1[3]);
                        *(u32x4*)(xb + off + bj * HALF) = pack8(o0, o1); }
                    q += __shfl_xor(q, 16); q += __shfl_xor(q, 32);
                    if (fq == 0) ss[(size_t)(u.pn * 4 + wc) * SS_M + row] = q; }
                asm volatile("" ::: "memory");
            }
        } else {
            u32x4 pre[2][4][2];
#pragma unroll
            for (int ai = 0; ai < 2; ++ai)
#pragma unroll
                for (int m = 0; m < 4; ++m) { const size_t off = (size_t)(row0 + ai * HALF + m * 16) * 1024 + col0;
#pragma unroll
                    for (int bj = 0; bj < 2; ++bj) pre[ai][m][bj] = *(const u32x4*)(xb + off + bj * HALF); }
            asm volatile("" ::: "memory");
#pragma unroll
            for (int ai = 0; ai < 2; ++ai)
#pragma unroll
                for (int m = 0; m < 4; ++m) { const int row = row0 + ai * HALF + m * 16; const size_t off = (size_t)row * 1024 + col0; float q = 0.f;
#pragma unroll
                    for (int bj = 0; bj < 2; ++bj) { const u32x4 p = pre[ai][m][bj];
                        const f32x4 b0 = {__builtin_bit_cast(float, p.x << 16), __builtin_bit_cast(float, p.x & 0xffff0000u), __builtin_bit_cast(float, p.y << 16), __builtin_bit_cast(float, p.y & 0xffff0000u)};
                        const f32x4 b1 = {__builtin_bit_cast(float, p.z << 16), __builtin_bit_cast(float, p.z & 0xffff0000u), __builtin_bit_cast(float, p.w << 16), __builtin_bit_cast(float, p.w & 0xffff0000u)};
                        const f32x4 o0 = b0 + acc[ai][bj][m][0], o1 = b1 + acc[ai][bj][m][1];
                        q += (o0[0] * o0[0] + o0[1] * o0[1]) + (o0[2] * o0[2] + o0[3] * o0[3]) + (o1[0] * o1[0] + o1[1] * o1[1]) + (o1[2] * o1[2] + o1[3] * o1[3]);
                        *(u32x4*)(xb + off + bj * HALF) = pack8(o0, o1); }
                    q += __shfl_xor(q, 16); q += __shfl_xor(q, 32);
                    if (fq == 0) ss[(size_t)(u.pn * 4 + wc) * SS_M + row] = q; }
        }
    }
};
__device__ __forceinline__ void rows_rstd(float (&rs)[2][4], const float* ss, const PG8_LAS float* tab, int pm, int row0, int fq) {
    if (tab) { const PG8_LAS float* t = tab + ((pm >> 3) & 1) * BM + (row0 - pm * BM);
#pragma unroll
        for (int ai = 0; ai < 2; ++ai)
#pragma unroll
            for (int m = 0; m < 4; ++m) rs[ai][m] = t[ai * HALF + m * 16];
        return; }
    f32x4 p[2][4];
#pragma unroll
    for (int ai = 0; ai < 2; ++ai)
#pragma unroll
        for (int m = 0; m < 4; ++m) { const float* q = ss + (size_t)(fq * 4) * SS_M + (row0 + ai * HALF + m * 16); p[ai][m] = (f32x4){q[0], q[SS_M], q[2 * SS_M], q[3 * SS_M]}; }
    asm volatile("" ::: "memory");
#pragma unroll
    for (int ai = 0; ai < 2; ++ai)
#pragma unroll
        for (int m = 0; m < 4; ++m) { float s = (p[ai][m][0] + p[ai][m][1]) + (p[ai][m][2] + p[ai][m][3]); s += __shfl_xor(s, 16); s += __shfl_xor(s, 32);
            rs[ai][m] = __builtin_amdgcn_rsqf(s * (1.0f / 1024.0f) + RMS_EPS); }
}
struct EpiSwiglu {
    static constexpr bool PERM = true, AFTER_DRAIN = false;
    bf16_t* O; int ldc; const float* ss; const PG8_LAS float* tab;
    __device__ __forceinline__ void operator()(const f32x4 (&acc)[2][2][4][2], const Unit& u, int wr, int wc, int fr, int fq) const {
        const int row0 = u.pm * BM + wr * 64 + fr, col0 = u.pn * HALF + wc * 32 + 8 * fq;
        float rs[2][4]; rows_rstd(rs, ss, tab, u.pm, row0, fq);
#pragma unroll
        for (int ai = 0; ai < 2; ++ai)
#pragma unroll
            for (int m = 0; m < 4; ++m) { const int row = row0 + ai * HALF + m * 16; const float r = rs[ai][m];
                const f32x4 a0 = swiglu4(acc[ai][0][m][0], acc[ai][1][m][0], r), a1 = swiglu4(acc[ai][0][m][1], acc[ai][1][m][1], r);
                *(u32x4*)(O + (size_t)row * ldc + col0) = pack8(a0, a1); }
    }
};
struct EpiConvIn {
    static constexpr bool PERM = true, AFTER_DRAIN = false;
    bf16_t* Z; bf16_t* BG; const float* ss; const PG8_LAS float* tab;
    __device__ __forceinline__ void operator()(const f32x4 (&acc)[2][2][4][2], const Unit& u, int wr, int wc, int fr, int fq) const {
        const int row0 = u.pm * BM + wr * 64 + fr;
        float rs[2][4]; rows_rstd(rs, ss, tab, u.pm, row0, fq);
        if (u.pn < 8) {
            const int col0 = u.pn * HALF + wc * 32 + 8 * fq;
#pragma unroll
            for (int ai = 0; ai < 2; ++ai)
#pragma unroll
                for (int m = 0; m < 4; ++m) { const int row = row0 + ai * HALF + m * 16; const float r2 = rs[ai][m] * rs[ai][m];
                    const f32x4 a0 = acc[ai][0][m][0] * acc[ai][1][m][0] * r2, a1 = acc[ai][0][m][1] * acc[ai][1][m][1] * r2;
                    *(u32x4*)(Z + (size_t)row * 1024 + col0) = pack8(a0, a1); }
        } else {
            const int col0 = (u.pn - 8) * BM + wc * 32 + 8 * fq;
#pragma unroll
            for (int ai = 0; ai < 2; ++ai)
#pragma unroll
                for (int m = 0; m < 4; ++m) { const int row = row0 + ai * HALF + m * 16; const float r = rs[ai][m];
#pragma unroll
                    for (int bj = 0; bj < 2; ++bj) *(u32x4*)(BG + (size_t)row * 1024 + col0 + bj * HALF) = pack8(acc[ai][bj][m][0] * r, acc[ai][bj][m][1] * r); }
        }
    }
};

template <class Epi, class Sched, bool ALIGN_EPI = false, bool SP2 = false>
__device__ __forceinline__ void gemm_phase(PG8_LAS unsigned char* lds, const Gemm g, const Sched& S, const Epi& E) {
    const int tid = threadIdx.x, wid = __builtin_amdgcn_readfirstlane(tid >> 6), lane = tid & 63, wr = wid >> 2, wc = wid & 3, fr = lane & 15, fq = lane >> 4;
    const int K = g.K, nt = K / BK;
    unsigned voffA[2], voffB[2];
#pragma unroll
    for (int i = 0; i < 2; ++i) { int R, C; stage_rc(tid * 16 + i * 8192, R, C); const int Rb = Epi::PERM ? ((R & ~31) + perm32(R & 31)) : R;
        voffA[i] = (unsigned)(R * K + C) * 2u; voffB[i] = (unsigned)(Rb * K + C) * 2u; }
    const size_t kstep = (size_t)(BK * 2);
    const size_t hstep = (size_t)HALF * K * 2;
    const size_t tstep = 2 * hstep;
    const unsigned ldsw = (unsigned)wid * 1024u;
    const int aoff = lds_byte(wr * 64 + fr, fq * 8), boff = lds_byte(wc * 32 + fr, fq * 8);
#define PG8_SA(b, h) (((b) * 2 + (h)) * HTB)
#define PG8_SB(b, h) ((4 + (b) * 2 + (h)) * HTB)
#define PG8_STAGE(bufoff, gbase, voff) do { _Pragma("unroll") for (int _i = 0; _i < 2; ++_i) \
        __builtin_amdgcn_global_load_lds((const unsigned*)((const char*)(gbase) + (voff)[_i]), (PG8_LAS unsigned*)(lds + (bufoff) + ldsw + _i * 8192), 16, 0, 0); } while (0)
#define PG8_LDA(dst, b, h) do { _Pragma("unroll") for (int m = 0; m < 4; ++m) _Pragma("unroll") for (int k = 0; k < 2; ++k) dst[m][k] = *(const PG8_LAS bf16x8*)(lds + PG8_SA(b, h) + aoff + m * 2048 + k * 1024); } while (0)
#define PG8_LDB(dst, b, h) do { _Pragma("unroll") for (int n = 0; n < 2; ++n) _Pragma("unroll") for (int k = 0; k < 2; ++k) dst[n][k] = *(const PG8_LAS bf16x8*)(lds + PG8_SB(b, h) + boff + n * 2048 + k * 1024); } while (0)
#define PG8_MMA(ai, bj, At, Bt) do { __builtin_amdgcn_s_setprio(1); _Pragma("unroll") for (int m = 0; m < 4; ++m) _Pragma("unroll") for (int n = 0; n < 2; ++n) _Pragma("unroll") for (int k = 0; k < 2; ++k) \
        acc[ai][bj][m][n] = __builtin_amdgcn_mfma_f32_16x16x32_bf16(Bt[n][k], At[m][k], acc[ai][bj][m][n], 0, 0, 0); __builtin_amdgcn_s_setprio(0); } while (0)
#define PG8_WAIT_V(n) asm volatile("s_waitcnt vmcnt(" #n ")" ::: "memory")
#define PG8_WAIT_L(n) asm volatile("s_waitcnt lgkmcnt(" #n ")" ::: "memory")
#define PG8_BAR __builtin_amdgcn_s_barrier()
#define PG8_SCHED __builtin_amdgcn_sched_barrier(0)
    Unit cur, nxt; int ui = 0;
    if (!S.next(0, cur)) return;
    f32x4 acc[2][2][4][2];
#pragma unroll
    for (int a = 0; a < 2; ++a)
#pragma unroll
        for (int b = 0; b < 2; ++b)
#pragma unroll
            for (int m = 0; m < 4; ++m)
#pragma unroll
                for (int n = 0; n < 2; ++n) acc[a][b][m][n] = (f32x4){0.f, 0.f, 0.f, 0.f};
    bf16x8 At[4][2], B0[2][2], B1[2][2];
    const char* cA = (const char*)g.A + (size_t)cur.pm * tstep; const char* cB = (const char*)g.Bt + (size_t)cur.pn * tstep;
    S.a_ready(cur);
    if constexpr (SP2) {
        PG8_STAGE(PG8_SB(0, 0), cB, voffB); PG8_STAGE(PG8_SB(0, 1), cB + hstep, voffB); PG8_STAGE(PG8_SA(0, 0), cA, voffA); PG8_STAGE(PG8_SA(0, 1), cA + hstep, voffA);
        if (wr == 1) PG8_BAR;
        PG8_WAIT_V(2); PG8_BAR;
        PG8_STAGE(PG8_SB(1, 0), cB + kstep, voffB); PG8_STAGE(PG8_SA(1, 0), cA + kstep, voffA); PG8_STAGE(PG8_SB(1, 1), cB + hstep + kstep, voffB);
        PG8_WAIT_V(6); PG8_BAR;
    } else {
        PG8_STAGE(PG8_SB(0, 0), cB, voffB); PG8_STAGE(PG8_SA(0, 0), cA, voffA); PG8_STAGE(PG8_SB(0, 1), cB + hstep, voffB); PG8_STAGE(PG8_SA(0, 1), cA + hstep, voffA);
        if (wr == 1) PG8_BAR;
        PG8_WAIT_V(4); PG8_BAR;
        PG8_STAGE(PG8_SB(1, 0), cB + kstep, voffB); PG8_STAGE(PG8_SA(1, 0), cA + kstep, voffA); PG8_STAGE(PG8_SB(1, 1), cB + hstep + kstep, voffB);
        PG8_WAIT_V(6); PG8_BAR;
    }
    for (;;) {
        const bool has_next = S.next(ui + 1, nxt);
        const char* nA = has_next ? (const char*)g.A + (size_t)nxt.pm * tstep : cA; const char* nB = has_next ? (const char*)g.Bt + (size_t)nxt.pn * tstep : cB;
        for (int t = 0; t < nt; t += 2) {
            const bool last = (t == nt - 2);
            const char* a1 = cA + (size_t)(t + 1) * kstep;
            const char* a2 = last ? nA : cA + (size_t)(t + 2) * kstep; const char* b2 = last ? nB : cB + (size_t)(t + 2) * kstep;
            const char* a3 = a2 + kstep; const char* b3 = b2 + kstep;
            if (last && has_next) S.a_ready(nxt);
            if constexpr (SP2) {
            PG8_LDB(B0, 0, 0); PG8_LDB(B1, 0, 1); PG8_SCHED; PG8_LDA(At, 0, 0); PG8_STAGE(PG8_SA(1, 1), a1 + hstep, voffA);
            PG8_WAIT_V(8); PG8_WAIT_L(0); PG8_BAR; PG8_MMA(0, 0, At, B0); PG8_MMA(0, 1, At, B1); PG8_BAR; PG8_SCHED;
            PG8_LDA(At, 0, 1); PG8_STAGE(PG8_SB(0, 0), b2, voffB); PG8_STAGE(PG8_SB(0, 1), b2 + hstep, voffB); PG8_STAGE(PG8_SA(0, 0), a2, voffA);
            PG8_WAIT_V(8); PG8_WAIT_L(0); PG8_BAR; PG8_MMA(1, 0, At, B0); PG8_MMA(1, 1, At, B1); PG8_BAR; PG8_SCHED;
            PG8_LDB(B0, 1, 0); PG8_LDB(B1, 1, 1); PG8_SCHED; PG8_LDA(At, 1, 0); PG8_STAGE(PG8_SA(0, 1), a2 + hstep, voffA);
            PG8_WAIT_V(8); PG8_WAIT_L(0); PG8_BAR; PG8_MMA(0, 0, At, B0); PG8_MMA(0, 1, At, B1); PG8_BAR; PG8_SCHED;
            PG8_LDA(At, 1, 1); PG8_STAGE(PG8_SB(1, 0), b3, voffB); PG8_STAGE(PG8_SB(1, 1), b3 + hstep, voffB); PG8_STAGE(PG8_SA(1, 0), a3, voffA);
            PG8_WAIT_V(8); PG8_WAIT_L(0); PG8_BAR; PG8_MMA(1, 0, At, B0); PG8_MMA(1, 1, At, B1); PG8_BAR; PG8_SCHED;
            } else {
            PG8_LDB(B0, 0, 0); PG8_SCHED; PG8_LDA(At, 0, 0); PG8_STAGE(PG8_SA(1, 1), a1 + hstep, voffA);
            PG8_WAIT_L(8); PG8_BAR; PG8_WAIT_L(0); PG8_MMA(0, 0, At, B0); PG8_BAR; PG8_SCHED;
            PG8_LDB(B1, 0, 1); PG8_STAGE(PG8_SB(0, 0), b2, voffB);
            PG8_BAR; PG8_WAIT_L(0); PG8_MMA(0, 1, At, B1); PG8_BAR;
            PG8_LDA(At, 0, 1); PG8_STAGE(PG8_SA(0, 0), a2, voffA);
            PG8_BAR; PG8_WAIT_L(0); PG8_MMA(1, 0, At, B0); PG8_BAR; PG8_SCHED;
            PG8_STAGE(PG8_SB(0, 1), b2 + hstep, voffB);
            PG8_WAIT_V(6); PG8_BAR; PG8_MMA(1, 1, At, B1); PG8_BAR;
            PG8_LDB(B0, 1, 0); PG8_SCHED; PG8_LDA(At, 1, 0); PG8_STAGE(PG8_SA(0, 1), a2 + hstep, voffA);
            PG8_WAIT_L(8); PG8_BAR; PG8_WAIT_L(0); PG8_MMA(0, 0, At, B0); PG8_BAR; PG8_SCHED;
            PG8_LDB(B1, 1, 1); PG8_STAGE(PG8_SB(1, 0), b3, voffB);
            PG8_BAR; PG8_WAIT_L(0); PG8_MMA(0, 1, At, B1); PG8_BAR;
            PG8_LDA(At, 1, 1); PG8_STAGE(PG8_SA(1, 0), a3, voffA);
            PG8_BAR; PG8_WAIT_L(0); PG8_MMA(1, 0, At, B0); PG8_BAR; PG8_SCHED;
            PG8_STAGE(PG8_SB(1, 1), b3 + hstep, voffB);
            PG8_WAIT_V(6); PG8_BAR; PG8_MMA(1, 1, At, B1); PG8_BAR;
            }
        }
        if constexpr (ALIGN_EPI) { if (wr == 0) PG8_BAR; }
        if constexpr (!Epi::AFTER_DRAIN) { E(acc, cur, wr, wc, fr, fq); S.done(cur); }
        if (!has_next) break;
#pragma unroll
        for (int a = 0; a < 2; ++a)
#pragma unroll
            for (int b = 0; b < 2; ++b)
#pragma unroll
                for (int m = 0; m < 4; ++m)
#pragma unroll
                    for (int n = 0; n < 2; ++n) acc[a][b][m][n] = (f32x4){0.f, 0.f, 0.f, 0.f};
        cur = nxt; cA = nA; cB = nB; ++ui;
        if constexpr (ALIGN_EPI) { if (wr == 1) PG8_BAR; }
    }
    PG8_WAIT_V(0);
    if constexpr (!ALIGN_EPI) { if (wr == 0) PG8_BAR; }
    PG8_BAR;
    if constexpr (Epi::AFTER_DRAIN) { E.fused(acc, cur, wr, wc, fr, fq, lds, wid, lane); S.done(cur); }
#undef PG8_SA
#undef PG8_SB
#undef PG8_STAGE
#undef PG8_LDA
#undef PG8_LDB
#undef PG8_MMA
#undef PG8_WAIT_V
#undef PG8_WAIT_L
#undef PG8_BAR
#undef PG8_SCHED
}
}

constexpr int NWAVES = 8;
constexpr int SEQ = 2048, D = 1024, M = 16 * SEQ;
constexpr int EA = 2048, NH = 16, CH = 128;
constexpr int FF = 2816;
constexpr float LN_EPS = 1e-6f;
#ifndef MK_ONE_LAUNCH
#define MK_ONE_LAUNCH 1
#endif
constexpr int N_PHASES = 12;

constexpr size_t MiB = 1u << 20;
constexpr size_t WS_AIN = 2 * MiB, WS_AOUT = 10 * MiB, WS_WS = 14 * MiB, WS_GU0 = 15 * MiB, WS_D0 = 26 * MiB, WS_GU1 = 32 * MiB, WS_D1 = 43 * MiB, WS_BIN = 49 * MiB, WS_BOUT = 55 * MiB;
constexpr size_t WS_SS = 58 * MiB, WS_VST = 60 * MiB;
constexpr size_t WS_XB = 64 * MiB;
constexpr size_t WS_U = 128 * MiB, WS_VT = 256 * MiB;
constexpr size_t WS_A = 128 * MiB;
constexpr size_t WS_YC = 304 * MiB, WS_Z = 384 * MiB, WS_BG = 448 * MiB, WS_END = 512 * MiB;
constexpr size_t WS_Y = 384 * MiB;
static_assert(WS_A + (size_t)M * FF * 2 <= WS_YC && WS_YC + (size_t)M * D * 2 <= WS_Z && WS_BG + (size_t)M * D * 2 <= WS_END, "d_ws map");
static_assert(WS_GU0 + (size_t)2 * FF * D * 2 <= WS_D0 && WS_D0 + (size_t)FF * D * 2 <= WS_GU1 && WS_D1 + (size_t)FF * D * 2 <= WS_BIN, "weight map");

constexpr int RING_BYTES = 131072, LDSCTL_OFF = 143360, MISC_OFF = LDSCTL_OFF + 320, LDS_BYTES = 147456;
constexpr size_t WS_CTL = 0, CTL_ZERO_BYTES = 65536;
constexpr int CW_BAR = 4096;

#define GAS __attribute__((address_space(1)))
#define LAS __attribute__((address_space(3)))
typedef unsigned short bf16;
typedef unsigned v4u __attribute__((ext_vector_type(4)));
typedef unsigned v2u __attribute__((ext_vector_type(2)));
typedef float f32x4 __attribute__((ext_vector_type(4)));
typedef float f32x2 __attribute__((ext_vector_type(2)));
typedef short bf16x8 __attribute__((ext_vector_type(8)));
#define LDS_WAIT() asm volatile("s_waitcnt lgkmcnt(0)" ::: "memory")
__device__ __forceinline__ unsigned f2bf(float f) { unsigned u = __builtin_bit_cast(unsigned, f); return (u + 0x7fffu + ((u >> 16) & 1u)) >> 16; }
__device__ __forceinline__ unsigned pk2(float lo, float hi) { return f2bf(lo) | (f2bf(hi) << 16); }
__device__ __forceinline__ float bflo(unsigned w) { return __builtin_bit_cast(float, w << 16); }
__device__ __forceinline__ float bfhi(unsigned w) { return __builtin_bit_cast(float, w & 0xffff0000u); }

typedef GAS unsigned gu32;
#define RLX_AGENT __ATOMIC_RELAXED, __HIP_MEMORY_SCOPE_AGENT
#define XB_TMO      128
#define XB_XCNT(j)  (256  + 64 * (j))
#define XB_XSUB(j)  (1280 + 64 * (j))
#define XB_XGEN(j)  (2304 + 64 * (j))
#define XB_TOP      3328
#define XB_TOPGEN   3392
#define XCD_BAR_WORDS 3456
#define XB_SPIN_CAP (1u << 18)

__device__ __forceinline__ unsigned xb_ld(unsigned* p)              { return __hip_atomic_load(p, __ATOMIC_RELAXED, __HIP_MEMORY_SCOPE_AGENT); }
__device__ __forceinline__ unsigned xb_add(unsigned* p, unsigned v) { return __hip_atomic_fetch_add(p, v, __ATOMIC_RELAXED, __HIP_MEMORY_SCOPE_AGENT); }
__device__ __forceinline__ unsigned xb_xcc_id() { return (unsigned)__builtin_amdgcn_s_getreg((3 << 11) | 20) & 0xFu; }
#define XB_SPIN(cond, bar) do { unsigned _sp = 0; while (cond) { __builtin_amdgcn_s_sleep(1); \
    if ((++_sp & 255u) == 0u) { if (xb_ld(&(bar)[XB_TMO])) break; if (_sp > XB_SPIN_CAP) { atomicAdd(&(bar)[XB_TMO], 1u); break; } } } } while (0)

struct XcdBarrier {
    unsigned* bar; unsigned x;
    volatile LAS unsigned* st;
};

__device__ __forceinline__ XcdBarrier xcd_barrier_post(unsigned* bar, volatile LAS unsigned* st) {
    XcdBarrier b; b.bar = bar; b.x = xb_xcc_id(); b.st = st;
    if (threadIdx.x == 0) (void)xb_add(&bar[XB_XCNT(b.x)], 1u);
    return b;
}
__device__ __forceinline__ void xcd_barrier_complete(unsigned* bar, unsigned x, unsigned& nloc, unsigned& nx) {
    const unsigned G = gridDim.x * gridDim.y * gridDim.z;
    unsigned sum, cnt, mine, sp = 0u;
    for (;;) {
        sum = 0u; cnt = 0u; mine = 0u;
#pragma unroll
        for (unsigned j = 0; j < 16; ++j) { const unsigned c = xb_ld(&bar[XB_XCNT(j)]); sum += c; cnt += (c > 0u) ? 1u : 0u; mine = (j == x) ? c : mine; }
        if (sum == G) break;
        __builtin_amdgcn_s_sleep(1);
        if ((++sp & 255u) == 0u) { if (xb_ld(&bar[XB_TMO])) break; if (sp > XB_SPIN_CAP) { atomicAdd(&bar[XB_TMO], 1u); break; } }
    }
    nloc = mine > 0u ? mine : 1u; nx = cnt > 0u ? cnt : 1u;
}

__device__ __forceinline__ void xcd_barrier(const XcdBarrier& b) {
    asm volatile("s_waitcnt vmcnt(0)" ::: "memory");
    __syncthreads();
    if (threadIdx.x == 0) {
        unsigned* bar = b.bar;
        __builtin_amdgcn_s_waitcnt(0);
        unsigned nloc = b.st[0], nx = b.st[1];
        if (nloc == 0u) { xcd_barrier_complete(bar, b.x, nloc, nx); b.st[0] = nloc; b.st[1] = nx; }
        const unsigned old = xb_add(&bar[XB_XSUB(b.x)], 1u);
        const unsigned gen = old / nloc;
        if (old + 1u == (gen + 1u) * nloc) {
            __builtin_amdgcn_fence(__ATOMIC_RELEASE, "agent");
            asm volatile("s_waitcnt vmcnt(0)" ::: "memory");
            const unsigned og = xb_add(&bar[XB_TOP], 1u);
            const unsigned tg = og / nx;
            if (og + 1u == (tg + 1u) * nx) xb_add(&bar[XB_TOPGEN], 1u);
            else XB_SPIN(xb_ld(&bar[XB_TOPGEN]) == tg, bar);
            __builtin_amdgcn_fence(__ATOMIC_ACQUIRE, "agent");
            xb_add(&bar[XB_XGEN(b.x)], 1u);
            asm volatile("s_waitcnt vmcnt(0)" ::: "memory");
        } else {
            XB_SPIN(xb_ld(&bar[XB_XGEN(b.x)]) == gen, bar);
            __builtin_amdgcn_fence(__ATOMIC_ACQUIRE, "agent");
            asm volatile("s_waitcnt vmcnt(0)" ::: "memory");
        }
    }
    __syncthreads();
}

struct Frame {
    LAS unsigned char* lds;
    int tid, lane, wave, vcu, G;
    const float *x, *mix_norm, *ffn_norm, *a_w_in, *a_v_gain, *a_v_bias, *a_w_s, *a_b_s, *a_w_out, *b_w_in, *b_conv_w, *b_w_out, *w_gate, *w_up, *w_down, *final_norm;
    float* out; unsigned char* ws;
};

__device__ __forceinline__ float wave_sum(float v) {
#pragma unroll
    for (int o = 1; o < 64; o <<= 1) v += __shfl_xor(v, o);
    return v;
}
template <int MODE> __device__ __forceinline__ void p0_transpose_item(const float* W, int K, int N, bf16* WT, int row_off, const float* gain, LAS float* scr, int item, int lane) {
    const int nblk = N / 32, kb = item / nblk, nb = item % nblk, k0 = 64 * kb, n0 = 32 * nb;
#pragma unroll 8
    for (int i = 0; i < 32; ++i) { const int kk = 2 * i + (lane >> 5); float w = W[(size_t)(k0 + kk) * N + n0 + (lane & 31)]; if (gain) w *= gain[k0 + kk]; scr[kk * 33 + (lane & 31)] = w; }
    LDS_WAIT(); asm volatile("" ::: "memory");
    const int c = lane & 7;
    const int rbase = (MODE == 0) ? (row_off + n0) : (row_off + 256 * (n0 / 128) + (n0 % 128));
#pragma unroll
    for (int j = 0; j < 4; ++j) { const int n = (lane >> 3) + 8 * j; const LAS float* s = scr + (8 * c) * 33 + n;
        v4u o; o.x = pk2(s[0 * 33], s[1 * 33]); o.y = pk2(s[2 * 33], s[3 * 33]); o.z = pk2(s[4 * 33], s[5 * 33]); o.w = pk2(s[6 * 33], s[7 * 33]);
        *(GAS v4u*)(WT + (size_t)(rbase + n) * K + k0 + 8 * c) = o; }
    LDS_WAIT(); asm volatile("" ::: "memory");
}
__device__ __forceinline__ void p0_prologue(Frame& F) {
    LAS float* scr = (LAS float*)(F.lds + F.wave * 16384);
    const int gw = F.vcu * NWAVES + F.wave, NGW = F.G * NWAVES;
    unsigned char* ws = F.ws;
    constexpr int I_AIN = (D / 64) * (2 * EA / 32), I_AOUT = (EA / 64) * (D / 32), I_G = (D / 64) * (FF / 32), I_DN = (FF / 64) * (D / 32), I_BIN = (D / 64) * (D / 32), I_BOUT = (D / 64) * (D / 32);
    constexpr int NITEMS = I_AIN + I_AOUT + 4 * I_G + 2 * I_DN + 3 * I_BIN + I_BOUT;
    for (int it = gw; it < NITEMS; it += NGW) {
        int r = it;
        if (r < I_AIN) { p0_transpose_item<0>(F.a_w_in, D, 2 * EA, (bf16*)(ws + WS_AIN), 0, F.mix_norm, scr, r, F.lane); continue; } r -= I_AIN;
        if (r < I_AOUT) { p0_transpose_item<0>(F.a_w_out, EA, D, (bf16*)(ws + WS_AOUT), 0, nullptr, scr, r, F.lane); continue; } r -= I_AOUT;
        if (r < I_G) { p0_transpose_item<1>(F.w_gate, D, FF, (bf16*)(ws + WS_GU0), 0, F.ffn_norm, scr, r, F.lane); continue; } r -= I_G;
        if (r < I_G) { p0_transpose_item<1>(F.w_up, D, FF, (bf16*)(ws + WS_GU0), 128, F.ffn_norm, scr, r, F.lane); continue; } r -= I_G;
        if (r < I_G) { p0_transpose_item<1>(F.w_gate + (size_t)D * FF, D, FF, (bf16*)(ws + WS_GU1), 0, F.ffn_norm + D, scr, r, F.lane); continue; } r -= I_G;
        if (r < I_G) { p0_transpose_item<1>(F.w_up + (size_t)D * FF, D, FF, (bf16*)(ws + WS_GU1), 128, F.ffn_norm + D, scr, r, F.lane); continue; } r -= I_G;
        if (r < I_DN) { p0_transpose_item<0>(F.w_down, FF, D, (bf16*)(ws + WS_D0), 0, nullptr, scr, r, F.lane); continue; } r -= I_DN;
        if (r < I_DN) { p0_transpose_item<0>(F.w_down + (size_t)FF * D, FF, D, (bf16*)(ws + WS_D1), 0, nullptr, scr, r, F.lane); continue; } r -= I_DN;
        if (r < 3 * I_BIN) {
            const int nblk = 3 * D / 32, nb = r % nblk, n0 = 32 * nb, part = n0 / D;
            const int kb = r / nblk, k0 = 64 * kb; const float* W = F.b_w_in; bf16* WT = (bf16*)(ws + WS_BIN); const float* gain = F.mix_norm + D;
#pragma unroll 8
            for (int i = 0; i < 32; ++i) { const int kk = 2 * i + (F.lane >> 5); scr[kk * 33 + (F.lane & 31)] = W[(size_t)(k0 + kk) * (3 * D) + n0 + (F.lane & 31)] * gain[k0 + kk]; }
            LDS_WAIT(); asm volatile("" ::: "memory");
            const int e0 = n0 - part * D;
            const int rbase = (part == 0) ? (2048 + e0) : (256 * (e0 / 128) + (e0 % 128) + (part == 2 ? 128 : 0));
            const int c = F.lane & 7;
#pragma unroll
            for (int j = 0; j < 4; ++j) { const int n = (F.lane >> 3) + 8 * j; const LAS float* s = scr + (8 * c) * 33 + n;
                v4u o; o.x = pk2(s[0 * 33], s[1 * 33]); o.y = pk2(s[2 * 33], s[3 * 33]); o.z = pk2(s[4 * 33], s[5 * 33]); o.w = pk2(s[6 * 33], s[7 * 33]);
                *(GAS v4u*)(WT + (size_t)(rbase + n) * D + k0 + 8 * c) = o; }
            LDS_WAIT(); asm volatile("" ::: "memory");
            continue; } r -= 3 * I_BIN;
        p0_transpose_item<0>(F.b_w_out, D, D, (bf16*)(ws + WS_BOUT), 0, nullptr, scr, r, F.lane);
    }
    { const int gt = (F.vcu * NWAVES + F.wave) * 64 + F.lane, NGT = NGW * 64; bf16* o = (bf16*)(ws + WS_WS);
      for (int i = gt; i < NH * CH * CH / 2; i += NGT) { const int e = 2 * i, t = (e / CH) % CH, s = e % CH; const float a = F.a_w_s[e], b = F.a_w_s[e + 1];
          ((GAS unsigned*)o)[i] = pk2(s <= t ? a : 0.f, (s + 1) <= t ? b : 0.f); } }
    for (int m = gw; m < M; m += NGW) {
        const GAS f32x4* xr = (const GAS f32x4*)(F.x + (size_t)m * D) + F.lane;
        f32x4 v[4]; float s = 0.f;
#pragma unroll
        for (int j = 0; j < 4; ++j) { v[j] = xr[64 * j]; s += (v[j].x * v[j].x + v[j].y * v[j].y) + (v[j].z * v[j].z + v[j].w * v[j].w); }
        const float rstd = 1.f / sqrtf(wave_sum(s) * (1.f / D) + pg8::RMS_EPS);
        GAS unsigned long long* o8 = (GAS unsigned long long*)((bf16*)(ws + WS_XB) + (size_t)m * D) + F.lane;
#pragma unroll
        for (int j = 0; j < 4; ++j) o8[64 * j] = (unsigned long long)pk2(v[j].x * rstd, v[j].y * rstd) | ((unsigned long long)pk2(v[j].z * rstd, v[j].w * rstd) << 32);
    }
}

constexpr int SG_PITCH = 272;
constexpr int SG_W = 0, SG_V = 128 * SG_PITCH, SG_ST = 2 * 128 * SG_PITCH;
__device__ __forceinline__ void sgu_phase(Frame& F) {
    LAS unsigned char* lds = F.lds;
    const int tid = F.tid, lane = F.lane, w = F.wave, fr = lane & 15, fq = lane >> 4;
    const bf16* U = (const bf16*)(F.ws + WS_U); bf16* Y = (bf16*)(F.ws + WS_Y); const bf16* VT = (const bf16*)(F.ws + WS_VT); const bf16* WSB = (const bf16*)(F.ws + WS_WS);
    const f32x2* vst = (const f32x2*)(F.ws + WS_VST);
    const int cs = tid & 15, r0 = tid >> 4;
    const int t = 16 * w + fr;
    for (int chunk = F.vcu; chunk < M / CH; chunk += F.G) {
        const int t0 = chunk * CH;
        __syncthreads();
        if (tid < CH) { float s = 0.f, q = 0.f;
#pragma unroll
            for (int i = 0; i < 16; ++i) { const f32x2 a = vst[(size_t)i * M + t0 + tid]; s += a.x; q += a.y; }
            const float mean = s * (1.f / EA); const float var = q * (1.f / EA) - mean * mean; const float rstd = 1.f / sqrtf(var + LN_EPS);
            ((LAS f32x2*)(lds + SG_ST))[tid] = (f32x2){rstd, -mean * rstd}; }
#define SG_BAR() do { asm volatile("s_waitcnt lgkmcnt(0)" ::: "memory"); __builtin_amdgcn_s_barrier(); asm volatile("" ::: "memory"); } while (0)
        v4u wreg[4], vreg[4], ureg[4]; float gn[4], bi[4];
#define SG_LOAD(h_) do { const int hh = (h_); \
            _Pragma("unroll") for (int i = 0; i < 4; ++i) { const int r = r0 + 32 * i; const int c = hh * CH + r; \
                wreg[i] = *(const GAS v4u*)(WSB + (size_t)hh * CH * CH + r * CH + cs * 8); \
                vreg[i] = *(const GAS v4u*)(VT + ((size_t)chunk * EA + c) * CH + cs * 8); gn[i] = F.a_v_gain[c]; bi[i] = F.a_v_bias[c]; } \
            _Pragma("unroll") for (int g = 0; g < 4; ++g) ureg[g] = *(const GAS v4u*)(U + (size_t)(t0 + t) * EA + hh * CH + 8 * fq + 32 * g); } while (0)
        SG_LOAD(0);
        __syncthreads();
        f32x2 st[8];
#pragma unroll
        for (int k = 0; k < 8; ++k) st[k] = ((const LAS f32x2*)(lds + SG_ST))[cs * 8 + k];
        for (int h = 0; h < NH; ++h) {
            if (h) SG_BAR();
#pragma unroll
            for (int i = 0; i < 4; ++i) { const int r = r0 + 32 * i;
                *(LAS v4u*)(lds + SG_W + r * SG_PITCH + cs * 16) = wreg[i];
                const float g = gn[i], b = bi[i]; const unsigned wd[4] = {vreg[i].x, vreg[i].y, vreg[i].z, vreg[i].w}; float o[8];
#pragma unroll
                for (int k = 0; k < 4; ++k) { o[2 * k] = (bflo(wd[k]) * st[2 * k].x + st[2 * k].y) * g + b; o[2 * k + 1] = (bfhi(wd[k]) * st[2 * k + 1].x + st[2 * k + 1].y) * g + b; }
                v4u ov; ov.x = pk2(o[0], o[1]); ov.y = pk2(o[2], o[3]); ov.z = pk2(o[4], o[5]); ov.w = pk2(o[6], o[7]);
                *(LAS v4u*)(lds + SG_V + r * SG_PITCH + cs * 16) = ov; }
            v4u ucur[4];
#pragma unroll
            for (int g = 0; g < 4; ++g) ucur[g] = ureg[g];
            __syncthreads();
            if (h + 1 < NH) SG_LOAD(h + 1);
            f32x4 acc[4][2];
#pragma unroll
            for (int g = 0; g < 4; ++g) { acc[g][0] = (f32x4){0.f, 0.f, 0.f, 0.f}; acc[g][1] = (f32x4){0.f, 0.f, 0.f, 0.f}; }
            const int kmax = (16 * w + 15) / 32;
            for (int kk = 0; kk <= kmax; ++kk) {
                const bf16x8 a = *(const LAS bf16x8*)(lds + SG_W + t * SG_PITCH + kk * 64 + fq * 16);
#pragma unroll
                for (int g = 0; g < 4; ++g)
#pragma unroll
                    for (int n = 0; n < 2; ++n) { const int crow = 32 * g + 8 * (fr >> 2) + 4 * n + (fr & 3);
                        const bf16x8 b = *(const LAS bf16x8*)(lds + SG_V + crow * SG_PITCH + kk * 64 + fq * 16);
                        acc[g][n] = __builtin_amdgcn_mfma_f32_16x16x32_bf16(b, a, acc[g][n], 0, 0, 0); }
            }
            const float bs = F.a_b_s[h * CH + t];
            bf16* yp = Y + (size_t)(t0 + t) * EA + h * CH + 8 * fq;
#pragma unroll
            for (int g = 0; g < 4; ++g) { const v4u uv = ucur[g];
                v4u ov; ov.x = pk2(bflo(uv.x) * (acc[g][0][0] + bs), bfhi(uv.x) * (acc[g][0][1] + bs)); ov.y = pk2(bflo(uv.y) * (acc[g][0][2] + bs), bfhi(uv.y) * (acc[g][0][3] + bs));
                ov.z = pk2(bflo(uv.z) * (acc[g][1][0] + bs), bfhi(uv.z) * (acc[g][1][1] + bs)); ov.w = pk2(bflo(uv.w) * (acc[g][1][2] + bs), bfhi(uv.w) * (acc[g][1][3] + bs));
                *(GAS v4u*)(yp + 32 * g) = ov; }
        }
#undef SG_LOAD
#undef SG_BAR
    }
}

__device__ __forceinline__ void conv_phase(Frame& F) {
    const bf16* Z = (const bf16*)(F.ws + WS_Z); const bf16* BG = (const bf16*)(F.ws + WS_BG); bf16* YC = (bf16*)(F.ws + WS_YC);
    const int gt = F.vcu * 512 + F.tid, NGT = F.G * 512;
    for (int i = gt; i < M * (D / 8); i += NGT) {
        const int row = i >> 7, c8 = (i & 127) * 8, tpos = row & (SEQ - 1);
        const size_t off = (size_t)row * D + c8;
        const v4u z2 = *(const GAS v4u*)(Z + off), bg = *(const GAS v4u*)(BG + off);
        v4u z1 = (v4u){0u, 0u, 0u, 0u}, z0 = (v4u){0u, 0u, 0u, 0u};
        if (tpos >= 1) z1 = *(const GAS v4u*)(Z + off - D);
        if (tpos >= 2) z0 = *(const GAS v4u*)(Z + off - 2 * D);
        const f32x4 w0a = *(const GAS f32x4*)(F.b_conv_w + c8), w0b = *(const GAS f32x4*)(F.b_conv_w + c8 + 4);
        const f32x4 w1a = *(const GAS f32x4*)(F.b_conv_w + D + c8), w1b = *(const GAS f32x4*)(F.b_conv_w + D + c8 + 4);
        const f32x4 w2a = *(const GAS f32x4*)(F.b_conv_w + 2 * D + c8), w2b = *(const GAS f32x4*)(F.b_conv_w + 2 * D + c8 + 4);
        const unsigned a0[4] = {z0.x, z0.y, z0.z, z0.w}, a1[4] = {z1.x, z1.y, z1.z, z1.w}, a2[4] = {z2.x, z2.y, z2.z, z2.w}, ab[4] = {bg.x, bg.y, bg.z, bg.w};
        const float w0[8] = {w0a[0], w0a[1], w0a[2], w0a[3], w0b[0], w0b[1], w0b[2], w0b[3]}, w1[8] = {w1a[0], w1a[1], w1a[2], w1a[3], w1b[0], w1b[1], w1b[2], w1b[3]}, w2[8] = {w2a[0], w2a[1], w2a[2], w2a[3], w2b[0], w2b[1], w2b[2], w2b[3]};
        unsigned o[4];
#pragma unroll
        for (int k = 0; k < 4; ++k) {
            const float lo = bflo(ab[k]) * (bflo(a0[k]) * w0[2 * k] + bflo(a1[k]) * w1[2 * k] + bflo(a2[k]) * w2[2 * k]);
            const float hi = bfhi(ab[k]) * (bfhi(a0[k]) * w0[2 * k + 1] + bfhi(a1[k]) * w1[2 * k + 1] + bfhi(a2[k]) * w2[2 * k + 1]);
            o[k] = pk2(lo, hi); }
        *(GAS v4u*)(YC + off) = (v4u){o[0], o[1], o[2], o[3]};
    }
}
__device__ __forceinline__ void final_norm_phase(Frame& F) {
    const int gw = F.vcu * NWAVES + F.wave, NGW = F.G * NWAVES; const float* ss = (const float*)(F.ws + WS_SS); const bf16* XBp = (const bf16*)(F.ws + WS_XB);
    const GAS f32x4* gr = (const GAS f32x4*)F.final_norm + 2 * F.lane;
    for (int m = gw; m < M; m += NGW) {
        float s = (F.lane < 16) ? ss[(size_t)F.lane * M + m] : 0.f;
        s = wave_sum(s);
        const float rstd = 1.f / sqrtf(s * (1.f / D) + pg8::RMS_EPS);
        const GAS v4u* xr = (const GAS v4u*)(XBp + (size_t)m * D) + F.lane; GAS f32x4* orow = (GAS f32x4*)(F.out + (size_t)m * D) + 2 * F.lane;
#pragma unroll
        for (int j = 0; j < 2; ++j) { const v4u v = xr[64 * j]; const f32x4 g0 = gr[128 * j], g1 = gr[128 * j + 1];
            orow[128 * j] = (f32x4){bflo(v.x), bfhi(v.x), bflo(v.y), bfhi(v.y)} * rstd * g0;
            orow[128 * j + 1] = (f32x4){bflo(v.z), bfhi(v.z), bflo(v.w), bfhi(v.w)} * rstd * g1; }
    }
}

constexpr int RSTD_OFF = RING_BYTES;
__device__ __forceinline__ const LAS float* fill_rstd_table(Frame& F, int pm0) {
    if (F.G != 256) return nullptr;
    const float* ss = (const float*)(F.ws + WS_SS);
    const int slot = F.tid >> 8, r = F.tid & 255, row = (((pm0 & ~8) | (slot << 3)) << 8) + r;
    float s = 0.f;
#pragma unroll
    for (int j = 0; j < 16; ++j) s += ss[(size_t)j * M + row];
    ((LAS float*)(F.lds + RSTD_OFF))[F.tid] = __builtin_amdgcn_rsqf(s * (1.0f / D) + pg8::RMS_EPS);
    __syncthreads();
    return (const LAS float*)(F.lds + RSTD_OFF);
}

struct Args { const float* in[16]; float* out; unsigned char* ws; int ph_lo, ph_hi, rep_mask, pad; };
__global__ void __launch_bounds__(NWAVES * 64, 2) hybrid_fwd(Args args) {
    extern __shared__ __attribute__((aligned(16))) unsigned char lds[];
    cg::grid_group grid = cg::this_grid();
    Frame F;
    F.lds = (LAS unsigned char*)lds;
    F.tid = threadIdx.x; F.lane = F.tid & 63; F.wave = __builtin_amdgcn_readfirstlane(F.tid >> 6);
    F.G = gridDim.x; { const int bx = blockIdx.x; F.vcu = (F.G % 8 == 0) ? (bx % 8) * (F.G / 8) + bx / 8 : bx; }
    F.x = args.in[0]; F.mix_norm = args.in[1]; F.ffn_norm = args.in[2]; F.a_w_in = args.in[3]; F.a_v_gain = args.in[4]; F.a_v_bias = args.in[5]; F.a_w_s = args.in[6]; F.a_b_s = args.in[7];
    F.a_w_out = args.in[8]; F.b_w_in = args.in[9]; F.b_conv_w = args.in[10]; F.b_w_out = args.in[11]; F.w_gate = args.in[12]; F.w_up = args.in[13]; F.w_down = args.in[14]; F.final_norm = args.in[15];
    F.out = args.out; F.ws = args.ws;
    unsigned char* ws = args.ws;
    for (int u = F.tid; u < (LDS_BYTES - LDSCTL_OFF) / 4; u += NWAVES * 64) ((LAS unsigned*)(F.lds + LDSCTL_OFF))[u] = 0u;
    __syncthreads();
    XcdBarrier bar = xcd_barrier_post((unsigned*)(ws + WS_CTL) + CW_BAR, (volatile LAS unsigned*)(F.lds + MISC_OFF) + 8);
    const int lo = args.ph_lo, hi = args.ph_hi;
    if (lo < 0) grid.sync();
#ifndef REP_MASK
#define REP_MASK 0
#endif
#ifndef EXTRA_SYNCS
#define EXTRA_SYNCS 0
#endif
#define REPS(k) 1
#define IN(k) (lo <= (k) && (k) < hi)
#ifndef PROBE_T
#define PROBE_T 0
#endif
#if PROBE_T
#ifndef PROBE_DIV
#define PROBE_DIV 20ull
#endif
#define STAMP(i) do { if (blockIdx.x == 0 && F.tid == 0) ((volatile LAS unsigned long long*)(F.lds + MISC_OFF + 128))[(i)] = __builtin_amdgcn_s_memrealtime(); } while (0)
#else
#define STAMP(i) do { } while (0)
#endif
#define SEAM(k) do { if (IN(k) && IN((k) + 1)) xcd_barrier(bar); STAMP((k) + 1); } while (0)
    pg8::bf16_t* XB = (pg8::bf16_t*)(ws + WS_XB); float* SS = (float*)(ws + WS_SS);
    const int c = (int)blockIdx.x;

    STAMP(0);
    if (IN(0)) { p0_prologue(F); __syncthreads(); } SEAM(0);

    if (IN(1)) {
        { pg8::Gemm g{XB, (const pg8::bf16_t*)(ws + WS_AIN), M, EA, D}; pg8::StaticOrder S; S.init(M, EA, F.G, c);
          pg8::EpiGelu E{(pg8::bf16_t*)(ws + WS_U), EA};
          pg8::gemm_phase<pg8::EpiGelu, pg8::StaticOrder, true, true>(F.lds, g, S, E); }
        { pg8::Gemm g{(const pg8::bf16_t*)(ws + WS_AIN) + (size_t)EA * D, XB, EA, M, D}; pg8::StaticOrder S; S.init(EA, M, F.G, c);
          pg8::EpiGeluT E{(pg8::bf16_t*)(ws + WS_VT), (pg8::f32x2*)(ws + WS_VST)};
          pg8::gemm_phase<pg8::EpiGeluT, pg8::StaticOrder, true, true>(F.lds, g, S, E); }
    } SEAM(1);

    if (IN(2)) { sgu_phase(F); } SEAM(2);

    if (IN(3)) {
        pg8::Gemm g{(const pg8::bf16_t*)(ws + WS_Y), (const pg8::bf16_t*)(ws + WS_AOUT), M, D, EA}; pg8::StaticOrder S; S.init(M, D, F.G, c);
        pg8::EpiRes<true> E{F.x, XB, SS};
        pg8::gemm_phase<pg8::EpiRes<true>, pg8::StaticOrder, true, true>(F.lds, g, S, E);
    } SEAM(3);

    if (IN(4)) {
        pg8::Gemm g{XB, (const pg8::bf16_t*)(ws + WS_GU0), M, 2 * FF, D}; pg8::StaticOrder S; S.init(M, 2 * FF, F.G, c);
        pg8::Unit u0; S.next(0, u0); pg8::EpiSwiglu E{(pg8::bf16_t*)(ws + WS_A), FF, SS, fill_rstd_table(F, u0.pm)};
        pg8::gemm_phase<pg8::EpiSwiglu, pg8::StaticOrder, true, true>(F.lds, g, S, E);
    } SEAM(4);

    if (IN(5)) {
        pg8::Gemm g{(const pg8::bf16_t*)(ws + WS_A), (const pg8::bf16_t*)(ws + WS_D0), M, D, FF}; pg8::StaticOrder S; S.init(M, D, F.G, c);
        pg8::EpiRes<false> E{nullptr, XB, SS};
        pg8::gemm_phase<pg8::EpiRes<false>, pg8::StaticOrder, true, true>(F.lds, g, S, E);
    } SEAM(5);

    if (IN(6)) {
        pg8::Gemm g{XB, (const pg8::bf16_t*)(ws + WS_BIN), M, 3 * D, D}; pg8::StaticOrder S; S.init(M, 3 * D, F.G, c);
        pg8::Unit u0; S.next(0, u0); pg8::EpiConvIn E{(pg8::bf16_t*)(ws + WS_Z), (pg8::bf16_t*)(ws + WS_BG), SS, fill_rstd_table(F, u0.pm)};
        pg8::gemm_phase<pg8::EpiConvIn, pg8::StaticOrder, true, true>(F.lds, g, S, E);
    } SEAM(6);

    if (IN(7)) { conv_phase(F); } SEAM(7);

    if (IN(8)) {
        pg8::Gemm g{(const pg8::bf16_t*)(ws + WS_YC), (const pg8::bf16_t*)(ws + WS_BOUT), M, D, D}; pg8::StaticOrder S; S.init(M, D, F.G, c);
        pg8::EpiRes<false> E{nullptr, XB, SS};
        pg8::gemm_phase<pg8::EpiRes<false>, pg8::StaticOrder, true, true>(F.lds, g, S, E);
    } SEAM(8);

    if (IN(9)) {
        pg8::Gemm g{XB, (const pg8::bf16_t*)(ws + WS_GU1), M, 2 * FF, D}; pg8::StaticOrder S; S.init(M, 2 * FF, F.G, c);
        pg8::Unit u0; S.next(0, u0); pg8::EpiSwiglu E{(pg8::bf16_t*)(ws + WS_A), FF, SS, fill_rstd_table(F, u0.pm)};
        pg8::gemm_phase<pg8::EpiSwiglu, pg8::StaticOrder, true, true>(F.lds, g, S, E);
    } SEAM(9);

    if (IN(10)) {
        pg8::Gemm g{(const pg8::bf16_t*)(ws + WS_A), (const pg8::bf16_t*)(ws + WS_D1), M, D, FF}; pg8::StaticOrder S; S.init(M, D, F.G, c);
        pg8::EpiRes<false> E{nullptr, XB, SS};
        pg8::gemm_phase<pg8::EpiRes<false>, pg8::StaticOrder, true, true>(F.lds, g, S, E);
    } SEAM(10);

    for (int i = 0; i < EXTRA_SYNCS; ++i) xcd_barrier(bar);
    if (IN(11)) { final_norm_phase(F); }
#if PROBE_T
    xcd_barrier(bar); STAMP(12);
    if (blockIdx.x == 0) {
        __syncthreads();
        volatile LAS unsigned long long* stp = (volatile LAS unsigned long long*)(F.lds + MISC_OFF + 128);
        const unsigned long long T = stp[PROBE_HI] - stp[PROBE_LO]; int K = (int)(T / PROBE_DIV); if (K > 4096) K = 4096;
        for (int j = F.tid; j < K; j += NWAVES * 64) F.out[(size_t)j * 8191] += 0.0625f;
    }
#endif
#undef IN
#undef SEAM
}

extern "C" void kernel_launch(void* const* d_in, const int* in_sizes, int n_in, void* d_out, int out_size, void* d_ws, size_t ws_size, hipStream_t stream) {
    static int grid = 0;
    if (grid == 0) {
        if (n_in != 16 || in_sizes[0] != M * D || out_size != M * D || ws_size < WS_END) { fprintf(stderr, "kernel_launch: unexpected shapes (n_in %d, in0 %d, out %d, ws %zu); nothing launched\n", n_in, n_in > 0 ? in_sizes[0] : -1, out_size, ws_size); grid = -1; return; }
        int dev = 0, cus = 0, per_cu = 0;
        if (hipGetDevice(&dev) != hipSuccess || hipDeviceGetAttribute(&cus, hipDeviceAttributeMultiprocessorCount, dev) != hipSuccess) { grid = -1; return; }
        if (hipFuncSetAttribute((const void*)hybrid_fwd, hipFuncAttributeMaxDynamicSharedMemorySize, LDS_BYTES) != hipSuccess) { fprintf(stderr, "kernel_launch: hipFuncSetAttribute failed\n"); grid = -1; return; }
        if (hipOccupancyMaxActiveBlocksPerMultiprocessor(&per_cu, (const void*)hybrid_fwd, NWAVES * 64, LDS_BYTES) != hipSuccess || per_cu < 1) { fprintf(stderr, "kernel_launch: occupancy query says %d blocks per CU\n", per_cu); per_cu = 1; }
        (void)hipGetLastError();
        grid = cus;
    }
    if (grid < 0) return;
    if (hipMemsetAsync((char*)d_ws + WS_CTL, 0, CTL_ZERO_BYTES, stream) != hipSuccess) { fprintf(stderr, "kernel_launch: memset failed\n"); return; }
    Args a{};
    for (int i = 0; i < 16; ++i) a.in[i] = (const float*)d_in[i];
    a.out = (float*)d_out; a.ws = (unsigned char*)d_ws; a.rep_mask = REP_MASK;
#if MK_ONE_LAUNCH
    a.ph_lo = 0; a.ph_hi = N_PHASES;
    void* kargs[] = {&a};
    const hipError_t e = hipLaunchCooperativeKernel((const void*)hybrid_fwd, dim3(grid), dim3(NWAVES * 64), kargs, LDS_BYTES, stream);
    if (e != hipSuccess) fprintf(stderr, "kernel_launch: cooperative launch failed: %s (grid %d)\n", hipGetErrorString(e), grid);
#else
    for (int p = 0; p < N_PHASES; ++p) { a.ph_lo = p; a.ph_hi = p + 1; hipLaunchKernelGGL(hybrid_fwd, dim3(grid), dim3(NWAVES * 64), LDS_BYTES, stream, a); }
#endif
}
```

```cpp
#include <hip/hip_runtime.h>
#include <hip/hip_cooperative_groups.h>
#include <cstdio>
#include <cstdint>
namespace cg = cooperative_groups;

namespace pg8 {
#define PG8_LAS __attribute__((address_space(3)))
typedef unsigned short bf16_t;
typedef short bf16x8 __attribute__((ext_vector_type(8)));
typedef float f32x4 __attribute__((ext_vector_type(4)));
typedef unsigned u32x4 __attribute__((ext_vector_type(4)));
constexpr int BM = 256, BK = 64, HALF = 128, HTB = HALF * BK * 2  , STAGE_BYTES = 8 * HTB, NXCD = 8, WGM = 8;

__host__ __device__ __forceinline__ int lds_byte(int r, int c) { const int st = (r >> 4) * 2 + (c >> 5), rr = r & 15, cc = c & 31, ob = rr * 64 + cc * 2; return st * 1024 + (ob ^ (((ob >> 9) & 1) << 5)); }
__host__ __device__ __forceinline__ void stage_rc(int b, int& R, int& C) { const int st = b / 1024, sb = b % 1024, swz = sb ^ (((sb >> 9) & 1) << 5); R = (st >> 1) * 16 + swz / 64; C = (st & 1) * 32 + (swz % 64) / 2; }
__host__ __device__ __forceinline__ int perm32(int rho) { const int n = rho >> 4, i = rho & 15; return 8 * (i >> 2) + 4 * n + (i & 3); }

struct Unit { int pm, pn; };
struct Gemm { const bf16_t* A; const bf16_t* Bt; int M, N, K; };

struct StaticOrder {
    int nM, nN, nwg, G, c;
    __host__ __device__ void init(int M, int N, int G_, int c_) { nM = M / BM; nN = N / BM; nwg = nM * nN; G = G_; c = c_; }
    __host__ __device__ bool next(int i, Unit& u) const {
        const long L = (long)i * G + c; if (L >= nwg) return false;
        int wgid = (int)L; { const int q = nwg / NXCD, r = nwg % NXCD, xcd = wgid % NXCD, off = wgid / NXCD; wgid = (xcd < r ? xcd * (q + 1) : r * (q + 1) + (xcd - r) * q) + off; }
        const int nig = WGM * nN, gid = wgid / nig, fm = gid * WGM, gsz = (nM - fm) < WGM ? (nM - fm) : WGM;
        u.pm = fm + ((wgid % nig) % gsz); u.pn = (wgid % nig) / gsz; return true;
    }
    __device__ __forceinline__ void a_ready(const Unit&) const {}
    __device__ __forceinline__ void done(const Unit&) const {}
};

__device__ __forceinline__ unsigned cvt_pk_bf16(float lo, float hi) { unsigned r; asm volatile("v_cvt_pk_bf16_f32 %0, %1, %2" : "=v"(r) : "v"(lo), "v"(hi)); return r; }
typedef float f32x2 __attribute__((ext_vector_type(2)));
typedef unsigned u32x2 __attribute__((ext_vector_type(2)));
constexpr float RMS_EPS = 1e-6f;
constexpr int SS_M = 32768;
__device__ __forceinline__ f32x2 gelu2(f32x2 v) {
    const f32x2 w = v * (v * v * 0.044715f + 1.0f) * (-2.0f * 0.7978845608028654f * 1.4426950408889634f);
    f32x2 e; e.x = __builtin_amdgcn_exp2f(w.x); e.y = __builtin_amdgcn_exp2f(w.y);
    e = e + 1.0f;
    f32x2 r; r.x = __builtin_amdgcn_rcpf(e.x); r.y = __builtin_amdgcn_rcpf(e.y);
    return v * r;
}
__device__ __forceinline__ f32x4 gelu4(f32x4 v) { const f32x2 a = gelu2((f32x2){v[0], v[1]}), b = gelu2((f32x2){v[2], v[3]}); return (f32x4){a.x, a.y, b.x, b.y}; }
__device__ __forceinline__ f32x2 swiglu2(f32x2 g, f32x2 u, float r) {
    g = g * r; u = u * r;
    const f32x2 w = g * (-1.4426950408889634f);
    f32x2 e; e.x = __builtin_amdgcn_exp2f(w.x); e.y = __builtin_amdgcn_exp2f(w.y);
    e = e + 1.0f;
    f32x2 q; q.x = __builtin_amdgcn_rcpf(e.x); q.y = __builtin_amdgcn_rcpf(e.y);
    return (g * u) * q;
}
__device__ __forceinline__ f32x4 swiglu4(f32x4 g, f32x4 u, float r) { const f32x2 a = swiglu2((f32x2){g[0], g[1]}, (f32x2){u[0], u[1]}, r), b = swiglu2((f32x2){g[2], g[3]}, (f32x2){u[2], u[3]}, r); return (f32x4){a.x, a.y, b.x, b.y}; }
__device__ __forceinline__ u32x4 pack8(const f32x4 a, const f32x4 b) {
    u32x4 w; w.x = cvt_pk_bf16(a[0], a[1]); w.y = cvt_pk_bf16(a[2], a[3]); w.z = cvt_pk_bf16(b[0], b[1]); w.w = cvt_pk_bf16(b[2], b[3]); return w;
}
__device__ __forceinline__ float row_rstd(const float* ss, int row, int fq) {
    const f32x4 p = *(const f32x4*)(ss + (size_t)row * 16 + fq * 4);
    float s = (p[0] + p[1]) + (p[2] + p[3]);
    s += __shfl_xor(s, 16); s += __shfl_xor(s, 32);
    return 1.0f / sqrtf(s * (1.0f / 1024.0f) + RMS_EPS);
}

struct EpiGelu {
    static constexpr bool PERM = true, AFTER_DRAIN = false, STAMPED = false;
    bf16_t* O; int ldc;
    __device__ __forceinline__ void operator()(const f32x4 (&acc)[2][2][4][2], const Unit& u, int wr, int wc, int fr, int fq) const {
        const int row0 = u.pm * BM + wr * 64 + fr, col0 = u.pn * BM + wc * 32 + 8 * fq;
#pragma unroll
        for (int ai = 0; ai < 2; ++ai)
#pragma unroll
            for (int m = 0; m < 4; ++m) { bf16_t* rowp = O + (size_t)(row0 + ai * HALF + m * 16) * ldc + col0;
#pragma unroll
                for (int bj = 0; bj < 2; ++bj) { f32x4 v0 = acc[ai][bj][m][0], v1 = acc[ai][bj][m][1];
                    v0 = gelu4(v0); v1 = gelu4(v1);
                    *(u32x4*)(rowp + bj * HALF) = pack8(v0, v1); } }
    }
};
struct EpiGeluT {
    static constexpr bool PERM = true, AFTER_DRAIN = false, STAMPED = false;
    bf16_t* O; f32x2* vst;
    __device__ __forceinline__ void operator()(const f32x4 (&acc)[2][2][4][2], const Unit& u, int wr, int wc, int fr, int fq) const {
        const int row0 = u.pm * BM + wr * 64 + fr, col0 = u.pn * BM + wc * 32 + 8 * fq;
        float v[32];
#pragma unroll
        for (int i = 0; i < 32; ++i) v[i] = 0.f;
#pragma unroll
        for (int ai = 0; ai < 2; ++ai)
#pragma unroll
            for (int m = 0; m < 4; ++m) { bf16_t* rowp = O + ((size_t)(2 * u.pn) * 2048 + (row0 + ai * HALF + m * 16)) * 128 + wc * 32 + 8 * fq;
#pragma unroll
                for (int bj = 0; bj < 2; ++bj) { f32x4 v0 = acc[ai][bj][m][0], v1 = acc[ai][bj][m][1];
                    v0 = gelu4(v0); v1 = gelu4(v1);
#pragma unroll
                    for (int e = 0; e < 4; ++e) {
                        v[2 * (8 * bj + e)] += v0[e]; v[2 * (8 * bj + e) + 1] += v0[e] * v0[e];
                        v[2 * (8 * bj + 4 + e)] += v1[e]; v[2 * (8 * bj + 4 + e) + 1] += v1[e] * v1[e]; }
                    *(u32x4*)(rowp + (size_t)bj * 2048 * 128) = pack8(v0, v1); } }
#define PG8_XSTEP(H, MASK) { const bool bit = (fr & (MASK)) != 0; _Pragma("unroll") for (int i = 0; i < (H); ++i) { const float send = bit ? v[i] : v[i + (H)]; const float keep = bit ? v[i + (H)] : v[i]; v[i] = keep + __shfl_xor(send, (MASK)); } }
        PG8_XSTEP(16, 8) PG8_XSTEP(8, 4) PG8_XSTEP(4, 2) PG8_XSTEP(2, 1)
#undef PG8_XSTEP
        const int token = u.pn * BM + (fr >> 3) * HALF + wc * 32 + 8 * fq + (fr & 7);
        vst[(size_t)(u.pm * 2 + wr) * SS_M + token] = (f32x2){v[0], v[1]};
    }
};
template <bool F32BASE> struct EpiRes {
    static constexpr bool PERM = true, AFTER_DRAIN = false, STAMPED = false;
    const float* base; bf16_t* xb; float* ss;
    __device__ __forceinline__ void operator()(const f32x4 (&acc)[2][2][4][2], const Unit& u, int wr, int wc, int fr, int fq) const {
        const int row0 = u.pm * BM + wr * 64 + fr, col0 = u.pn * BM + wc * 32 + 8 * fq;
        if constexpr (F32BASE) {
#pragma unroll
            for (int ai = 0; ai < 2; ++ai) {
                f32x4 pre[4][2][2];
#pragma unroll
                for (int m = 0; m < 4; ++m) { const size_t off = (size_t)(row0 + ai * HALF + m * 16) * 1024 + col0;
#pragma unroll
                    for (int bj = 0; bj < 2; ++bj) { pre[m][bj][0] = *(const f32x4*)(base + off + bj * HALF); pre[m][bj][1] = *(const f32x4*)(base + off + bj * HALF + 4); } }
                asm volatile("" ::: "memory");
#pragma unroll
                for (int m = 0; m < 4; ++m) { const int row = row0 + ai * HALF + m * 16; const size_t off = (size_t)row * 1024 + col0; float q = 0.f;
#pragma unroll
                    for (int bj = 0; bj < 2; ++bj) {
                        const f32x4 o0 = pre[m][bj][0] + acc[ai][bj][m][0], o1 = pre[m][bj][1] + acc[ai][bj][m][1];
                        q += (o0[0] * o0[0] + o0[1] * o0[1]) + (o0[2] * o0[2] + o0[3] * o0[3]) + (o1[0] * o1[0] + o1[1] * o1[1]) + (o1[2] * o1[2] + o1[3] * o1[3]);
                        *(u32x4*)(xb + off + bj * HALF) = pack8(o0, o1); }
                    q += __shfl_xor(q, 16); q += __shfl_xor(q, 32);
                    if (fq == 0) ss[(size_t)(u.pn * 4 + wc) * SS_M + row] = q; }
                asm volatile("" ::: "memory");
            }
        } else {
            u32x4 pre[2][4][2];
#pragma unroll
            for (int ai = 0; ai < 2; ++ai)
#pragma unroll
                for (int m = 0; m < 4; ++m) { const size_t off = (size_t)(row0 + ai * HALF + m * 16) * 1024 + col0;
#pragma unroll
                    for (int bj = 0; bj < 2; ++bj) pre[ai][m][bj] = *(const u32x4*)(xb + off + bj * HALF); }
            asm volatile("" ::: "memory");
#pragma unroll
            for (int ai = 0; ai < 2; ++ai)
#pragma unroll
                for (int m = 0; m < 4; ++m) { const int row = row0 + ai * HALF + m * 16; const size_t off = (size_t)row * 1024 + col0; float q = 0.f;
#pragma unroll
                    for (int bj = 0; bj < 2; ++bj) { const u32x4 p = pre[ai][m][bj];
                        const f32x4 b0 = {__builtin_bit_cast(float, p.x << 16), __builtin_bit_cast(float, p.x & 0xffff0000u), __builtin_bit_cast(float, p.y << 16), __builtin_bit_cast(float, p.y & 0xffff0000u)};
                        const f32x4 b1 = {__builtin_bit_cast(float, p.z << 16), __builtin_bit_cast(float, p.z & 0xffff0000u), __builtin_bit_cast(float, p.w << 16), __builtin_bit_cast(float, p.w & 0xffff0000u)};
                        const f32x4 o0 = b0 + acc[ai][bj][m][0], o1 = b1 + acc[ai][bj][m][1];
                        q += (o0[0] * o0[0] + o0[1] * o0[1]) + (o0[2] * o0[2] + o0[3] * o0[3]) + (o1[0] * o1[0] + o1[1] * o1[1]) + (o1[2] * o1[2] + o1[3] * o1[3]);
                        *(u32x4*)(xb + off + bj * HALF) = pack8(o0, o1); }
                    q += __shfl_xor(q, 16); q += __shfl_xor(q, 32);
                    if (fq == 0) ss[(size_t)(u.pn * 4 + wc) * SS_M + row] = q; }
        }
    }
};
__device__ __forceinline__ void rows_rstd(float (&rs)[2][4], const float* ss, const PG8_LAS float* tab, int pm, int row0, int fq) {
    if (tab) { const PG8_LAS float* t = tab + ((pm >> 3) & 1) * BM + (row0 - pm * BM);
#pragma unroll
        for (int ai = 0; ai < 2; ++ai)
#pragma unroll
            for (int m = 0; m < 4; ++m) rs[ai][m] = t[ai * HALF + m * 16];
        return; }
    f32x4 p[2][4];
#pragma unroll
    for (int ai = 0; ai < 2; ++ai)
#pragma unroll
        for (int m = 0; m < 4; ++m) { const float* q = ss + (size_t)(fq * 4) * SS_M + (row0 + ai * HALF + m * 16); p[ai][m] = (f32x4){q[0], q[SS_M], q[2 * SS_M], q[3 * SS_M]}; }
    asm volatile("" ::: "memory");
#pragma unroll
    for (int ai = 0; ai < 2; ++ai)
#pragma unroll
        for (int m = 0; m < 4; ++m) { float s = (p[ai][m][0] + p[ai][m][1]) + (p[ai][m][2] + p[ai][m][3]); s += __shfl_xor(s, 16); s += __shfl_xor(s, 32);
            rs[ai][m] = __builtin_amdgcn_rsqf(s * (1.0f / 1024.0f) + RMS_EPS); }
}
struct EpiSwiglu {
    static constexpr bool PERM = true, AFTER_DRAIN = false, STAMPED = false;
    bf16_t* O; int ldc; const float* ss; const PG8_LAS float* tab;
    __device__ __forceinline__ void operator()(const f32x4 (&acc)[2][2][4][2], const Unit& u, int wr, int wc, int fr, int fq) const {
        const int row0 = u.pm * BM + wr * 64 + fr, col0 = u.pn * HALF + wc * 32 + 8 * fq;
        float rs[2][4]; rows_rstd(rs, ss, tab, u.pm, row0, fq);
#pragma unroll
        for (int ai = 0; ai < 2; ++ai)
#pragma unroll
            for (int m = 0; m < 4; ++m) { const int row = row0 + ai * HALF + m * 16; const float r = rs[ai][m];
                const f32x4 a0 = swiglu4(acc[ai][0][m][0], acc[ai][1][m][0], r), a1 = swiglu4(acc[ai][0][m][1], acc[ai][1][m][1], r);
                *(u32x4*)(O + (size_t)row * ldc + col0) = pack8(a0, a1); }
    }
};
struct EpiConvIn {
    static constexpr bool PERM = true, AFTER_DRAIN = false, STAMPED = false;
    bf16_t* Z; bf16_t* BG; const float* ss; const PG8_LAS float* tab;
    __device__ __forceinline__ void operator()(const f32x4 (&acc)[2][2][4][2], const Unit& u, int wr, int wc, int fr, int fq) const {
        const int row0 = u.pm * BM + wr * 64 + fr;
        float rs[2][4]; rows_rstd(rs, ss, tab, u.pm, row0, fq);
        if (u.pn < 8) {
            const int col0 = u.pn * HALF + wc * 32 + 8 * fq;
#pragma unroll
            for (int ai = 0; ai < 2; ++ai)
#pragma unroll
                for (int m = 0; m < 4; ++m) { const int row = row0 + ai * HALF + m * 16; const float r2 = rs[ai][m] * rs[ai][m];
                    const f32x4 a0 = acc[ai][0][m][0] * acc[ai][1][m][0] * r2, a1 = acc[ai][0][m][1] * acc[ai][1][m][1] * r2;
                    *(u32x4*)(Z + (size_t)row * 1024 + col0) = pack8(a0, a1); }
        } else {
            const int col0 = (u.pn - 8) * BM + wc * 32 + 8 * fq;
#pragma unroll
            for (int ai = 0; ai < 2; ++ai)
#pragma unroll
                for (int m = 0; m < 4; ++m) { const int row = row0 + ai * HALF + m * 16; const float r = rs[ai][m];
#pragma unroll
                    for (int bj = 0; bj < 2; ++bj) *(u32x4*)(BG + (size_t)row * 1024 + col0 + bj * HALF) = pack8(acc[ai][bj][m][0] * r, acc[ai][bj][m][1] * r); }
        }
    }
};

#define PG8_STAMP(i, cond) do { } while (0)
template <class Epi, class Sched, bool ALIGN_EPI = false, bool SP2 = false>
__device__ __forceinline__ void gemm_phase(PG8_LAS unsigned char* lds, const Gemm g, const Sched& S, const Epi& E) {
    const int tid = threadIdx.x, wid = __builtin_amdgcn_readfirstlane(tid >> 6), lane = tid & 63, wr = wid >> 2, wc = wid & 3, fr = lane & 15, fq = lane >> 4;
    const int K = g.K, nt = K / BK;
    unsigned voffA[2], voffB[2];
#pragma unroll
    for (int i = 0; i < 2; ++i) { int R, C; stage_rc(tid * 16 + i * 8192, R, C); const int Rb = Epi::PERM ? ((R & ~31) + perm32(R & 31)) : R;
        voffA[i] = (unsigned)(R * K + C) * 2u; voffB[i] = (unsigned)(Rb * K + C) * 2u; }
    const size_t kstep = (size_t)(BK * 2);
    const size_t hstep = (size_t)HALF * K * 2;
    const size_t tstep = 2 * hstep;
    const unsigned ldsw = (unsigned)wid * 1024u;
    const int aoff = lds_byte(wr * 64 + fr, fq * 8), boff = lds_byte(wc * 32 + fr, fq * 8);
#define PG8_SA(b, h) (((b) * 2 + (h)) * HTB)
#define PG8_SB(b, h) ((4 + (b) * 2 + (h)) * HTB)
#define PG8_STAGE(bufoff, gbase, voff) do { _Pragma("unroll") for (int _i = 0; _i < 2; ++_i) \
        __builtin_amdgcn_global_load_lds((const unsigned*)((const char*)(gbase) + (voff)[_i]), (PG8_LAS unsigned*)(lds + (bufoff) + ldsw + _i * 8192), 16, 0, 0); } while (0)
#define PG8_LDA(dst, b, h) do { _Pragma("unroll") for (int m = 0; m < 4; ++m) _Pragma("unroll") for (int k = 0; k < 2; ++k) dst[m][k] = *(const PG8_LAS bf16x8*)(lds + PG8_SA(b, h) + aoff + m * 2048 + k * 1024); } while (0)
#define PG8_LDB(dst, b, h) do { _Pragma("unroll") for (int n = 0; n < 2; ++n) _Pragma("unroll") for (int k = 0; k < 2; ++k) dst[n][k] = *(const PG8_LAS bf16x8*)(lds + PG8_SB(b, h) + boff + n * 2048 + k * 1024); } while (0)
#define PG8_MMA(ai, bj, At, Bt) do { __builtin_amdgcn_s_setprio(1); _Pragma("unroll") for (int m = 0; m < 4; ++m) _Pragma("unroll") for (int n = 0; n < 2; ++n) _Pragma("unroll") for (int k = 0; k < 2; ++k) \
        acc[ai][bj][m][n] = __builtin_amdgcn_mfma_f32_16x16x32_bf16(Bt[n][k], At[m][k], acc[ai][bj][m][n], 0, 0, 0); __builtin_amdgcn_s_setprio(0); } while (0)
#define PG8_WAIT_V(n) asm volatile("s_waitcnt vmcnt(" #n ")" ::: "memory")
#define PG8_WAIT_L(n) asm volatile("s_waitcnt lgkmcnt(" #n ")" ::: "memory")
#define PG8_BAR __builtin_amdgcn_s_barrier()
#define PG8_SCHED __builtin_amdgcn_sched_barrier(0)
    Unit cur, nxt; int ui = 0;
    if (!S.next(0, cur)) return;
    f32x4 acc[2][2][4][2];
#pragma unroll
    for (int a = 0; a < 2; ++a)
#pragma unroll
        for (int b = 0; b < 2; ++b)
#pragma unroll
            for (int m = 0; m < 4; ++m)
#pragma unroll
                for (int n = 0; n < 2; ++n) acc[a][b][m][n] = (f32x4){0.f, 0.f, 0.f, 0.f};
    bf16x8 At[4][2], B0[2][2], B1[2][2];
    const char* cA = (const char*)g.A + (size_t)cur.pm * tstep; const char* cB = (const char*)g.Bt + (size_t)cur.pn * tstep;
    S.a_ready(cur);
    if constexpr (SP2) {
        PG8_STAGE(PG8_SB(0, 0), cB, voffB); PG8_STAGE(PG8_SB(0, 1), cB + hstep, voffB); PG8_STAGE(PG8_SA(0, 0), cA, voffA); PG8_STAGE(PG8_SA(0, 1), cA + hstep, voffA);
        if (wr == 1) PG8_BAR;
        PG8_WAIT_V(2); PG8_BAR;
        PG8_STAGE(PG8_SB(1, 0), cB + kstep, voffB); PG8_STAGE(PG8_SA(1, 0), cA + kstep, voffA); PG8_STAGE(PG8_SB(1, 1), cB + hstep + kstep, voffB);
        PG8_WAIT_V(6); PG8_BAR;
    } else {
        PG8_STAGE(PG8_SB(0, 0), cB, voffB); PG8_STAGE(PG8_SA(0, 0), cA, voffA); PG8_STAGE(PG8_SB(0, 1), cB + hstep, voffB); PG8_STAGE(PG8_SA(0, 1), cA + hstep, voffA);
        if (wr == 1) PG8_BAR;
        PG8_WAIT_V(4); PG8_BAR;
        PG8_STAGE(PG8_SB(1, 0), cB + kstep, voffB); PG8_STAGE(PG8_SA(1, 0), cA + kstep, voffA); PG8_STAGE(PG8_SB(1, 1), cB + hstep + kstep, voffB);
        PG8_WAIT_V(6); PG8_BAR;
    }
    for (;;) {
        const bool has_next = S.next(ui + 1, nxt);
        const char* nA = has_next ? (const char*)g.A + (size_t)nxt.pm * tstep : cA; const char* nB = has_next ? (const char*)g.Bt + (size_t)nxt.pn * tstep : cB;
        for (int t = 0; t < nt; t += 2) {
            const bool last = (t == nt - 2);
            const char* a1 = cA + (size_t)(t + 1) * kstep;
            const char* a2 = last ? nA : cA + (size_t)(t + 2) * kstep; const char* b2 = last ? nB : cB + (size_t)(t + 2) * kstep;
            const char* a3 = a2 + kstep; const char* b3 = b2 + kstep;
            if (last && has_next) S.a_ready(nxt);
            if constexpr (SP2) {
            PG8_LDB(B0, 0, 0); PG8_LDB(B1, 0, 1); PG8_SCHED; PG8_LDA(At, 0, 0); PG8_STAGE(PG8_SA(1, 1), a1 + hstep, voffA);
            PG8_WAIT_V(8); PG8_WAIT_L(0); PG8_BAR; PG8_MMA(0, 0, At, B0); PG8_MMA(0, 1, At, B1); PG8_BAR; PG8_SCHED;
            PG8_LDA(At, 0, 1); PG8_STAGE(PG8_SB(0, 0), b2, voffB); PG8_STAGE(PG8_SB(0, 1), b2 + hstep, voffB); PG8_STAGE(PG8_SA(0, 0), a2, voffA);
            PG8_WAIT_V(8); PG8_WAIT_L(0); PG8_BAR; PG8_MMA(1, 0, At, B0); PG8_MMA(1, 1, At, B1); PG8_BAR; PG8_SCHED;
            PG8_LDB(B0, 1, 0); PG8_LDB(B1, 1, 1); PG8_SCHED; PG8_LDA(At, 1, 0); PG8_STAGE(PG8_SA(0, 1), a2 + hstep, voffA);
            PG8_WAIT_V(8); PG8_WAIT_L(0); PG8_BAR; PG8_MMA(0, 0, At, B0); PG8_MMA(0, 1, At, B1); PG8_BAR; PG8_SCHED;
            PG8_LDA(At, 1, 1); PG8_STAGE(PG8_SB(1, 0), b3, voffB); PG8_STAGE(PG8_SB(1, 1), b3 + hstep, voffB); PG8_STAGE(PG8_SA(1, 0), a3, voffA);
            PG8_WAIT_V(8); PG8_WAIT_L(0); PG8_BAR; PG8_MMA(1, 0, At, B0); PG8_MMA(1, 1, At, B1); PG8_BAR; PG8_SCHED;
            } else {
            PG8_LDB(B0, 0, 0); PG8_SCHED; PG8_LDA(At, 0, 0); PG8_STAGE(PG8_SA(1, 1), a1 + hstep, voffA);
            PG8_WAIT_L(8); PG8_BAR; PG8_WAIT_L(0); PG8_MMA(0, 0, At, B0); PG8_BAR; PG8_SCHED;
            PG8_LDB(B1, 0, 1); PG8_STAGE(PG8_SB(0, 0), b2, voffB);
            PG8_BAR; PG8_WAIT_L(0); PG8_MMA(0, 1, At, B1); PG8_BAR;
            PG8_LDA(At, 0, 1); PG8_STAGE(PG8_SA(0, 0), a2, voffA);
            PG8_BAR; PG8_WAIT_L(0); PG8_MMA(1, 0, At, B0); PG8_BAR; PG8_SCHED;
            PG8_STAGE(PG8_SB(0, 1), b2 + hstep, voffB);
            PG8_WAIT_V(6); PG8_BAR; PG8_MMA(1, 1, At, B1); PG8_BAR;
            PG8_LDB(B0, 1, 0); PG8_SCHED; PG8_LDA(At, 1, 0); PG8_STAGE(PG8_SA(0, 1), a2 + hstep, voffA);
            PG8_WAIT_L(8); PG8_BAR; PG8_WAIT_L(0); PG8_MMA(0, 0, At, B0); PG8_BAR; PG8_SCHED;
            PG8_LDB(B1, 1, 1); PG8_STAGE(PG8_SB(1, 0), b3, voffB);
            PG8_BAR; PG8_WAIT_L(0); PG8_MMA(0, 1, At, B1); PG8_BAR;
            PG8_LDA(At, 1, 1); PG8_STAGE(PG8_SA(1, 0), a3, voffA);
            PG8_BAR; PG8_WAIT_L(0); PG8_MMA(1, 0, At, B0); PG8_BAR; PG8_SCHED;
            PG8_STAGE(PG8_SB(1, 1), b3 + hstep, voffB);
            PG8_WAIT_V(6); PG8_BAR; PG8_MMA(1, 1, At, B1); PG8_BAR;
            }
        }
        if constexpr (ALIGN_EPI) { if (wr == 0) PG8_BAR; }
        if constexpr (!Epi::AFTER_DRAIN) { E(acc, cur, wr, wc, fr, fq); S.done(cur); }
        if (!has_next) break;
#pragma unroll
        for (int a = 0; a < 2; ++a)
#pragma unroll
            for (int b = 0; b < 2; ++b)
#pragma unroll
                for (int m = 0; m < 4; ++m)
#pragma unroll
                    for (int n = 0; n < 2; ++n) acc[a][b][m][n] = (f32x4){0.f, 0.f, 0.f, 0.f};
        cur = nxt; cA = nA; cB = nB; ++ui;
        if constexpr (ALIGN_EPI) { if (wr == 1) PG8_BAR; }
    }
    PG8_WAIT_V(0);
    if constexpr (!ALIGN_EPI) { if (wr == 0) PG8_BAR; }
    PG8_BAR;
    if constexpr (Epi::AFTER_DRAIN) { E.fused(acc, cur, wr, wc, fr, fq, lds, wid, lane); S.done(cur); }
#undef PG8_SA
#undef PG8_SB
#undef PG8_STAGE
#undef PG8_LDA
#undef PG8_LDB
#undef PG8_MMA
#undef PG8_WAIT_V
#undef PG8_WAIT_L
#undef PG8_BAR
#undef PG8_SCHED
}
}

constexpr int NWAVES = 8;
constexpr int SEQ = 2048, D = 1024, M = 16 * SEQ;
constexpr int EA = 2048, NH = 16, CH = 128;
constexpr int FF = 2816;
constexpr float LN_EPS = 1e-6f;
#ifndef MK_ONE_LAUNCH
#define MK_ONE_LAUNCH 1
#endif
constexpr int N_PHASES = 12;

constexpr size_t MiB = 1u << 20;
constexpr size_t WS_AIN = 2 * MiB, WS_AOUT = 10 * MiB, WS_WS = 14 * MiB, WS_GU0 = 15 * MiB, WS_D0 = 26 * MiB, WS_GU1 = 32 * MiB, WS_D1 = 43 * MiB, WS_BIN = 49 * MiB, WS_BOUT = 55 * MiB;
constexpr size_t WS_SS = 58 * MiB, WS_VST = 60 * MiB;
constexpr size_t WS_XB = 64 * MiB;
constexpr size_t WS_U = 128 * MiB, WS_VT = 256 * MiB;
constexpr size_t WS_A = 128 * MiB;
constexpr size_t WS_YC = 304 * MiB, WS_Z = 384 * MiB, WS_BG = 448 * MiB, WS_END = 512 * MiB;
constexpr size_t WS_Y = 384 * MiB;
static_assert(WS_A + (size_t)M * FF * 2 <= WS_YC && WS_YC + (size_t)M * D * 2 <= WS_Z && WS_BG + (size_t)M * D * 2 <= WS_END, "d_ws map");
static_assert(WS_GU0 + (size_t)2 * FF * D * 2 <= WS_D0 && WS_D0 + (size_t)FF * D * 2 <= WS_GU1 && WS_D1 + (size_t)FF * D * 2 <= WS_BIN, "weight map");

constexpr int RING_BYTES = 131072, LDSCTL_OFF = 143360, MISC_OFF = LDSCTL_OFF + 320, LDS_BYTES = 147456;
constexpr size_t WS_CTL = 0, CTL_ZERO_BYTES = 65536;
constexpr int CW_BAR = 4096;

#define GAS __attribute__((address_space(1)))
#define LAS __attribute__((address_space(3)))
typedef unsigned short bf16;
typedef unsigned v4u __attribute__((ext_vector_type(4)));
typedef unsigned v2u __attribute__((ext_vector_type(2)));
typedef float f32x4 __attribute__((ext_vector_type(4)));
typedef float f32x2 __attribute__((ext_vector_type(2)));
typedef short bf16x8 __attribute__((ext_vector_type(8)));
#define LDS_WAIT() asm volatile("s_waitcnt lgkmcnt(0)" ::: "memory")
__device__ __forceinline__ unsigned f2bf(float f) { unsigned u = __builtin_bit_cast(unsigned, f); return (u + 0x7fffu + ((u >> 16) & 1u)) >> 16; }
__device__ __forceinline__ unsigned pk2(float lo, float hi) { return f2bf(lo) | (f2bf(hi) << 16); }
__device__ __forceinline__ float bflo(unsigned w) { return __builtin_bit_cast(float, w << 16); }
__device__ __forceinline__ float bfhi(unsigned w) { return __builtin_bit_cast(float, w & 0xffff0000u); }

typedef GAS unsigned gu32;
#define RLX_AGENT __ATOMIC_RELAXED, __HIP_MEMORY_SCOPE_AGENT
#define XB_TMO      128
#define XB_XCNT(j)  (256  + 64 * (j))
#define XB_XSUB(j)  (1280 + 64 * (j))
#define XB_XGEN(j)  (2304 + 64 * (j))
#define XB_TOP      3328
#define XB_TOPGEN   3392
#define XCD_BAR_WORDS 3456
#define XB_SPIN_CAP (1u << 18)

__device__ __forceinline__ unsigned xb_ld(unsigned* p)              { return __hip_atomic_load(p, __ATOMIC_RELAXED, __HIP_MEMORY_SCOPE_AGENT); }
__device__ __forceinline__ unsigned xb_add(unsigned* p, unsigned v) { return __hip_atomic_fetch_add(p, v, __ATOMIC_RELAXED, __HIP_MEMORY_SCOPE_AGENT); }
__device__ __forceinline__ unsigned xb_xcc_id() { return (unsigned)__builtin_amdgcn_s_getreg((3 << 11) | 20) & 0xFu; }
#define XB_SPIN(cond, bar) do { unsigned _sp = 0; while (cond) { __builtin_amdgcn_s_sleep(1); \
    if ((++_sp & 255u) == 0u) { if (xb_ld(&(bar)[XB_TMO])) break; if (_sp > XB_SPIN_CAP) { atomicAdd(&(bar)[XB_TMO], 1u); break; } } } } while (0)

struct XcdBarrier {
    unsigned* bar; unsigned x;
    volatile LAS unsigned* st;
};

__device__ __forceinline__ XcdBarrier xcd_barrier_post(unsigned* bar, volatile LAS unsigned* st) {
    XcdBarrier b; b.bar = bar; b.x = xb_xcc_id(); b.st = st;
    if (threadIdx.x == 0) (void)xb_add(&bar[XB_XCNT(b.x)], 1u);
    return b;
}
__device__ __forceinline__ void xcd_barrier_complete(unsigned* bar, unsigned x, unsigned& nloc, unsigned& nx) {
    const unsigned G = gridDim.x * gridDim.y * gridDim.z;
    unsigned sum, cnt, mine, sp = 0u;
    for (;;) {
        sum = 0u; cnt = 0u; mine = 0u;
#pragma unroll
        for (unsigned j = 0; j < 16; ++j) { const unsigned c = xb_ld(&bar[XB_XCNT(j)]); sum += c; cnt += (c > 0u) ? 1u : 0u; mine = (j == x) ? c : mine; }
        if (sum == G) break;
        __builtin_amdgcn_s_sleep(1);
        if ((++sp & 255u) == 0u) { if (xb_ld(&bar[XB_TMO])) break; if (sp > XB_SPIN_CAP) { atomicAdd(&bar[XB_TMO], 1u); break; } }
    }
    nloc = mine > 0u ? mine : 1u; nx = cnt > 0u ? cnt : 1u;
}

__device__ __forceinline__ void xcd_barrier(const XcdBarrier& b) {
    asm volatile("s_waitcnt vmcnt(0)" ::: "memory");
    __syncthreads();
    if (threadIdx.x == 0) {
        unsigned* bar = b.bar;
        __builtin_amdgcn_s_waitcnt(0);
        unsigned nloc = b.st[0], nx = b.st[1];
        if (nloc == 0u) { xcd_barrier_complete(bar, b.x, nloc, nx); b.st[0] = nloc; b.st[1] = nx; }
        const unsigned old = xb_add(&bar[XB_XSUB(b.x)], 1u);
        const unsigned gen = old / nloc;
        if (old + 1u == (gen + 1u) * nloc) {
            __builtin_amdgcn_fence(__ATOMIC_RELEASE, "agent");
            asm volatile("s_waitcnt vmcnt(0)" ::: "memory");
            const unsigned og = xb_add(&bar[XB_TOP], 1u);
            const unsigned tg = og / nx;
            if (og + 1u == (tg + 1u) * nx) xb_add(&bar[XB_TOPGEN], 1u);
            else XB_SPIN(xb_ld(&bar[XB_TOPGEN]) == tg, bar);
            __builtin_amdgcn_fence(__ATOMIC_ACQUIRE, "agent");
            xb_add(&bar[XB_XGEN(b.x)], 1u);
            asm volatile("s_waitcnt vmcnt(0)" ::: "memory");
        } else {
            XB_SPIN(xb_ld(&bar[XB_XGEN(b.x)]) == gen, bar);
            __builtin_amdgcn_fence(__ATOMIC_ACQUIRE, "agent");
            asm volatile("s_waitcnt vmcnt(0)" ::: "memory");
        }
    }
    __syncthreads();
}

struct Frame {
    LAS unsigned char* lds;
    int tid, lane, wave, vcu, G;
    const float *x, *mix_norm, *ffn_norm, *a_w_in, *a_v_gain, *a_v_bias, *a_w_s, *a_b_s, *a_w_out, *b_w_in, *b_conv_w, *b_w_out, *w_gate, *w_up, *w_down, *final_norm;
    float* out; unsigned char* ws;
};

__device__ __forceinline__ float wave_sum(float v) {
#pragma unroll
    for (int o = 1; o < 64; o <<= 1) v += __shfl_xor(v, o);
    return v;
}
template <int MODE> __device__ __forceinline__ void p0_transpose_item(const float* W, int K, int N, bf16* WT, int row_off, const float* gain, LAS float* scr, int item, int lane) {
    const int nblk = N / 32, kb = item / nblk, nb = item % nblk, k0 = 64 * kb, n0 = 32 * nb;
    const int kr = lane >> 3, n4 = lane & 7;
    f32x4 wv[8];
#pragma unroll
    for (int i = 0; i < 8; ++i) wv[i] = *(const GAS f32x4*)(W + (size_t)(k0 + 8 * i + kr) * N + n0 + 4 * n4);
#pragma unroll
    for (int i = 0; i < 8; ++i) { const int kk = 8 * i + kr; f32x4 w = wv[i]; if (gain) w = w * gain[k0 + kk];
        LAS float* d = scr + kk * 33 + 4 * n4; d[0] = w[0]; d[1] = w[1]; d[2] = w[2]; d[3] = w[3]; }
    LDS_WAIT(); asm volatile("" ::: "memory");
    const int c = lane & 7;
    const int rbase = (MODE == 0) ? (row_off + n0) : (MODE == 1) ? (row_off + 256 * (n0 / 128) + (n0 % 128))
        : ((n0 < 1024) ? (2048 + n0) : (256 * ((n0 & 1023) / 128) + ((n0 & 1023) % 128) + (n0 >= 2048 ? 128 : 0)));
#pragma unroll
    for (int j = 0; j < 4; ++j) { const int n = (lane >> 3) + 8 * j; const LAS float* s = scr + (8 * c) * 33 + n;
        v4u o; o.x = pk2(s[0 * 33], s[1 * 33]); o.y = pk2(s[2 * 33], s[3 * 33]); o.z = pk2(s[4 * 33], s[5 * 33]); o.w = pk2(s[6 * 33], s[7 * 33]);
        *(GAS v4u*)(WT + (size_t)(rbase + n) * K + k0 + 8 * c) = o; }
    LDS_WAIT(); asm volatile("" ::: "memory");
}
__device__ __forceinline__ void p0_prologue(Frame& F) {
    LAS float* scr = (LAS float*)(F.lds + F.wave * 16384);
    const int gw = F.vcu * NWAVES + F.wave, NGW = F.G * NWAVES;
    unsigned char* ws = F.ws;
    constexpr int I_AIN = (D / 64) * (2 * EA / 32), I_AOUT = (EA / 64) * (D / 32), I_G = (D / 64) * (FF / 32), I_DN = (FF / 64) * (D / 32), I_BIN = (D / 64) * (D / 32), I_BOUT = (D / 64) * (D / 32);
    constexpr int NITEMS = I_AIN + I_AOUT + 4 * I_G + 2 * I_DN + 3 * I_BIN + I_BOUT;
    for (int it = gw; it < NITEMS; it += NGW) {
        int r = it;
        if (r < I_AIN) { p0_transpose_item<0>(F.a_w_in, D, 2 * EA, (bf16*)(ws + WS_AIN), 0, F.mix_norm, scr, r, F.lane); continue; } r -= I_AIN;
        if (r < I_AOUT) { p0_transpose_item<0>(F.a_w_out, EA, D, (bf16*)(ws + WS_AOUT), 0, nullptr, scr, r, F.lane); continue; } r -= I_AOUT;
        if (r < I_G) { p0_transpose_item<1>(F.w_gate, D, FF, (bf16*)(ws + WS_GU0), 0, F.ffn_norm, scr, r, F.lane); continue; } r -= I_G;
        if (r < I_G) { p0_transpose_item<1>(F.w_up, D, FF, (bf16*)(ws + WS_GU0), 128, F.ffn_norm, scr, r, F.lane); continue; } r -= I_G;
        if (r < I_G) { p0_transpose_item<1>(F.w_gate + (size_t)D * FF, D, FF, (bf16*)(ws + WS_GU1), 0, F.ffn_norm + D, scr, r, F.lane); continue; } r -= I_G;
        if (r < I_G) { p0_transpose_item<1>(F.w_up + (size_t)D * FF, D, FF, (bf16*)(ws + WS_GU1), 128, F.ffn_norm + D, scr, r, F.lane); continue; } r -= I_G;
        if (r < I_DN) { p0_transpose_item<0>(F.w_down, FF, D, (bf16*)(ws + WS_D0), 0, nullptr, scr, r, F.lane); continue; } r -= I_DN;
        if (r < I_DN) { p0_transpose_item<0>(F.w_down + (size_t)FF * D, FF, D, (bf16*)(ws + WS_D1), 0, nullptr, scr, r, F.lane); continue; } r -= I_DN;
        if (r < 3 * I_BIN) { p0_transpose_item<2>(F.b_w_in, D, 3 * D, (bf16*)(ws + WS_BIN), 0, F.mix_norm + D, scr, r, F.lane); continue; } r -= 3 * I_BIN;
        p0_transpose_item<0>(F.b_w_out, D, D, (bf16*)(ws + WS_BOUT), 0, nullptr, scr, r, F.lane);
    }
    { const int gt = (F.vcu * NWAVES + F.wave) * 64 + F.lane, NGT = NGW * 64; bf16* o = (bf16*)(ws + WS_WS);
      for (int i = gt; i < NH * CH * CH / 2; i += NGT) { const int e = 2 * i, t = (e / CH) % CH, s = e % CH; const float a = F.a_w_s[e], b = F.a_w_s[e + 1];
          ((GAS unsigned*)o)[i] = pk2(s <= t ? a : 0.f, (s + 1) <= t ? b : 0.f); } }
    for (int m = gw; m < M; m += NGW) {
        const GAS f32x4* xr = (const GAS f32x4*)(F.x + (size_t)m * D) + 2 * F.lane;
        f32x4 v[4]; float s = 0.f;
#pragma unroll
        for (int j = 0; j < 2; ++j) { v[2 * j] = xr[128 * j]; v[2 * j + 1] = xr[128 * j + 1]; }
#pragma unroll
        for (int j = 0; j < 4; ++j) s += (v[j].x * v[j].x + v[j].y * v[j].y) + (v[j].z * v[j].z + v[j].w * v[j].w);
        const float rstd = 1.f / sqrtf(wave_sum(s) * (1.f / D) + pg8::RMS_EPS);
        GAS v4u* o16 = (GAS v4u*)((bf16*)(ws + WS_XB) + (size_t)m * D) + F.lane;
#pragma unroll
        for (int j = 0; j < 2; ++j) { const f32x4 a = v[2 * j] * rstd, b = v[2 * j + 1] * rstd; o16[64 * j] = (v4u){pk2(a.x, a.y), pk2(a.z, a.w), pk2(b.x, b.y), pk2(b.z, b.w)}; }
    }
}

constexpr int SG_PITCH = 272;
constexpr int SG_W = 0, SG_V = 128 * SG_PITCH, SG_ST = 2 * 128 * SG_PITCH;
__device__ __forceinline__ void sgu_phase(Frame& F) {
    LAS unsigned char* lds = F.lds;
    const int tid = F.tid, lane = F.lane, w = F.wave, fr = lane & 15, fq = lane >> 4;
    const bf16* U = (const bf16*)(F.ws + WS_U); bf16* Y = (bf16*)(F.ws + WS_Y); const bf16* VT = (const bf16*)(F.ws + WS_VT); const bf16* WSB = (const bf16*)(F.ws + WS_WS);
    const f32x2* vst = (const f32x2*)(F.ws + WS_VST);
    const int cs = tid & 15, r0 = tid >> 4;
    const int t = 16 * w + fr;
    for (int chunk = F.vcu; chunk < M / CH; chunk += F.G) {
        const int t0 = chunk * CH;
        __syncthreads();
        if (tid < CH) { float s = 0.f, q = 0.f;
#pragma unroll
            for (int i = 0; i < 16; ++i) { const f32x2 a = vst[(size_t)i * M + t0 + tid]; s += a.x; q += a.y; }
            const float mean = s * (1.f / EA); const float var = q * (1.f / EA) - mean * mean; const float rstd = 1.f / sqrtf(var + LN_EPS);
            ((LAS f32x2*)(lds + SG_ST))[tid] = (f32x2){rstd, -mean * rstd}; }
#define SG_BAR() do { asm volatile("s_waitcnt lgkmcnt(0)" ::: "memory"); __builtin_amdgcn_s_barrier(); asm volatile("" ::: "memory"); } while (0)
        v4u wreg[4], vreg[4], ureg[4]; float gn[4], bi[4];
#define SG_LOAD(h_) do { const int hh = (h_); \
            _Pragma("unroll") for (int i = 0; i < 4; ++i) { const int r = r0 + 32 * i; const int c = hh * CH + r; \
                wreg[i] = *(const GAS v4u*)(WSB + (size_t)hh * CH * CH + r * CH + cs * 8); \
                vreg[i] = *(const GAS v4u*)(VT + ((size_t)chunk * EA + c) * CH + cs * 8); gn[i] = F.a_v_gain[c]; bi[i] = F.a_v_bias[c]; } \
            _Pragma("unroll") for (int g = 0; g < 4; ++g) ureg[g] = *(const GAS v4u*)(U + (size_t)(t0 + t) * EA + hh * CH + 8 * fq + 32 * g); } while (0)
        SG_LOAD(0);
        __syncthreads();
        f32x2 st[8];
#pragma unroll
        for (int k = 0; k < 8; ++k) st[k] = ((const LAS f32x2*)(lds + SG_ST))[cs * 8 + k];
        for (int h = 0; h < NH; ++h) {
            if (h) SG_BAR();
#pragma unroll
            for (int i = 0; i < 4; ++i) { const int r = r0 + 32 * i;
                *(LAS v4u*)(lds + SG_W + r * SG_PITCH + cs * 16) = wreg[i];
                const float g = gn[i], b = bi[i]; const unsigned wd[4] = {vreg[i].x, vreg[i].y, vreg[i].z, vreg[i].w}; float o[8];
#pragma unroll
                for (int k = 0; k < 4; ++k) { o[2 * k] = (bflo(wd[k]) * st[2 * k].x + st[2 * k].y) * g + b; o[2 * k + 1] = (bfhi(wd[k]) * st[2 * k + 1].x + st[2 * k + 1].y) * g + b; }
                v4u ov; ov.x = pk2(o[0], o[1]); ov.y = pk2(o[2], o[3]); ov.z = pk2(o[4], o[5]); ov.w = pk2(o[6], o[7]);
                *(LAS v4u*)(lds + SG_V + r * SG_PITCH + cs * 16) = ov; }
            v4u ucur[4];
#pragma unroll
            for (int g = 0; g < 4; ++g) ucur[g] = ureg[g];
            __syncthreads();
            if (h + 1 < NH) SG_LOAD(h + 1);
            f32x4 acc[4][2];
#pragma unroll
            for (int g = 0; g < 4; ++g) { acc[g][0] = (f32x4){0.f, 0.f, 0.f, 0.f}; acc[g][1] = (f32x4){0.f, 0.f, 0.f, 0.f}; }
            const int kmax = (16 * w + 15) / 32;
            for (int kk = 0; kk <= kmax; ++kk) {
                const bf16x8 a = *(const LAS bf16x8*)(lds + SG_W + t * SG_PITCH + kk * 64 + fq * 16);
#pragma unroll
                for (int g = 0; g < 4; ++g)
#pragma unroll
                    for (int n = 0; n < 2; ++n) { const int crow = 32 * g + 8 * (fr >> 2) + 4 * n + (fr & 3);
                        const bf16x8 b = *(const LAS bf16x8*)(lds + SG_V + crow * SG_PITCH + kk * 64 + fq * 16);
                        acc[g][n] = __builtin_amdgcn_mfma_f32_16x16x32_bf16(b, a, acc[g][n], 0, 0, 0); }
            }
            const float bs = F.a_b_s[h * CH + t];
            bf16* yp = Y + (size_t)(t0 + t) * EA + h * CH + 8 * fq;
#pragma unroll
            for (int g = 0; g < 4; ++g) { const v4u uv = ucur[g];
                v4u ov; ov.x = pk2(bflo(uv.x) * (acc[g][0][0] + bs), bfhi(uv.x) * (acc[g][0][1] + bs)); ov.y = pk2(bflo(uv.y) * (acc[g][0][2] + bs), bfhi(uv.y) * (acc[g][0][3] + bs));
                ov.z = pk2(bflo(uv.z) * (acc[g][1][0] + bs), bfhi(uv.z) * (acc[g][1][1] + bs)); ov.w = pk2(bflo(uv.w) * (acc[g][1][2] + bs), bfhi(uv.w) * (acc[g][1][3] + bs));
                *(GAS v4u*)(yp + 32 * g) = ov; }
        }
#undef SG_LOAD
#undef SG_BAR
    }
}

__device__ __forceinline__ void conv_phase(Frame& F) {
    const bf16* Z = (const bf16*)(F.ws + WS_Z); const bf16* BG = (const bf16*)(F.ws + WS_BG); bf16* YC = (bf16*)(F.ws + WS_YC);
    const int gt = F.vcu * 512 + F.tid, NGT = F.G * 512;
    for (int i = gt; i < M * (D / 8); i += NGT) {
        const int row = i >> 7, c8 = (i & 127) * 8, tpos = row & (SEQ - 1);
        const size_t off = (size_t)row * D + c8;
        const v4u z2 = *(const GAS v4u*)(Z + off), bg = *(const GAS v4u*)(BG + off);
        v4u z1 = (v4u){0u, 0u, 0u, 0u}, z0 = (v4u){0u, 0u, 0u, 0u};
        if (tpos >= 1) z1 = *(const GAS v4u*)(Z + off - D);
        if (tpos >= 2) z0 = *(const GAS v4u*)(Z + off - 2 * D);
        const f32x4 w0a = *(const GAS f32x4*)(F.b_conv_w + c8), w0b = *(const GAS f32x4*)(F.b_conv_w + c8 + 4);
        const f32x4 w1a = *(const GAS f32x4*)(F.b_conv_w + D + c8), w1b = *(const GAS f32x4*)(F.b_conv_w + D + c8 + 4);
        const f32x4 w2a = *(const GAS f32x4*)(F.b_conv_w + 2 * D + c8), w2b = *(const GAS f32x4*)(F.b_conv_w + 2 * D + c8 + 4);
        const unsigned a0[4] = {z0.x, z0.y, z0.z, z0.w}, a1[4] = {z1.x, z1.y, z1.z, z1.w}, a2[4] = {z2.x, z2.y, z2.z, z2.w}, ab[4] = {bg.x, bg.y, bg.z, bg.w};
        const float w0[8] = {w0a[0], w0a[1], w0a[2], w0a[3], w0b[0], w0b[1], w0b[2], w0b[3]}, w1[8] = {w1a[0], w1a[1], w1a[2], w1a[3], w1b[0], w1b[1], w1b[2], w1b[3]}, w2[8] = {w2a[0], w2a[1], w2a[2], w2a[3], w2b[0], w2b[1], w2b[2], w2b[3]};
        unsigned o[4];
#pragma unroll
        for (int k = 0; k < 4; ++k) {
            const float lo = bflo(ab[k]) * (bflo(a0[k]) * w0[2 * k] + bflo(a1[k]) * w1[2 * k] + bflo(a2[k]) * w2[2 * k]);
            const float hi = bfhi(ab[k]) * (bfhi(a0[k]) * w0[2 * k + 1] + bfhi(a1[k]) * w1[2 * k + 1] + bfhi(a2[k]) * w2[2 * k + 1]);
            o[k] = pk2(lo, hi); }
        *(GAS v4u*)(YC + off) = (v4u){o[0], o[1], o[2], o[3]};
    }
}
__device__ __forceinline__ void final_norm_phase(Frame& F) {
    const int gw = F.vcu * NWAVES + F.wave, NGW = F.G * NWAVES; const float* ss = (const float*)(F.ws + WS_SS); const bf16* XBp = (const bf16*)(F.ws + WS_XB);
    const GAS f32x4* gr = (const GAS f32x4*)F.final_norm + 2 * F.lane;
    for (int m = gw; m < M; m += NGW) {
        float s = (F.lane < 16) ? ss[(size_t)F.lane * M + m] : 0.f;
        s = wave_sum(s);
        const float rstd = 1.f / sqrtf(s * (1.f / D) + pg8::RMS_EPS);
        const GAS v4u* xr = (const GAS v4u*)(XBp + (size_t)m * D) + F.lane; GAS f32x4* orow = (GAS f32x4*)(F.out + (size_t)m * D) + 2 * F.lane;
#pragma unroll
        for (int j = 0; j < 2; ++j) { const v4u v = xr[64 * j]; const f32x4 g0 = gr[128 * j], g1 = gr[128 * j + 1];
            orow[128 * j] = (f32x4){bflo(v.x), bfhi(v.x), bflo(v.y), bfhi(v.y)} * rstd * g0;
            orow[128 * j + 1] = (f32x4){bflo(v.z), bfhi(v.z), bflo(v.w), bfhi(v.w)} * rstd * g1; }
    }
}

constexpr int RSTD_OFF = RING_BYTES;
__device__ __forceinline__ const LAS float* fill_rstd_table(Frame& F, int pm0) {
    if (F.G != 256) return nullptr;
    const float* ss = (const float*)(F.ws + WS_SS);
    const int slot = F.tid >> 8, r = F.tid & 255, row = (((pm0 & ~8) | (slot << 3)) << 8) + r;
    float s = 0.f;
#pragma unroll
    for (int j = 0; j < 16; ++j) s += ss[(size_t)j * M + row];
    ((LAS float*)(F.lds + RSTD_OFF))[F.tid] = __builtin_amdgcn_rsqf(s * (1.0f / D) + pg8::RMS_EPS);
    __syncthreads();
    return (const LAS float*)(F.lds + RSTD_OFF);
}

struct Args { const float* in[16]; float* out; unsigned char* ws; int ph_lo, ph_hi, rep_mask, pad; };
__global__ void __launch_bounds__(NWAVES * 64, 2) hybrid_fwd(Args args) {
    extern __shared__ __attribute__((aligned(16))) unsigned char lds[];
    cg::grid_group grid = cg::this_grid();
    Frame F;
    F.lds = (LAS unsigned char*)lds;
    F.tid = threadIdx.x; F.lane = F.tid & 63; F.wave = __builtin_amdgcn_readfirstlane(F.tid >> 6);
    F.G = gridDim.x; { const int bx = blockIdx.x; F.vcu = (F.G % 8 == 0) ? (bx % 8) * (F.G / 8) + bx / 8 : bx; }
    F.x = args.in[0]; F.mix_norm = args.in[1]; F.ffn_norm = args.in[2]; F.a_w_in = args.in[3]; F.a_v_gain = args.in[4]; F.a_v_bias = args.in[5]; F.a_w_s = args.in[6]; F.a_b_s = args.in[7];
    F.a_w_out = args.in[8]; F.b_w_in = args.in[9]; F.b_conv_w = args.in[10]; F.b_w_out = args.in[11]; F.w_gate = args.in[12]; F.w_up = args.in[13]; F.w_down = args.in[14]; F.final_norm = args.in[15];
    F.out = args.out; F.ws = args.ws;
    unsigned char* ws = args.ws;
    for (int u = F.tid; u < (LDS_BYTES - LDSCTL_OFF) / 4; u += NWAVES * 64) ((LAS unsigned*)(F.lds + LDSCTL_OFF))[u] = 0u;
    __syncthreads();
    XcdBarrier bar = xcd_barrier_post((unsigned*)(ws + WS_CTL) + CW_BAR, (volatile LAS unsigned*)(F.lds + MISC_OFF) + 8);
    const int lo = args.ph_lo, hi = args.ph_hi;
    if (lo < 0) grid.sync();
#ifndef REP_MASK
#define REP_MASK 0
#endif
#ifndef EXTRA_SYNCS
#define EXTRA_SYNCS 0
#endif
#define REPS(k) 1
#define IN(k) (lo <= (k) && (k) < hi)
#ifndef PROBE_T
#define PROBE_T 0
#endif
#if PROBE_T
#ifndef PROBE_DIV
#define PROBE_DIV 20ull
#endif
#define STAMP(i) do { if (blockIdx.x == 0 && F.tid == 0) ((volatile LAS unsigned long long*)(F.lds + MISC_OFF + 128))[(i)] = __builtin_amdgcn_s_memrealtime(); } while (0)
#else
#define STAMP(i) do { } while (0)
#endif
#define SEAM(k) do { if (IN(k) && IN((k) + 1)) xcd_barrier(bar); STAMP((k) + 1); } while (0)
    pg8::bf16_t* XB = (pg8::bf16_t*)(ws + WS_XB); float* SS = (float*)(ws + WS_SS);
    const int c = (int)blockIdx.x;

    STAMP(0);
    if (IN(0)) { p0_prologue(F); __syncthreads(); } SEAM(0);

    if (IN(1)) {
        { pg8::Gemm g{XB, (const pg8::bf16_t*)(ws + WS_AIN), M, EA, D}; pg8::StaticOrder S; S.init(M, EA, F.G, c);
          pg8::EpiGelu E{(pg8::bf16_t*)(ws + WS_U), EA};
          pg8::gemm_phase<pg8::EpiGelu, pg8::StaticOrder, true, true>(F.lds, g, S, E); }
        { pg8::Gemm g{(const pg8::bf16_t*)(ws + WS_AIN) + (size_t)EA * D, XB, EA, M, D}; pg8::StaticOrder S; S.init(EA, M, F.G, c);
          pg8::EpiGeluT E{(pg8::bf16_t*)(ws + WS_VT), (pg8::f32x2*)(ws + WS_VST)};
          pg8::gemm_phase<pg8::EpiGeluT, pg8::StaticOrder, true, true>(F.lds, g, S, E); }
    } SEAM(1);

    if (IN(2)) { sgu_phase(F); } SEAM(2);

    if (IN(3)) {
        pg8::Gemm g{(const pg8::bf16_t*)(ws + WS_Y), (const pg8::bf16_t*)(ws + WS_AOUT), M, D, EA}; pg8::StaticOrder S; S.init(M, D, F.G, c);
        pg8::EpiRes<true> E{F.x, XB, SS};
        pg8::gemm_phase<pg8::EpiRes<true>, pg8::StaticOrder, true, true>(F.lds, g, S, E);
    } SEAM(3);

    if (IN(4)) {
        pg8::Gemm g{XB, (const pg8::bf16_t*)(ws + WS_GU0), M, 2 * FF, D}; pg8::StaticOrder S; S.init(M, 2 * FF, F.G, c);
        pg8::Unit u0; S.next(0, u0); pg8::EpiSwiglu E{(pg8::bf16_t*)(ws + WS_A), FF, SS, fill_rstd_table(F, u0.pm)};
        pg8::gemm_phase<pg8::EpiSwiglu, pg8::StaticOrder, true, true>(F.lds, g, S, E);
    } SEAM(4);

    if (IN(5)) {
        pg8::Gemm g{(const pg8::bf16_t*)(ws + WS_A), (const pg8::bf16_t*)(ws + WS_D0), M, D, FF}; pg8::StaticOrder S; S.init(M, D, F.G, c);
        pg8::EpiRes<false> E{nullptr, XB, SS};
        pg8::gemm_phase<pg8::EpiRes<false>, pg8::StaticOrder, true, true>(F.lds, g, S, E);
    } SEAM(5);

    if (IN(6)) {
        pg8::Gemm g{XB, (const pg8::bf16_t*)(ws + WS_BIN), M, 3 * D, D}; pg8::StaticOrder S; S.init(M, 3 * D, F.G, c);
        pg8::Unit u0; S.next(0, u0); pg8::EpiConvIn E{(pg8::bf16_t*)(ws + WS_Z), (pg8::bf16_t*)(ws + WS_BG), SS, fill_rstd_table(F, u0.pm)};
        pg8::gemm_phase<pg8::EpiConvIn, pg8::StaticOrder, true, true>(F.lds, g, S, E);
    } SEAM(6);

    if (IN(7)) { conv_phase(F); } SEAM(7);

    if (IN(8)) {
        pg8::Gemm g{(const pg8::bf16_t*)(ws + WS_YC), (const pg8::bf16_t*)(ws + WS_BOUT), M, D, D}; pg8::StaticOrder S; S.init(M, D, F.G, c);
        pg8::EpiRes<false> E{nullptr, XB, SS};
        pg8::gemm_phase<pg8::EpiRes<false>, pg8::StaticOrder, true, true>(F.lds, g, S, E);
    } SEAM(8);

    if (IN(9)) {
        pg8::Gemm g{XB, (const pg8::bf16_t*)(ws + WS_GU1), M, 2 * FF, D}; pg8::StaticOrder S; S.init(M, 2 * FF, F.G, c);
        pg8::Unit u0; S.next(0, u0); pg8::EpiSwiglu E{(pg8::bf16_t*)(ws + WS_A), FF, SS, fill_rstd_table(F, u0.pm)};
        pg8::gemm_phase<pg8::EpiSwiglu, pg8::StaticOrder, true, true>(F.lds, g, S, E);
    } SEAM(9);

    if (IN(10)) {
        pg8::Gemm g{(const pg8::bf16_t*)(ws + WS_A), (const pg8::bf16_t*)(ws + WS_D1), M, D, FF}; pg8::StaticOrder S; S.init(M, D, F.G, c);
        pg8::EpiRes<false> E{nullptr, XB, SS};
        pg8::gemm_phase<pg8::EpiRes<false>, pg8::StaticOrder, true, true>(F.lds, g, S, E);
    } SEAM(10);

    for (int i = 0; i < EXTRA_SYNCS; ++i) xcd_barrier(bar);
    if (IN(11)) { final_norm_phase(F); }
#if PROBE_T
    xcd_barrier(bar); STAMP(12);
    if (blockIdx.x == 0) {
        __syncthreads();
        volatile LAS unsigned long long* stp = (volatile LAS unsigned long long*)(F.lds + MISC_OFF + 128);
        const unsigned long long T = stp[PROBE_HI] - stp[PROBE_LO]; int K = (int)(T / PROBE_DIV); if (K > 4096) K = 4096;
        for (int j = F.tid; j < K; j += NWAVES * 64) F.out[(size_t)j * 8191] += 0.0625f;
    }
#endif
#undef IN
#undef SEAM
}

extern "C" void kernel_launch(void* const* d_in, const int* in_sizes, int n_in, void* d_out, int out_size, void* d_ws, size_t ws_size, hipStream_t stream) {
    static int grid = 0;
    if (grid == 0) {
        if (n_in != 16 || in_sizes[0] != M * D || out_size != M * D || ws_size < WS_END) { fprintf(stderr, "kernel_launch: unexpected shapes (n_in %d, in0 %d, out %d, ws %zu); nothing launched\n", n_in, n_in > 0 ? in_sizes[0] : -1, out_size, ws_size); grid = -1; return; }
        int dev = 0, cus = 0, per_cu = 0;
        if (hipGetDevice(&dev) != hipSuccess || hipDeviceGetAttribute(&cus, hipDeviceAttributeMultiprocessorCount, dev) != hipSuccess) { grid = -1; return; }
        if (hipFuncSetAttribute((const void*)hybrid_fwd, hipFuncAttributeMaxDynamicSharedMemorySize, LDS_BYTES) != hipSuccess) { fprintf(stderr, "kernel_launch: hipFuncSetAttribute failed\n"); grid = -1; return; }
        if (hipOccupancyMaxActiveBlocksPerMultiprocessor(&per_cu, (const void*)hybrid_fwd, NWAVES * 64, LDS_BYTES) != hipSuccess || per_cu < 1) { fprintf(stderr, "kernel_launch: occupancy query says %d blocks per CU\n", per_cu); per_cu = 1; }
        (void)hipGetLastError();
        grid = cus;
    }
    if (grid < 0) return;
    if (hipMemsetAsync((char*)d_ws + WS_CTL, 0, CTL_ZERO_BYTES, stream) != hipSuccess) { fprintf(stderr, "kernel_launch: memset failed\n"); return; }
    Args a{};
    for (int i = 0; i < 16; ++i) a.in[i] = (const float*)d_in[i];
    a.out = (float*)d_out; a.ws = (unsigned char*)d_ws; a.rep_mask = REP_MASK;
#if MK_ONE_LAUNCH
    a.ph_lo = 0; a.ph_hi = N_PHASES;
    void* kargs[] = {&a};
    const hipError_t e = hipLaunchCooperativeKernel((const void*)hybrid_fwd, dim3(grid), dim3(NWAVES * 64), kargs, LDS_BYTES, stream);
    if (e != hipSuccess) fprintf(stderr, "kernel_launch: cooperative launch failed: %s (grid %d)\n", hipGetErrorString(e), grid);
#else
    for (int p = 0; p < N_PHASES; ++p) { a.ph_lo = p; a.ph_hi = p + 1; hipLaunchKernelGGL(hybrid_fwd, dim3(grid), dim3(NWAVES * 64), LDS_BYTES, stream, a); }
#endif
}
```

```cpp
#include <hip/hip_runtime.h>
#include <hip/hip_cooperative_groups.h>
#include <cstdio>
#include <cstdint>
namespace cg = cooperative_groups;

namespace pg8 {
#define PG8_LAS __attribute__((address_space(3)))
typedef unsigned short bf16_t;
typedef short bf16x8 __attribute__((ext_vector_type(8)));
typedef float f32x4 __attribute__((ext_vector_type(4)));
typedef unsigned u32x4 __attribute__((ext_vector_type(4)));
constexpr int BM = 256, BK = 64, HALF = 128, HTB = HALF * BK * 2  , STAGE_BYTES = 8 * HTB, NXCD = 8, WGM = 8;

__host__ __device__ __forceinline__ int lds_byte(int r, int c) { const int st = (r >> 4) * 2 + (c >> 5), rr = r & 15, cc = c & 31, ob = rr * 64 + cc * 2; return st * 1024 + (ob ^ (((ob >> 9) & 1) << 5)); }
__host__ __device__ __forceinline__ void stage_rc(int b, int& R, int& C) { const int st = b / 1024, sb = b % 1024, swz = sb ^ (((sb >> 9) & 1) << 5); R = (st >> 1) * 16 + swz / 64; C = (st & 1) * 32 + (swz % 64) / 2; }
__host__ __device__ __forceinline__ int perm32(int rho) { const int n = rho >> 4, i = rho & 15; return 8 * (i >> 2) + 4 * n + (i & 3); }

struct Unit { int pm, pn; };
struct Gemm { const bf16_t* A; const bf16_t* Bt; int M, N, K; };

struct StaticOrder {
    int nM, nN, nwg, G, c;
    __host__ __device__ void init(int M, int N, int G_, int c_) { nM = M / BM; nN = N / BM; nwg = nM * nN; G = G_; c = c_; }
    __host__ __device__ bool next(int i, Unit& u) const {
        const long L = (long)i * G + c; if (L >= nwg) return false;
        int wgid = (int)L; { const int q = nwg / NXCD, r = nwg % NXCD, xcd = wgid % NXCD, off = wgid / NXCD; wgid = (xcd < r ? xcd * (q + 1) : r * (q + 1) + (xcd - r) * q) + off; }
        const int nig = WGM * nN, gid = wgid / nig, fm = gid * WGM, gsz = (nM - fm) < WGM ? (nM - fm) : WGM;
        u.pm = fm + ((wgid % nig) % gsz); u.pn = (wgid % nig) / gsz; return true;
    }
    __device__ __forceinline__ void a_ready(const Unit&) const {}
    __device__ __forceinline__ void done(const Unit&) const {}
};

__device__ __forceinline__ unsigned cvt_pk_bf16(float lo, float hi) { unsigned r; asm volatile("v_cvt_pk_bf16_f32 %0, %1, %2" : "=v"(r) : "v"(lo), "v"(hi)); return r; }
typedef float f32x2 __attribute__((ext_vector_type(2)));
typedef unsigned u32x2 __attribute__((ext_vector_type(2)));
constexpr float RMS_EPS = 1e-6f;
constexpr int SS_M = 32768;
__device__ __forceinline__ f32x2 gelu2(f32x2 v) {
    const f32x2 w = v * (v * v * 0.044715f + 1.0f) * (-2.0f * 0.7978845608028654f * 1.4426950408889634f);
    f32x2 e; e.x = __builtin_amdgcn_exp2f(w.x); e.y = __builtin_amdgcn_exp2f(w.y);
    e = e + 1.0f;
    f32x2 r; r.x = __builtin_amdgcn_rcpf(e.x); r.y = __builtin_amdgcn_rcpf(e.y);
    return v * r;
}
__device__ __forceinline__ f32x4 gelu4(f32x4 v) { const f32x2 a = gelu2((f32x2){v[0], v[1]}), b = gelu2((f32x2){v[2], v[3]}); return (f32x4){a.x, a.y, b.x, b.y}; }
__device__ __forceinline__ f32x2 swiglu2(f32x2 g, f32x2 u, float r) {
    g = g * r; u = u * r;
    const f32x2 w = g * (-1.4426950408889634f);
    f32x2 e; e.x = __builtin_amdgcn_exp2f(w.x); e.y = __builtin_amdgcn_exp2f(w.y);
    e = e + 1.0f;
    f32x2 q; q.x = __builtin_amdgcn_rcpf(e.x); q.y = __builtin_amdgcn_rcpf(e.y);
    return (g * u) * q;
}
__device__ __forceinline__ f32x4 swiglu4(f32x4 g, f32x4 u, float r) { const f32x2 a = swiglu2((f32x2){g[0], g[1]}, (f32x2){u[0], u[1]}, r), b = swiglu2((f32x2){g[2], g[3]}, (f32x2){u[2], u[3]}, r); return (f32x4){a.x, a.y, b.x, b.y}; }
__device__ __forceinline__ u32x4 pack8(const f32x4 a, const f32x4 b) {
    u32x4 w; w.x = cvt_pk_bf16(a[0], a[1]); w.y = cvt_pk_bf16(a[2], a[3]); w.z = cvt_pk_bf16(b[0], b[1]); w.w = cvt_pk_bf16(b[2], b[3]); return w;
}
__device__ __forceinline__ float row_rstd(const float* ss, int row, int fq) {
    const f32x4 p = *(const f32x4*)(ss + (size_t)row * 16 + fq * 4);
    float s = (p[0] + p[1]) + (p[2] + p[3]);
    s += __shfl_xor(s, 16); s += __shfl_xor(s, 32);
    return 1.0f / sqrtf(s * (1.0f / 1024.0f) + RMS_EPS);
}

struct EpiGelu {
    static constexpr bool PERM = true, AFTER_DRAIN = false, STAMPED = false;
    bf16_t* O; int ldc;
    __device__ __forceinline__ void operator()(const f32x4 (&acc)[2][2][4][2], const Unit& u, int wr, int wc, int fr, int fq) const {
        const int row0 = u.pm * BM + wr * 64 + fr, col0 = u.pn * BM + wc * 32 + 8 * fq;
#pragma unroll
        for (int ai = 0; ai < 2; ++ai)
#pragma unroll
            for (int m = 0; m < 4; ++m) { bf16_t* rowp = O + (size_t)(row0 + ai * HALF + m * 16) * ldc + col0;
#pragma unroll
                for (int bj = 0; bj < 2; ++bj) { f32x4 v0 = acc[ai][bj][m][0], v1 = acc[ai][bj][m][1];
                    v0 = gelu4(v0); v1 = gelu4(v1);
                    *(u32x4*)(rowp + bj * HALF) = pack8(v0, v1); } }
    }
};
struct EpiGeluT {
    static constexpr bool PERM = true, AFTER_DRAIN = false, STAMPED = false;
    bf16_t* O; f32x2* vst;
    __device__ __forceinline__ void operator()(const f32x4 (&acc)[2][2][4][2], const Unit& u, int wr, int wc, int fr, int fq) const {
        const int row0 = u.pm * BM + wr * 64 + fr, col0 = u.pn * BM + wc * 32 + 8 * fq;
        float v[32];
#pragma unroll
        for (int i = 0; i < 32; ++i) v[i] = 0.f;
#pragma unroll
        for (int ai = 0; ai < 2; ++ai)
#pragma unroll
            for (int m = 0; m < 4; ++m) { bf16_t* rowp = O + ((size_t)(2 * u.pn) * 2048 + (row0 + ai * HALF + m * 16)) * 128 + wc * 32 + 8 * fq;
#pragma unroll
                for (int bj = 0; bj < 2; ++bj) { f32x4 v0 = acc[ai][bj][m][0], v1 = acc[ai][bj][m][1];
                    v0 = gelu4(v0); v1 = gelu4(v1);
#pragma unroll
                    for (int e = 0; e < 4; ++e) {
                        v[2 * (8 * bj + e)] += v0[e]; v[2 * (8 * bj + e) + 1] += v0[e] * v0[e];
                        v[2 * (8 * bj + 4 + e)] += v1[e]; v[2 * (8 * bj + 4 + e) + 1] += v1[e] * v1[e]; }
                    *(u32x4*)(rowp + (size_t)bj * 2048 * 128) = pack8(v0, v1); } }
#define PG8_XSTEP(H, MASK) { const bool bit = (fr & (MASK)) != 0; _Pragma("unroll") for (int i = 0; i < (H); ++i) { const float send = bit ? v[i] : v[i + (H)]; const float keep = bit ? v[i + (H)] : v[i]; v[i] = keep + __shfl_xor(send, (MASK)); } }
        PG8_XSTEP(16, 8) PG8_XSTEP(8, 4) PG8_XSTEP(4, 2) PG8_XSTEP(2, 1)
#undef PG8_XSTEP
        const int token = u.pn * BM + (fr >> 3) * HALF + wc * 32 + 8 * fq + (fr & 7);
        vst[(size_t)(u.pm * 2 + wr) * SS_M + token] = (f32x2){v[0], v[1]};
    }
};
struct EpiRes {
    static constexpr bool PERM = true, AFTER_DRAIN = false;
    bf16_t* xb; float* ss; const PG8_LAS float* stab;
    __device__ __forceinline__ void operator()(const f32x4 (&acc)[2][2][4][2], const Unit& u, int wr, int wc, int fr, int fq) const {
        const int row0 = u.pm * BM + wr * 64 + fr, col0 = u.pn * BM + wc * 32 + 8 * fq;
        u32x4 pre[2][4][2];
#pragma unroll
        for (int ai = 0; ai < 2; ++ai)
#pragma unroll
            for (int m = 0; m < 4; ++m) { const size_t off = (size_t)(row0 + ai * HALF + m * 16) * 1024 + col0;
#pragma unroll
                for (int bj = 0; bj < 2; ++bj) pre[ai][m][bj] = *(const u32x4*)(xb + off + bj * HALF); }
        asm volatile("" ::: "memory");
        const PG8_LAS float* st = stab ? stab + ((u.pm >> 3) & 1) * BM + wr * 64 + fr : nullptr;
#pragma unroll
        for (int ai = 0; ai < 2; ++ai)
#pragma unroll
            for (int m = 0; m < 4; ++m) { const int row = row0 + ai * HALF + m * 16; const size_t off = (size_t)row * 1024 + col0; float q = 0.f;
                const float sc = st ? st[ai * HALF + m * 16] : 1.0f;
#pragma unroll
                for (int bj = 0; bj < 2; ++bj) { const u32x4 p = pre[ai][m][bj];
                    const f32x4 b0 = {__builtin_bit_cast(float, p.x << 16), __builtin_bit_cast(float, p.x & 0xffff0000u), __builtin_bit_cast(float, p.y << 16), __builtin_bit_cast(float, p.y & 0xffff0000u)};
                    const f32x4 b1 = {__builtin_bit_cast(float, p.z << 16), __builtin_bit_cast(float, p.z & 0xffff0000u), __builtin_bit_cast(float, p.w << 16), __builtin_bit_cast(float, p.w & 0xffff0000u)};
                    const f32x4 o0 = b0 * sc + acc[ai][bj][m][0], o1 = b1 * sc + acc[ai][bj][m][1];
                    q += (o0[0] * o0[0] + o0[1] * o0[1]) + (o0[2] * o0[2] + o0[3] * o0[3]) + (o1[0] * o1[0] + o1[1] * o1[1]) + (o1[2] * o1[2] + o1[3] * o1[3]);
                    *(u32x4*)(xb + off + bj * HALF) = pack8(o0, o1); }
                q += __shfl_xor(q, 16); q += __shfl_xor(q, 32);
                if (fq == 0) ss[(size_t)(u.pn * 4 + wc) * SS_M + row] = q; }
    }
};
__device__ __forceinline__ void rows_rstd(float (&rs)[2][4], const float* ss, const PG8_LAS float* tab, int pm, int row0, int fq) {
    if (tab) { const PG8_LAS float* t = tab + ((pm >> 3) & 1) * BM + (row0 - pm * BM);
#pragma unroll
        for (int ai = 0; ai < 2; ++ai)
#pragma unroll
            for (int m = 0; m < 4; ++m) rs[ai][m] = t[ai * HALF + m * 16];
        return; }
    f32x4 p[2][4];
#pragma unroll
    for (int ai = 0; ai < 2; ++ai)
#pragma unroll
        for (int m = 0; m < 4; ++m) { const float* q = ss + (size_t)(fq * 4) * SS_M + (row0 + ai * HALF + m * 16); p[ai][m] = (f32x4){q[0], q[SS_M], q[2 * SS_M], q[3 * SS_M]}; }
    asm volatile("" ::: "memory");
#pragma unroll
    for (int ai = 0; ai < 2; ++ai)
#pragma unroll
        for (int m = 0; m < 4; ++m) { float s = (p[ai][m][0] + p[ai][m][1]) + (p[ai][m][2] + p[ai][m][3]); s += __shfl_xor(s, 16); s += __shfl_xor(s, 32);
            rs[ai][m] = __builtin_amdgcn_rsqf(s * (1.0f / 1024.0f) + RMS_EPS); }
}
struct EpiSwiglu {
    static constexpr bool PERM = true, AFTER_DRAIN = false, STAMPED = false;
    bf16_t* O; int ldc; const float* ss; const PG8_LAS float* tab;
    __device__ __forceinline__ void operator()(const f32x4 (&acc)[2][2][4][2], const Unit& u, int wr, int wc, int fr, int fq) const {
        const int row0 = u.pm * BM + wr * 64 + fr, col0 = u.pn * HALF + wc * 32 + 8 * fq;
        float rs[2][4]; rows_rstd(rs, ss, tab, u.pm, row0, fq);
#pragma unroll
        for (int ai = 0; ai < 2; ++ai)
#pragma unroll
            for (int m = 0; m < 4; ++m) { const int row = row0 + ai * HALF + m * 16; const float r = rs[ai][m];
                const f32x4 a0 = swiglu4(acc[ai][0][m][0], acc[ai][1][m][0], r), a1 = swiglu4(acc[ai][0][m][1], acc[ai][1][m][1], r);
                *(u32x4*)(O + (size_t)row * ldc + col0) = pack8(a0, a1); }
    }
};
struct EpiConvIn {
    static constexpr bool PERM = true, AFTER_DRAIN = false, STAMPED = false;
    bf16_t* Z; bf16_t* BG; const float* ss; const PG8_LAS float* tab;
    __device__ __forceinline__ void operator()(const f32x4 (&acc)[2][2][4][2], const Unit& u, int wr, int wc, int fr, int fq) const {
        const int row0 = u.pm * BM + wr * 64 + fr;
        float rs[2][4]; rows_rstd(rs, ss, tab, u.pm, row0, fq);
        if (u.pn < 8) {
            const int col0 = u.pn * HALF + wc * 32 + 8 * fq;
#pragma unroll
            for (int ai = 0; ai < 2; ++ai)
#pragma unroll
                for (int m = 0; m < 4; ++m) { const int row = row0 + ai * HALF + m * 16; const float r2 = rs[ai][m] * rs[ai][m];
                    const f32x4 a0 = acc[ai][0][m][0] * acc[ai][1][m][0] * r2, a1 = acc[ai][0][m][1] * acc[ai][1][m][1] * r2;
                    *(u32x4*)(Z + (size_t)row * 1024 + col0) = pack8(a0, a1); }
        } else {
            const int col0 = (u.pn - 8) * BM + wc * 32 + 8 * fq;
#pragma unroll
            for (int ai = 0; ai < 2; ++ai)
#pragma unroll
                for (int m = 0; m < 4; ++m) { const int row = row0 + ai * HALF + m * 16; const float r = rs[ai][m];
#pragma unroll
                    for (int bj = 0; bj < 2; ++bj) *(u32x4*)(BG + (size_t)row * 1024 + col0 + bj * HALF) = pack8(acc[ai][bj][m][0] * r, acc[ai][bj][m][1] * r); }
        }
    }
};

#define PG8_STAMP(i, cond) do { } while (0)
template <class Epi, class Sched, bool ALIGN_EPI = false, bool SP2 = false>
__device__ __forceinline__ void gemm_phase(PG8_LAS unsigned char* lds, const Gemm g, const Sched& S, const Epi& E) {
    const int tid = threadIdx.x, wid = __builtin_amdgcn_readfirstlane(tid >> 6), lane = tid & 63, wr = wid >> 2, wc = wid & 3, fr = lane & 15, fq = lane >> 4;
    const int K = g.K, nt = K / BK;
    unsigned voffA[2], voffB[2];
#pragma unroll
    for (int i = 0; i < 2; ++i) { int R, C; stage_rc(tid * 16 + i * 8192, R, C); const int Rb = Epi::PERM ? ((R & ~31) + perm32(R & 31)) : R;
        voffA[i] = (unsigned)(R * K + C) * 2u; voffB[i] = (unsigned)(Rb * K + C) * 2u; }
    const size_t kstep = (size_t)(BK * 2);
    const size_t hstep = (size_t)HALF * K * 2;
    const size_t tstep = 2 * hstep;
    const unsigned ldsw = (unsigned)wid * 1024u;
    const int aoff = lds_byte(wr * 64 + fr, fq * 8), boff = lds_byte(wc * 32 + fr, fq * 8);
#define PG8_SA(b, h) (((b) * 2 + (h)) * HTB)
#define PG8_SB(b, h) ((4 + (b) * 2 + (h)) * HTB)
#define PG8_STAGE(bufoff, gbase, voff) do { _Pragma("unroll") for (int _i = 0; _i < 2; ++_i) \
        __builtin_amdgcn_global_load_lds((const unsigned*)((const char*)(gbase) + (voff)[_i]), (PG8_LAS unsigned*)(lds + (bufoff) + ldsw + _i * 8192), 16, 0, 0); } while (0)
#define PG8_LDA(dst, b, h) do { _Pragma("unroll") for (int m = 0; m < 4; ++m) _Pragma("unroll") for (int k = 0; k < 2; ++k) dst[m][k] = *(const PG8_LAS bf16x8*)(lds + PG8_SA(b, h) + aoff + m * 2048 + k * 1024); } while (0)
#define PG8_LDB(dst, b, h) do { _Pragma("unroll") for (int n = 0; n < 2; ++n) _Pragma("unroll") for (int k = 0; k < 2; ++k) dst[n][k] = *(const PG8_LAS bf16x8*)(lds + PG8_SB(b, h) + boff + n * 2048 + k * 1024); } while (0)
#define PG8_MMA(ai, bj, At, Bt) do { __builtin_amdgcn_s_setprio(1); _Pragma("unroll") for (int m = 0; m < 4; ++m) _Pragma("unroll") for (int n = 0; n < 2; ++n) _Pragma("unroll") for (int k = 0; k < 2; ++k) \
        acc[ai][bj][m][n] = __builtin_amdgcn_mfma_f32_16x16x32_bf16(Bt[n][k], At[m][k], acc[ai][bj][m][n], 0, 0, 0); __builtin_amdgcn_s_setprio(0); } while (0)
#define PG8_WAIT_V(n) asm volatile("s_waitcnt vmcnt(" #n ")" ::: "memory")
#define PG8_WAIT_L(n) asm volatile("s_waitcnt lgkmcnt(" #n ")" ::: "memory")
#define PG8_BAR __builtin_amdgcn_s_barrier()
#define PG8_SCHED __builtin_amdgcn_sched_barrier(0)
    Unit cur, nxt; int ui = 0;
    if (!S.next(0, cur)) return;
    f32x4 acc[2][2][4][2];
#pragma unroll
    for (int a = 0; a < 2; ++a)
#pragma unroll
        for (int b = 0; b < 2; ++b)
#pragma unroll
            for (int m = 0; m < 4; ++m)
#pragma unroll
                for (int n = 0; n < 2; ++n) acc[a][b][m][n] = (f32x4){0.f, 0.f, 0.f, 0.f};
    bf16x8 At[4][2], B0[2][2], B1[2][2];
    const char* cA = (const char*)g.A + (size_t)cur.pm * tstep; const char* cB = (const char*)g.Bt + (size_t)cur.pn * tstep;
    S.a_ready(cur);
    if constexpr (SP2) {
        PG8_STAGE(PG8_SB(0, 0), cB, voffB); PG8_STAGE(PG8_SB(0, 1), cB + hstep, voffB); PG8_STAGE(PG8_SA(0, 0), cA, voffA); PG8_STAGE(PG8_SA(0, 1), cA + hstep, voffA);
        if (wr == 1) PG8_BAR;
        PG8_WAIT_V(2); PG8_BAR;
        PG8_STAGE(PG8_SB(1, 0), cB + kstep, voffB); PG8_STAGE(PG8_SA(1, 0), cA + kstep, voffA); PG8_STAGE(PG8_SB(1, 1), cB + hstep + kstep, voffB);
        PG8_WAIT_V(6); PG8_BAR;
    } else {
        PG8_STAGE(PG8_SB(0, 0), cB, voffB); PG8_STAGE(PG8_SA(0, 0), cA, voffA); PG8_STAGE(PG8_SB(0, 1), cB + hstep, voffB); PG8_STAGE(PG8_SA(0, 1), cA + hstep, voffA);
        if (wr == 1) PG8_BAR;
        PG8_WAIT_V(4); PG8_BAR;
        PG8_STAGE(PG8_SB(1, 0), cB + kstep, voffB); PG8_STAGE(PG8_SA(1, 0), cA + kstep, voffA); PG8_STAGE(PG8_SB(1, 1), cB + hstep + kstep, voffB);
        PG8_WAIT_V(6); PG8_BAR;
    }
    for (;;) {
        const bool has_next = S.next(ui + 1, nxt);
        const char* nA = has_next ? (const char*)g.A + (size_t)nxt.pm * tstep : cA; const char* nB = has_next ? (const char*)g.Bt + (size_t)nxt.pn * tstep : cB;
        for (int t = 0; t < nt; t += 2) {
            const bool last = (t == nt - 2);
            const char* a1 = cA + (size_t)(t + 1) * kstep;
            const char* a2 = last ? nA : cA + (size_t)(t + 2) * kstep; const char* b2 = last ? nB : cB + (size_t)(t + 2) * kstep;
            const char* a3 = a2 + kstep; const char* b3 = b2 + kstep;
            if (last && has_next) S.a_ready(nxt);
            if constexpr (SP2) {
            PG8_LDB(B0, 0, 0); PG8_LDB(B1, 0, 1); PG8_SCHED; PG8_LDA(At, 0, 0); PG8_STAGE(PG8_SA(1, 1), a1 + hstep, voffA);
            PG8_WAIT_V(8); PG8_WAIT_L(0); PG8_BAR; PG8_MMA(0, 0, At, B0); PG8_MMA(0, 1, At, B1); PG8_BAR; PG8_SCHED;
            PG8_LDA(At, 0, 1); PG8_STAGE(PG8_SB(0, 0), b2, voffB); PG8_STAGE(PG8_SB(0, 1), b2 + hstep, voffB); PG8_STAGE(PG8_SA(0, 0), a2, voffA);
            PG8_WAIT_V(8); PG8_WAIT_L(0); PG8_BAR; PG8_MMA(1, 0, At, B0); PG8_MMA(1, 1, At, B1); PG8_BAR; PG8_SCHED;
            PG8_LDB(B0, 1, 0); PG8_LDB(B1, 1, 1); PG8_SCHED; PG8_LDA(At, 1, 0); PG8_STAGE(PG8_SA(0, 1), a2 + hstep, voffA);
            PG8_WAIT_V(8); PG8_WAIT_L(0); PG8_BAR; PG8_MMA(0, 0, At, B0); PG8_MMA(0, 1, At, B1); PG8_BAR; PG8_SCHED;
            PG8_LDA(At, 1, 1); PG8_STAGE(PG8_SB(1, 0), b3, voffB); PG8_STAGE(PG8_SB(1, 1), b3 + hstep, voffB); PG8_STAGE(PG8_SA(1, 0), a3, voffA);
            PG8_WAIT_V(8); PG8_WAIT_L(0); PG8_BAR; PG8_MMA(1, 0, At, B0); PG8_MMA(1, 1, At, B1); PG8_BAR; PG8_SCHED;
            } else {
            PG8_LDB(B0, 0, 0); PG8_SCHED; PG8_LDA(At, 0, 0); PG8_STAGE(PG8_SA(1, 1), a1 + hstep, voffA);
            PG8_WAIT_L(8); PG8_BAR; PG8_WAIT_L(0); PG8_MMA(0, 0, At, B0); PG8_BAR; PG8_SCHED;
            PG8_LDB(B1, 0, 1); PG8_STAGE(PG8_SB(0, 0), b2, voffB);
            PG8_BAR; PG8_WAIT_L(0); PG8_MMA(0, 1, At, B1); PG8_BAR;
            PG8_LDA(At, 0, 1); PG8_STAGE(PG8_SA(0, 0), a2, voffA);
            PG8_BAR; PG8_WAIT_L(0); PG8_MMA(1, 0, At, B0); PG8_BAR; PG8_SCHED;
            PG8_STAGE(PG8_SB(0, 1), b2 + hstep, voffB);
            PG8_WAIT_V(6); PG8_BAR; PG8_MMA(1, 1, At, B1); PG8_BAR;
            PG8_LDB(B0, 1, 0); PG8_SCHED; PG8_LDA(At, 1, 0); PG8_STAGE(PG8_SA(0, 1), a2 + hstep, voffA);
            PG8_WAIT_L(8); PG8_BAR; PG8_WAIT_L(0); PG8_MMA(0, 0, At, B0); PG8_BAR; PG8_SCHED;
            PG8_LDB(B1, 1, 1); PG8_STAGE(PG8_SB(1, 0), b3, voffB);
            PG8_BAR; PG8_WAIT_L(0); PG8_MMA(0, 1, At, B1); PG8_BAR;
            PG8_LDA(At, 1, 1); PG8_STAGE(PG8_SA(1, 0), a3, voffA);
            PG8_BAR; PG8_WAIT_L(0); PG8_MMA(1, 0, At, B0); PG8_BAR; PG8_SCHED;
            PG8_STAGE(PG8_SB(1, 1), b3 + hstep, voffB);
            PG8_WAIT_V(6); PG8_BAR; PG8_MMA(1, 1, At, B1); PG8_BAR;
            }
        }
        if constexpr (ALIGN_EPI) { if (wr == 0) PG8_BAR; }
        if constexpr (!Epi::AFTER_DRAIN) { E(acc, cur, wr, wc, fr, fq); S.done(cur); }
        if (!has_next) break;
#pragma unroll
        for (int a = 0; a < 2; ++a)
#pragma unroll
            for (int b = 0; b < 2; ++b)
#pragma unroll
                for (int m = 0; m < 4; ++m)
#pragma unroll
                    for (int n = 0; n < 2; ++n) acc[a][b][m][n] = (f32x4){0.f, 0.f, 0.f, 0.f};
        cur = nxt; cA = nA; cB = nB; ++ui;
        if constexpr (ALIGN_EPI) { if (wr == 1) PG8_BAR; }
    }
    PG8_WAIT_V(0);
    if constexpr (!ALIGN_EPI) { if (wr == 0) PG8_BAR; }
    PG8_BAR;
    if constexpr (Epi::AFTER_DRAIN) { E.fused(acc, cur, wr, wc, fr, fq, lds, wid, lane); S.done(cur); }
#undef PG8_SA
#undef PG8_SB
#undef PG8_STAGE
#undef PG8_LDA
#undef PG8_LDB
#undef PG8_MMA
#undef PG8_WAIT_V
#undef PG8_WAIT_L
#undef PG8_BAR
#undef PG8_SCHED
}
}

constexpr int NWAVES = 8;
constexpr int SEQ = 2048, D = 1024, M = 16 * SEQ;
constexpr int EA = 2048, NH = 16, CH = 128;
constexpr int FF = 2816;
constexpr float LN_EPS = 1e-6f;
#ifndef MK_ONE_LAUNCH
#define MK_ONE_LAUNCH 1
#endif
constexpr int N_PHASES = 12;

constexpr size_t MiB = 1u << 20;
constexpr size_t WS_AIN = 2 * MiB, WS_AOUT = 10 * MiB, WS_WS = 14 * MiB, WS_GU0 = 15 * MiB, WS_D0 = 26 * MiB, WS_GU1 = 32 * MiB, WS_D1 = 43 * MiB, WS_BIN = 49 * MiB, WS_BOUT = 55 * MiB;
constexpr size_t WS_R0 = 57 * MiB;
constexpr size_t WS_SS = 58 * MiB, WS_VST = 60 * MiB;
constexpr size_t WS_XB = 64 * MiB;
constexpr size_t WS_U = 128 * MiB, WS_VT = 256 * MiB;
constexpr size_t WS_A = 128 * MiB;
constexpr size_t WS_YC = 304 * MiB, WS_Z = 384 * MiB, WS_BG = 448 * MiB, WS_END = 512 * MiB;
constexpr size_t WS_Y = 384 * MiB;
static_assert(WS_A + (size_t)M * FF * 2 <= WS_YC && WS_YC + (size_t)M * D * 2 <= WS_Z && WS_BG + (size_t)M * D * 2 <= WS_END, "d_ws map");
static_assert(WS_GU0 + (size_t)2 * FF * D * 2 <= WS_D0 && WS_D0 + (size_t)FF * D * 2 <= WS_GU1 && WS_D1 + (size_t)FF * D * 2 <= WS_BIN, "weight map");

constexpr int RING_BYTES = 131072, LDSCTL_OFF = 143360, MISC_OFF = LDSCTL_OFF + 320, LDS_BYTES = 147456;
constexpr size_t WS_CTL = 0, CTL_ZERO_BYTES = 65536;
constexpr int CW_BAR = 4096;

#define GAS __attribute__((address_space(1)))
#define LAS __attribute__((address_space(3)))
typedef unsigned short bf16;
typedef unsigned v4u __attribute__((ext_vector_type(4)));
typedef unsigned v2u __attribute__((ext_vector_type(2)));
typedef float f32x4 __attribute__((ext_vector_type(4)));
typedef float f32x2 __attribute__((ext_vector_type(2)));
typedef short bf16x8 __attribute__((ext_vector_type(8)));
#define LDS_WAIT() asm volatile("s_waitcnt lgkmcnt(0)" ::: "memory")
__device__ __forceinline__ unsigned f2bf(float f) { unsigned u = __builtin_bit_cast(unsigned, f); return (u + 0x7fffu + ((u >> 16) & 1u)) >> 16; }
__device__ __forceinline__ unsigned pk2(float lo, float hi) { return f2bf(lo) | (f2bf(hi) << 16); }
__device__ __forceinline__ float bflo(unsigned w) { return __builtin_bit_cast(float, w << 16); }
__device__ __forceinline__ float bfhi(unsigned w) { return __builtin_bit_cast(float, w & 0xffff0000u); }

typedef GAS unsigned gu32;
#define RLX_AGENT __ATOMIC_RELAXED, __HIP_MEMORY_SCOPE_AGENT
#define XB_TMO      128
#define XB_XCNT(j)  (256  + 64 * (j))
#define XB_XSUB(j)  (1280 + 64 * (j))
#define XB_XGEN(j)  (2304 + 64 * (j))
#define XB_TOP      3328
#define XB_TOPGEN   3392
#define XCD_BAR_WORDS 3456
#define XB_SPIN_CAP (1u << 18)

__device__ __forceinline__ unsigned xb_ld(unsigned* p)              { return __hip_atomic_load(p, __ATOMIC_RELAXED, __HIP_MEMORY_SCOPE_AGENT); }
__device__ __forceinline__ unsigned xb_add(unsigned* p, unsigned v) { return __hip_atomic_fetch_add(p, v, __ATOMIC_RELAXED, __HIP_MEMORY_SCOPE_AGENT); }
__device__ __forceinline__ unsigned xb_xcc_id() { return (unsigned)__builtin_amdgcn_s_getreg((3 << 11) | 20) & 0xFu; }
#define XB_SPIN(cond, bar) do { unsigned _sp = 0; while (cond) { __builtin_amdgcn_s_sleep(1); \
    if ((++_sp & 255u) == 0u) { if (xb_ld(&(bar)[XB_TMO])) break; if (_sp > XB_SPIN_CAP) { atomicAdd(&(bar)[XB_TMO], 1u); break; } } } } while (0)

struct XcdBarrier {
    unsigned* bar; unsigned x;
    volatile LAS unsigned* st;
};

__device__ __forceinline__ XcdBarrier xcd_barrier_post(unsigned* bar, volatile LAS unsigned* st) {
    XcdBarrier b; b.bar = bar; b.x = xb_xcc_id(); b.st = st;
    if (threadIdx.x == 0) (void)xb_add(&bar[XB_XCNT(b.x)], 1u);
    return b;
}
__device__ __forceinline__ void xcd_barrier_complete(unsigned* bar, unsigned x, unsigned& nloc, unsigned& nx) {
    const unsigned G = gridDim.x * gridDim.y * gridDim.z;
    unsigned sum, cnt, mine, sp = 0u;
    for (;;) {
        sum = 0u; cnt = 0u; mine = 0u;
#pragma unroll
        for (unsigned j = 0; j < 16; ++j) { const unsigned c = xb_ld(&bar[XB_XCNT(j)]); sum += c; cnt += (c > 0u) ? 1u : 0u; mine = (j == x) ? c : mine; }
        if (sum == G) break;
        __builtin_amdgcn_s_sleep(1);
        if ((++sp & 255u) == 0u) { if (xb_ld(&bar[XB_TMO])) break; if (sp > XB_SPIN_CAP) { atomicAdd(&bar[XB_TMO], 1u); break; } }
    }
    nloc = mine > 0u ? mine : 1u; nx = cnt > 0u ? cnt : 1u;
}

__device__ __forceinline__ void xcd_barrier(const XcdBarrier& b) {
    asm volatile("s_waitcnt vmcnt(0)" ::: "memory");
    __syncthreads();
    if (threadIdx.x == 0) {
        unsigned* bar = b.bar;
        __builtin_amdgcn_s_waitcnt(0);
        unsigned nloc = b.st[0], nx = b.st[1];
        if (nloc == 0u) { xcd_barrier_complete(bar, b.x, nloc, nx); b.st[0] = nloc; b.st[1] = nx; }
        const unsigned old = xb_add(&bar[XB_XSUB(b.x)], 1u);
        const unsigned gen = old / nloc;
        if (old + 1u == (gen + 1u) * nloc) {
            __builtin_amdgcn_fence(__ATOMIC_RELEASE, "agent");
            asm volatile("s_waitcnt vmcnt(0)" ::: "memory");
            const unsigned og = xb_add(&bar[XB_TOP], 1u);
            const unsigned tg = og / nx;
            if (og + 1u == (tg + 1u) * nx) xb_add(&bar[XB_TOPGEN], 1u);
            else XB_SPIN(xb_ld(&bar[XB_TOPGEN]) == tg, bar);
            __builtin_amdgcn_fence(__ATOMIC_ACQUIRE, "agent");
            xb_add(&bar[XB_XGEN(b.x)], 1u);
            asm volatile("s_waitcnt vmcnt(0)" ::: "memory");
        } else {
            XB_SPIN(xb_ld(&bar[XB_XGEN(b.x)]) == gen, bar);
            __builtin_amdgcn_fence(__ATOMIC_ACQUIRE, "agent");
            asm volatile("s_waitcnt vmcnt(0)" ::: "memory");
        }
    }
    __syncthreads();
}

struct Frame {
    LAS unsigned char* lds;
    int tid, lane, wave, vcu, G;
    const float *x, *mix_norm, *ffn_norm, *a_w_in, *a_v_gain, *a_v_bias, *a_w_s, *a_b_s, *a_w_out, *b_w_in, *b_conv_w, *b_w_out, *w_gate, *w_up, *w_down, *final_norm;
    float* out; unsigned char* ws;
};

__device__ __forceinline__ float wave_sum(float v) {
#pragma unroll
    for (int o = 1; o < 64; o <<= 1) v += __shfl_xor(v, o);
    return v;
}
template <int MODE> __device__ __forceinline__ void p0_transpose_item(const float* W, int K, int N, bf16* WT, int row_off, const float* gain, LAS float* scr, int item, int lane) {
    const int nblk = N / 32, kb = item / nblk, nb = item % nblk, k0 = 64 * kb, n0 = 32 * nb;
    const int kr = lane >> 3, n4 = lane & 7;
    f32x4 wv[8];
#pragma unroll
    for (int i = 0; i < 8; ++i) wv[i] = *(const GAS f32x4*)(W + (size_t)(k0 + 8 * i + kr) * N + n0 + 4 * n4);
#pragma unroll
    for (int i = 0; i < 8; ++i) { const int kk = 8 * i + kr; f32x4 w = wv[i]; if (gain) w = w * gain[k0 + kk];
        LAS float* d = scr + kk * 33 + 4 * n4; d[0] = w[0]; d[1] = w[1]; d[2] = w[2]; d[3] = w[3]; }
    LDS_WAIT(); asm volatile("" ::: "memory");
    const int c = lane & 7;
    const int rbase = (MODE == 0) ? (row_off + n0) : (MODE == 1) ? (row_off + 256 * (n0 / 128) + (n0 % 128))
        : ((n0 < 1024) ? (2048 + n0) : (256 * ((n0 & 1023) / 128) + ((n0 & 1023) % 128) + (n0 >= 2048 ? 128 : 0)));
#pragma unroll
    for (int j = 0; j < 4; ++j) { const int n = (lane >> 3) + 8 * j; const LAS float* s = scr + (8 * c) * 33 + n;
        v4u o; o.x = pk2(s[0 * 33], s[1 * 33]); o.y = pk2(s[2 * 33], s[3 * 33]); o.z = pk2(s[4 * 33], s[5 * 33]); o.w = pk2(s[6 * 33], s[7 * 33]);
        *(GAS v4u*)(WT + (size_t)(rbase + n) * K + k0 + 8 * c) = o; }
    LDS_WAIT(); asm volatile("" ::: "memory");
}
__device__ __forceinline__ void p0_prologue(Frame& F) {
    LAS float* scr = (LAS float*)(F.lds + F.wave * 16384);
    const int gw = F.vcu * NWAVES + F.wave, NGW = F.G * NWAVES;
    unsigned char* ws = F.ws;
    constexpr int I_AIN = (D / 64) * (2 * EA / 32), I_AOUT = (EA / 64) * (D / 32), I_G = (D / 64) * (FF / 32), I_DN = (FF / 64) * (D / 32), I_BIN = (D / 64) * (D / 32), I_BOUT = (D / 64) * (D / 32);
    constexpr int NITEMS = I_AIN + I_AOUT + 4 * I_G + 2 * I_DN + 3 * I_BIN + I_BOUT;
    for (int it = gw; it < NITEMS; it += NGW) {
        int r = it;
        if (r < I_AIN) { p0_transpose_item<0>(F.a_w_in, D, 2 * EA, (bf16*)(ws + WS_AIN), 0, F.mix_norm, scr, r, F.lane); continue; } r -= I_AIN;
        if (r < I_AOUT) { p0_transpose_item<0>(F.a_w_out, EA, D, (bf16*)(ws + WS_AOUT), 0, nullptr, scr, r, F.lane); continue; } r -= I_AOUT;
        if (r < I_G) { p0_transpose_item<1>(F.w_gate, D, FF, (bf16*)(ws + WS_GU0), 0, F.ffn_norm, scr, r, F.lane); continue; } r -= I_G;
        if (r < I_G) { p0_transpose_item<1>(F.w_up, D, FF, (bf16*)(ws + WS_GU0), 128, F.ffn_norm, scr, r, F.lane); continue; } r -= I_G;
        if (r < I_G) { p0_transpose_item<1>(F.w_gate + (size_t)D * FF, D, FF, (bf16*)(ws + WS_GU1), 0, F.ffn_norm + D, scr, r, F.lane); continue; } r -= I_G;
        if (r < I_G) { p0_transpose_item<1>(F.w_up + (size_t)D * FF, D, FF, (bf16*)(ws + WS_GU1), 128, F.ffn_norm + D, scr, r, F.lane); continue; } r -= I_G;
        if (r < I_DN) { p0_transpose_item<0>(F.w_down, FF, D, (bf16*)(ws + WS_D0), 0, nullptr, scr, r, F.lane); continue; } r -= I_DN;
        if (r < I_DN) { p0_transpose_item<0>(F.w_down + (size_t)FF * D, FF, D, (bf16*)(ws + WS_D1), 0, nullptr, scr, r, F.lane); continue; } r -= I_DN;
        if (r < 3 * I_BIN) { p0_transpose_item<2>(F.b_w_in, D, 3 * D, (bf16*)(ws + WS_BIN), 0, F.mix_norm + D, scr, r, F.lane); continue; } r -= 3 * I_BIN;
        p0_transpose_item<0>(F.b_w_out, D, D, (bf16*)(ws + WS_BOUT), 0, nullptr, scr, r, F.lane);
    }
    { const int gt = (F.vcu * NWAVES + F.wave) * 64 + F.lane, NGT = NGW * 64; bf16* o = (bf16*)(ws + WS_WS);
      for (int i = gt; i < NH * CH * CH / 2; i += NGT) { const int e = 2 * i, t = (e / CH) % CH, s = e % CH; const float a = F.a_w_s[e], b = F.a_w_s[e + 1];
          ((GAS unsigned*)o)[i] = pk2(s <= t ? a : 0.f, (s + 1) <= t ? b : 0.f); } }
    for (int m = gw; m < M; m += NGW) {
        const GAS f32x4* xr = (const GAS f32x4*)(F.x + (size_t)m * D) + 2 * F.lane;
        f32x4 v[4]; float s = 0.f;
#pragma unroll
        for (int j = 0; j < 2; ++j) { v[2 * j] = xr[128 * j]; v[2 * j + 1] = xr[128 * j + 1]; }
#pragma unroll
        for (int j = 0; j < 4; ++j) s += (v[j].x * v[j].x + v[j].y * v[j].y) + (v[j].z * v[j].z + v[j].w * v[j].w);
        const float rms = sqrtf(wave_sum(s) * (1.f / D) + pg8::RMS_EPS), rstd = 1.f / rms;
        if (F.lane == 0) ((float*)(ws + WS_R0))[m] = rms;
        GAS v4u* o16 = (GAS v4u*)((bf16*)(ws + WS_XB) + (size_t)m * D) + F.lane;
#pragma unroll
        for (int j = 0; j < 2; ++j) { const f32x4 a = v[2 * j] * rstd, b = v[2 * j + 1] * rstd; o16[64 * j] = (v4u){pk2(a.x, a.y), pk2(a.z, a.w), pk2(b.x, b.y), pk2(b.z, b.w)}; }
    }
}

constexpr int SG_PITCH = 272;
constexpr int SG_W = 0, SG_V = 128 * SG_PITCH, SG_ST = 2 * 128 * SG_PITCH;
__device__ __forceinline__ void sgu_phase(Frame& F) {
    LAS unsigned char* lds = F.lds;
    const int tid = F.tid, lane = F.lane, w = F.wave, fr = lane & 15, fq = lane >> 4;
    const bf16* U = (const bf16*)(F.ws + WS_U); bf16* Y = (bf16*)(F.ws + WS_Y); const bf16* VT = (const bf16*)(F.ws + WS_VT); const bf16* WSB = (const bf16*)(F.ws + WS_WS);
    const f32x2* vst = (const f32x2*)(F.ws + WS_VST);
    const int cs = tid & 15, r0 = tid >> 4;
    const int t = 16 * w + fr;
    for (int chunk = F.vcu; chunk < M / CH; chunk += F.G) {
        const int t0 = chunk * CH;
        __syncthreads();
        if (tid < CH) { float s = 0.f, q = 0.f;
#pragma unroll
            for (int i = 0; i < 16; ++i) { const f32x2 a = vst[(size_t)i * M + t0 + tid]; s += a.x; q += a.y; }
            const float mean = s * (1.f / EA); const float var = q * (1.f / EA) - mean * mean; const float rstd = 1.f / sqrtf(var + LN_EPS);
            ((LAS f32x2*)(lds + SG_ST))[tid] = (f32x2){rstd, -mean * rstd}; }
#define SG_BAR() do { asm volatile("s_waitcnt lgkmcnt(0)" ::: "memory"); __builtin_amdgcn_s_barrier(); asm volatile("" ::: "memory"); } while (0)
        v4u wreg[4], vreg[4], ureg[4]; float gn[4], bi[4];
#define SG_LOAD(h_) do { const int hh = (h_); \
            _Pragma("unroll") for (int i = 0; i < 4; ++i) { const int r = r0 + 32 * i; const int c = hh * CH + r; \
                wreg[i] = *(const GAS v4u*)(WSB + (size_t)hh * CH * CH + r * CH + cs * 8); \
                vreg[i] = *(const GAS v4u*)(VT + ((size_t)chunk * EA + c) * CH + cs * 8); gn[i] = F.a_v_gain[c]; bi[i] = F.a_v_bias[c]; } \
            _Pragma("unroll") for (int g = 0; g < 4; ++g) ureg[g] = *(const GAS v4u*)(U + (size_t)(t0 + t) * EA + hh * CH + 8 * fq + 32 * g); } while (0)
        SG_LOAD(0);
        __syncthreads();
        f32x2 st[8];
#pragma unroll
        for (int k = 0; k < 8; ++k) st[k] = ((const LAS f32x2*)(lds + SG_ST))[cs * 8 + k];
        for (int h = 0; h < NH; ++h) {
            if (h) SG_BAR();
#pragma unroll
            for (int i = 0; i < 4; ++i) { const int r = r0 + 32 * i;
                *(LAS v4u*)(lds + SG_W + r * SG_PITCH + cs * 16) = wreg[i];
                const float g = gn[i], b = bi[i]; const unsigned wd[4] = {vreg[i].x, vreg[i].y, vreg[i].z, vreg[i].w}; float o[8];
#pragma unroll
                for (int k = 0; k < 4; ++k) { o[2 * k] = (bflo(wd[k]) * st[2 * k].x + st[2 * k].y) * g + b; o[2 * k + 1] = (bfhi(wd[k]) * st[2 * k + 1].x + st[2 * k + 1].y) * g + b; }
                v4u ov; ov.x = pk2(o[0], o[1]); ov.y = pk2(o[2], o[3]); ov.z = pk2(o[4], o[5]); ov.w = pk2(o[6], o[7]);
                *(LAS v4u*)(lds + SG_V + r * SG_PITCH + cs * 16) = ov; }
            v4u ucur[4];
#pragma unroll
            for (int g = 0; g < 4; ++g) ucur[g] = ureg[g];
            __syncthreads();
            if (h + 1 < NH) SG_LOAD(h + 1);
            f32x4 acc[4][2];
#pragma unroll
            for (int g = 0; g < 4; ++g) { acc[g][0] = (f32x4){0.f, 0.f, 0.f, 0.f}; acc[g][1] = (f32x4){0.f, 0.f, 0.f, 0.f}; }
            const int kmax = (16 * w + 15) / 32;
            for (int kk = 0; kk <= kmax; ++kk) {
                const bf16x8 a = *(const LAS bf16x8*)(lds + SG_W + t * SG_PITCH + kk * 64 + fq * 16);
#pragma unroll
                for (int g = 0; g < 4; ++g)
#pragma unroll
                    for (int n = 0; n < 2; ++n) { const int crow = 32 * g + 8 * (fr >> 2) + 4 * n + (fr & 3);
                        const bf16x8 b = *(const LAS bf16x8*)(lds + SG_V + crow * SG_PITCH + kk * 64 + fq * 16);
                        acc[g][n] = __builtin_amdgcn_mfma_f32_16x16x32_bf16(b, a, acc[g][n], 0, 0, 0); }
            }
            const float bs = F.a_b_s[h * CH + t];
            bf16* yp = Y + (size_t)(t0 + t) * EA + h * CH + 8 * fq;
#pragma unroll
            for (int g = 0; g < 4; ++g) { const v4u uv = ucur[g];
                v4u ov; ov.x = pk2(bflo(uv.x) * (acc[g][0][0] + bs), bfhi(uv.x) * (acc[g][0][1] + bs)); ov.y = pk2(bflo(uv.y) * (acc[g][0][2] + bs), bfhi(uv.y) * (acc[g][0][3] + bs));
                ov.z = pk2(bflo(uv.z) * (acc[g][1][0] + bs), bfhi(uv.z) * (acc[g][1][1] + bs)); ov.w = pk2(bflo(uv.w) * (acc[g][1][2] + bs), bfhi(uv.w) * (acc[g][1][3] + bs));
                *(GAS v4u*)(yp + 32 * g) = ov; }
        }
#undef SG_LOAD
#undef SG_BAR
    }
}

__device__ __forceinline__ void conv_phase(Frame& F) {
    const bf16* Z = (const bf16*)(F.ws + WS_Z); const bf16* BG = (const bf16*)(F.ws + WS_BG); bf16* YC = (bf16*)(F.ws + WS_YC);
    const int gt = F.vcu * 512 + F.tid, NGT = F.G * 512;
    for (int i = gt; i < M * (D / 8); i += NGT) {
        const int row = i >> 7, c8 = (i & 127) * 8, tpos = row & (SEQ - 1);
        const size_t off = (size_t)row * D + c8;
        const v4u z2 = *(const GAS v4u*)(Z + off), bg = *(const GAS v4u*)(BG + off);
        v4u z1 = (v4u){0u, 0u, 0u, 0u}, z0 = (v4u){0u, 0u, 0u, 0u};
        if (tpos >= 1) z1 = *(const GAS v4u*)(Z + off - D);
        if (tpos >= 2) z0 = *(const GAS v4u*)(Z + off - 2 * D);
        const f32x4 w0a = *(const GAS f32x4*)(F.b_conv_w + c8), w0b = *(const GAS f32x4*)(F.b_conv_w + c8 + 4);
        const f32x4 w1a = *(const GAS f32x4*)(F.b_conv_w + D + c8), w1b = *(const GAS f32x4*)(F.b_conv_w + D + c8 + 4);
        const f32x4 w2a = *(const GAS f32x4*)(F.b_conv_w + 2 * D + c8), w2b = *(const GAS f32x4*)(F.b_conv_w + 2 * D + c8 + 4);
        const unsigned a0[4] = {z0.x, z0.y, z0.z, z0.w}, a1[4] = {z1.x, z1.y, z1.z, z1.w}, a2[4] = {z2.x, z2.y, z2.z, z2.w}, ab[4] = {bg.x, bg.y, bg.z, bg.w};
        const float w0[8] = {w0a[0], w0a[1], w0a[2], w0a[3], w0b[0], w0b[1], w0b[2], w0b[3]}, w1[8] = {w1a[0], w1a[1], w1a[2], w1a[3], w1b[0], w1b[1], w1b[2], w1b[3]}, w2[8] = {w2a[0], w2a[1], w2a[2], w2a[3], w2b[0], w2b[1], w2b[2], w2b[3]};
        unsigned o[4];
#pragma unroll
        for (int k = 0; k < 4; ++k) {
            const float lo = bflo(ab[k]) * (bflo(a0[k]) * w0[2 * k] + bflo(a1[k]) * w1[2 * k] + bflo(a2[k]) * w2[2 * k]);
            const float hi = bfhi(ab[k]) * (bfhi(a0[k]) * w0[2 * k + 1] + bfhi(a1[k]) * w1[2 * k + 1] + bfhi(a2[k]) * w2[2 * k + 1]);
            o[k] = pk2(lo, hi); }
        *(GAS v4u*)(YC + off) = (v4u){o[0], o[1], o[2], o[3]};
    }
}
__device__ __forceinline__ void final_norm_phase(Frame& F) {
    const int gw = F.vcu * NWAVES + F.wave, NGW = F.G * NWAVES; const float* ss = (const float*)(F.ws + WS_SS); const bf16* XBp = (const bf16*)(F.ws + WS_XB);
    const GAS f32x4* gr = (const GAS f32x4*)F.final_norm + 2 * F.lane;
    for (int m = gw; m < M; m += NGW) {
        float s = (F.lane < 16) ? ss[(size_t)F.lane * M + m] : 0.f;
        s = wave_sum(s);
        const float rstd = 1.f / sqrtf(s * (1.f / D) + pg8::RMS_EPS);
        const GAS v4u* xr = (const GAS v4u*)(XBp + (size_t)m * D) + F.lane; GAS f32x4* orow = (GAS f32x4*)(F.out + (size_t)m * D) + 2 * F.lane;
#pragma unroll
        for (int j = 0; j < 2; ++j) { const v4u v = xr[64 * j]; const f32x4 g0 = gr[128 * j], g1 = gr[128 * j + 1];
            orow[128 * j] = (f32x4){bflo(v.x), bfhi(v.x), bflo(v.y), bfhi(v.y)} * rstd * g0;
            orow[128 * j + 1] = (f32x4){bflo(v.z), bfhi(v.z), bflo(v.w), bfhi(v.w)} * rstd * g1; }
    }
}

constexpr int RSTD_OFF = RING_BYTES;
__device__ __forceinline__ const LAS float* fill_rstd_table(Frame& F, int pm0) {
    if (F.G != 256) return nullptr;
    const float* ss = (const float*)(F.ws + WS_SS);
    const int slot = F.tid >> 8, r = F.tid & 255, row = (((pm0 & ~8) | (slot << 3)) << 8) + r;
    float s = 0.f;
#pragma unroll
    for (int j = 0; j < 16; ++j) s += ss[(size_t)j * M + row];
    ((LAS float*)(F.lds + RSTD_OFF))[F.tid] = __builtin_amdgcn_rsqf(s * (1.0f / D) + pg8::RMS_EPS);
    __syncthreads();
    return (const LAS float*)(F.lds + RSTD_OFF);
}

__device__ __forceinline__ const LAS float* fill_rms_table(Frame& F, int pm0) {
    if (F.G != 256) return nullptr;
    const int slot = F.tid >> 8, r = F.tid & 255, row = (((pm0 & ~8) | (slot << 3)) << 8) + r;
    ((LAS float*)(F.lds + RSTD_OFF))[F.tid] = ((const float*)(F.ws + WS_R0))[row];
    __syncthreads();
    return (const LAS float*)(F.lds + RSTD_OFF);
}

__device__ __forceinline__ void unscale_xb(Frame& F) {
    const int gw = F.vcu * NWAVES + F.wave, NGW = F.G * NWAVES;
    for (int m = gw; m < M; m += NGW) { const float rms = ((const float*)(F.ws + WS_R0))[m];
        GAS v4u* xr = (GAS v4u*)((bf16*)(F.ws + WS_XB) + (size_t)m * D) + F.lane;
#pragma unroll
        for (int j = 0; j < 2; ++j) { const v4u v = xr[64 * j];
            xr[64 * j] = (v4u){pk2(bflo(v.x) * rms, bfhi(v.x) * rms), pk2(bflo(v.y) * rms, bfhi(v.y) * rms), pk2(bflo(v.z) * rms, bfhi(v.z) * rms), pk2(bflo(v.w) * rms, bfhi(v.w) * rms)}; } }
}

struct Args { const float* in[16]; float* out; unsigned char* ws; int ph_lo, ph_hi, rep_mask, pad; };
__global__ void __launch_bounds__(NWAVES * 64, 2) hybrid_fwd(Args args) {
    extern __shared__ __attribute__((aligned(16))) unsigned char lds[];
    cg::grid_group grid = cg::this_grid();
    Frame F;
    F.lds = (LAS unsigned char*)lds;
    F.tid = threadIdx.x; F.lane = F.tid & 63; F.wave = __builtin_amdgcn_readfirstlane(F.tid >> 6);
    F.G = gridDim.x; { const int bx = blockIdx.x; F.vcu = (F.G % 8 == 0) ? (bx % 8) * (F.G / 8) + bx / 8 : bx; }
    F.x = args.in[0]; F.mix_norm = args.in[1]; F.ffn_norm = args.in[2]; F.a_w_in = args.in[3]; F.a_v_gain = args.in[4]; F.a_v_bias = args.in[5]; F.a_w_s = args.in[6]; F.a_b_s = args.in[7];
    F.a_w_out = args.in[8]; F.b_w_in = args.in[9]; F.b_conv_w = args.in[10]; F.b_w_out = args.in[11]; F.w_gate = args.in[12]; F.w_up = args.in[13]; F.w_down = args.in[14]; F.final_norm = args.in[15];
    F.out = args.out; F.ws = args.ws;
    unsigned char* ws = args.ws;
    for (int u = F.tid; u < (LDS_BYTES - LDSCTL_OFF) / 4; u += NWAVES * 64) ((LAS unsigned*)(F.lds + LDSCTL_OFF))[u] = 0u;
    __syncthreads();
    XcdBarrier bar = xcd_barrier_post((unsigned*)(ws + WS_CTL) + CW_BAR, (volatile LAS unsigned*)(F.lds + MISC_OFF) + 8);
    const int lo = args.ph_lo, hi = args.ph_hi;
    if (lo < 0) grid.sync();
#ifndef REP_MASK
#define REP_MASK 0
#endif
#ifndef EXTRA_SYNCS
#define EXTRA_SYNCS 0
#endif
#define REPS(k) 1
#define IN(k) (lo <= (k) && (k) < hi)
#ifndef PROBE_T
#define PROBE_T 0
#endif
#if PROBE_T
#ifndef PROBE_DIV
#define PROBE_DIV 20ull
#endif
#define STAMP(i) do { if (blockIdx.x == 0 && F.tid == 0) ((volatile LAS unsigned long long*)(F.lds + MISC_OFF + 128))[(i)] = __builtin_amdgcn_s_memrealtime(); } while (0)
#else
#define STAMP(i) do { } while (0)
#endif
#define SEAM(k) do { if (IN(k) && IN((k) + 1)) xcd_barrier(bar); STAMP((k) + 1); } while (0)
    pg8::bf16_t* XB = (pg8::bf16_t*)(ws + WS_XB); float* SS = (float*)(ws + WS_SS);
    const int c = (int)blockIdx.x;

    STAMP(0);
    if (IN(0)) { p0_prologue(F); __syncthreads(); } SEAM(0);

    if (IN(1)) {
        { pg8::Gemm g{XB, (const pg8::bf16_t*)(ws + WS_AIN), M, EA, D}; pg8::StaticOrder S; S.init(M, EA, F.G, c);
          pg8::EpiGelu E{(pg8::bf16_t*)(ws + WS_U), EA};
          pg8::gemm_phase<pg8::EpiGelu, pg8::StaticOrder, true, true>(F.lds, g, S, E); }
        { pg8::Gemm g{(const pg8::bf16_t*)(ws + WS_AIN) + (size_t)EA * D, XB, EA, M, D}; pg8::StaticOrder S; S.init(EA, M, F.G, c);
          pg8::EpiGeluT E{(pg8::bf16_t*)(ws + WS_VT), (pg8::f32x2*)(ws + WS_VST)};
          pg8::gemm_phase<pg8::EpiGeluT, pg8::StaticOrder, true, true>(F.lds, g, S, E); }
    } SEAM(1);

    if (IN(2)) { sgu_phase(F); } SEAM(2);

    if (IN(3)) {
        pg8::Gemm g{(const pg8::bf16_t*)(ws + WS_Y), (const pg8::bf16_t*)(ws + WS_AOUT), M, D, EA}; pg8::StaticOrder S; S.init(M, D, F.G, c);
        pg8::Unit u0; S.next(0, u0); const LAS float* rtab = fill_rms_table(F, u0.pm);
        if (!rtab) { unscale_xb(F); xcd_barrier(bar); }
        pg8::EpiRes E{XB, SS, rtab};
        pg8::gemm_phase<pg8::EpiRes, pg8::StaticOrder, true, true>(F.lds, g, S, E);
    } SEAM(3);

    if (IN(4)) {
        pg8::Gemm g{XB, (const pg8::bf16_t*)(ws + WS_GU0), M, 2 * FF, D}; pg8::StaticOrder S; S.init(M, 2 * FF, F.G, c);
        pg8::Unit u0; S.next(0, u0); pg8::EpiSwiglu E{(pg8::bf16_t*)(ws + WS_A), FF, SS, fill_rstd_table(F, u0.pm)};
        pg8::gemm_phase<pg8::EpiSwiglu, pg8::StaticOrder, true, true>(F.lds, g, S, E);
    } SEAM(4);

    if (IN(5)) {
        pg8::Gemm g{(const pg8::bf16_t*)(ws + WS_A), (const pg8::bf16_t*)(ws + WS_D0), M, D, FF}; pg8::StaticOrder S; S.init(M, D, F.G, c);
        pg8::EpiRes E{XB, SS, nullptr};
        pg8::gemm_phase<pg8::EpiRes, pg8::StaticOrder, true, true>(F.lds, g, S, E);
    } SEAM(5);

    if (IN(6)) {
        pg8::Gemm g{XB, (const pg8::bf16_t*)(ws + WS_BIN), M, 3 * D, D}; pg8::StaticOrder S; S.init(M, 3 * D, F.G, c);
        pg8::Unit u0; S.next(0, u0); pg8::EpiConvIn E{(pg8::bf16_t*)(ws + WS_Z), (pg8::bf16_t*)(ws + WS_BG), SS, fill_rstd_table(F, u0.pm)};
        pg8::gemm_phase<pg8::EpiConvIn, pg8::StaticOrder, true, true>(F.lds, g, S, E);
    } SEAM(6);

    if (IN(7)) { conv_phase(F); } SEAM(7);

    if (IN(8)) {
        pg8::Gemm g{(const pg8::bf16_t*)(ws + WS_YC), (const pg8::bf16_t*)(ws + WS_BOUT), M, D, D}; pg8::StaticOrder S; S.init(M, D, F.G, c);
        pg8::EpiRes E{XB, SS, nullptr};
        pg8::gemm_phase<pg8::EpiRes, pg8::StaticOrder, true, true>(F.lds, g, S, E);
    } SEAM(8);

    if (IN(9)) {
        pg8::Gemm g{XB, (const pg8::bf16_t*)(ws + WS_GU1), M, 2 * FF, D}; pg8::StaticOrder S; S.init(M, 2 * FF, F.G, c);
        pg8::Unit u0; S.next(0, u0); pg8::EpiSwiglu E{(pg8::bf16_t*)(ws + WS_A), FF, SS, fill_rstd_table(F, u0.pm)};
        pg8::gemm_phase<pg8::EpiSwiglu, pg8::StaticOrder, true, true>(F.lds, g, S, E);
    } SEAM(9);

    if (IN(10)) {
        pg8::Gemm g{(const pg8::bf16_t*)(ws + WS_A), (const pg8::bf16_t*)(ws + WS_D1), M, D, FF}; pg8::StaticOrder S; S.init(M, D, F.G, c);
        pg8::EpiRes E{XB, SS, nullptr};
        pg8::gemm_phase<pg8::EpiRes, pg8::StaticOrder, true, true>(F.lds, g, S, E);
    } SEAM(10);

    for (int i = 0; i < EXTRA_SYNCS; ++i) xcd_barrier(bar);
    if (IN(11)) { final_norm_phase(F); }
#if PROBE_T
    xcd_barrier(bar); STAMP(12);
    if (blockIdx.x == 0) {
        __syncthreads();
        volatile LAS unsigned long long* stp = (volatile LAS unsigned long long*)(F.lds + MISC_OFF + 128);
        const unsigned long long T = stp[PROBE_HI] - stp[PROBE_LO]; int K = (int)(T / PROBE_DIV); if (K > 4096) K = 4096;
        for (int j = F.tid; j < K; j += NWAVES * 64) F.out[(size_t)j * 8191] += 0.0625f;
    }
#endif
#undef IN
#undef SEAM
}

extern "C" void kernel_launch(void* const* d_in, const int* in_sizes, int n_in, void* d_out, int out_size, void* d_ws, size_t ws_size, hipStream_t stream) {
    static int grid = 0;
    if (grid == 0) {
        if (n_in != 16 || in_sizes[0] != M * D || out_size != M * D || ws_size < WS_END) { fprintf(stderr, "kernel_launch: unexpected shapes (n_in %d, in0 %d, out %d, ws %zu); nothing launched\n", n_in, n_in > 0 ? in_sizes[0] : -1, out_size, ws_size); grid = -1; return; }
        int dev = 0, cus = 0, per_cu = 0;
        if (hipGetDevice(&dev) != hipSuccess || hipDeviceGetAttribute(&cus, hipDeviceAttributeMultiprocessorCount, dev) != hipSuccess) { grid = -1; return; }
        if (hipFuncSetAttribute((const void*)hybrid_fwd, hipFuncAttributeMaxDynamicSharedMemorySize, LDS_BYTES) != hipSuccess) { fprintf(stderr, "kernel_launch: hipFuncSetAttribute failed\n"); grid = -1; return; }
        if (hipOccupancyMaxActiveBlocksPerMultiprocessor(&per_cu, (const void*)hybrid_fwd, NWAVES * 64, LDS_BYTES) != hipSuccess || per_cu < 1) { fprintf(stderr, "kernel_launch: occupancy query says %d blocks per CU\n", per_cu); per_cu = 1; }
        (void)hipGetLastError();
        grid = cus;
    }
    if (grid < 0) return;
    if (hipMemsetAsync((char*)d_ws + WS_CTL, 0, CTL_ZERO_BYTES, stream) != hipSuccess) { fprintf(stderr, "kernel_launch: memset failed\n"); return; }
    Args a{};
    for (int i = 0; i < 16; ++i) a.in[i] = (const float*)d_in[i];
    a.out = (float*)d_out; a.ws = (unsigned char*)d_ws; a.rep_mask = REP_MASK;
#if MK_ONE_LAUNCH
    a.ph_lo = 0; a.ph_hi = N_PHASES;
    void* kargs[] = {&a};
    const hipError_t e = hipLaunchCooperativeKernel((const void*)hybrid_fwd, dim3(grid), dim3(NWAVES * 64), kargs, LDS_BYTES, stream);
    if (e != hipSuccess) fprintf(stderr, "kernel_launch: cooperative launch failed: %s (grid %d)\n", hipGetErrorString(e), grid);
#else
    for (int p = 0; p < N_PHASES; ++p) { a.ph_lo = p; a.ph_hi = p + 1; hipLaunchKernelGGL(hybrid_fwd, dim3(grid), dim3(NWAVES * 64), LDS_BYTES, stream, a); }
#endif
}
```
